# Optimizing an MI355X kernel written in HIP

```python
import math
import jax, jax.numpy as jnp
from jax import lax
import numpy as np

D_MODEL = 2048
BATCH = 16
SEQ = 2048
DEPTH = 4

GRID_W = 64
CTX_LEN = 256
N_MIXERS = 4
MIXER_GLA, MIXER_GQA, MIXER_DIFF, MIXER_FOURIER = 0, 1, 2, 3
NORM_EPS = 1e-6
ROPE_THETA = 10000.0
Q_BLOCK = 128
HEAD_DIM = 128
FFN_HIDDEN = -(-8 * D_MODEL // (3 * 256)) * 256

GLA_HEADS = 4
GLA_DK = D_MODEL // 2 // GLA_HEADS
GLA_DV = D_MODEL // GLA_HEADS
GLA_QK = GLA_HEADS * GLA_DK
GLA_RANK = 16
GLA_TAU = 16.0
GLA_CHUNK = 64
GLA_SPLITS = (GLA_QK, 2 * GLA_QK, 2 * GLA_QK + D_MODEL, 2 * GLA_QK + 2 * D_MODEL,
              2 * GLA_QK + 2 * D_MODEL + GLA_RANK)
GLA_IN_DIM = 2 * GLA_QK + 2 * D_MODEL + 2 * GLA_RANK

GQA_HEADS = D_MODEL // HEAD_DIM
GQA_KV_HEADS = 4
GQA_GROUP = GQA_HEADS // GQA_KV_HEADS
GQA_IN_DIM = (GQA_HEADS + 2 * GQA_KV_HEADS) * HEAD_DIM

DIFF_HEADS = D_MODEL // (2 * HEAD_DIM)
DIFF_DH = HEAD_DIM
DIFF_IN_DIM = 3 * D_MODEL

FNET_GROUPS = 4
FNET_GROUP_DIM = D_MODEL // FNET_GROUPS

kernel_name = "hybrid_interleaved_prefix_dit_block"


def rms_norm(x, gain):
    xf = x.astype(jnp.float32)
    y = xf * lax.rsqrt(jnp.mean(xf * xf, axis=-1, keepdims=True) + NORM_EPS)
    return (y * gain.astype(jnp.float32)).astype(x.dtype)


def modulate(h, shift, scale):
    return h * (1 + scale) + shift


def swiglu(h, w_in, w_out):
    gate, up = jnp.split(h @ w_in, 2, axis=-1)
    return (jax.nn.silu(gate) * up) @ w_out


def axial_rope_tables(n_tokens, dim, dtype):
    t = jnp.arange(n_tokens)
    row = (t // GRID_W).astype(jnp.float32)
    col = (t % GRID_W).astype(jnp.float32)
    half = dim // 2
    inv_freq = ROPE_THETA ** (-jnp.arange(0, half, 2, dtype=jnp.float32) / half)
    ang_r = row[:, None] * inv_freq[None, :]
    ang_c = col[:, None] * inv_freq[None, :]
    ang = jnp.concatenate([ang_r, ang_r, ang_c, ang_c], axis=-1)
    return jnp.cos(ang).astype(dtype), jnp.sin(ang).astype(dtype)


def apply_axial_rope(x, cos, sin):
    x1, x2, x3, x4 = jnp.split(x, 4, axis=-1)
    rot = jnp.concatenate([-x2, x1, -x4, x3], axis=-1)
    return x * cos[:, None, :] + rot * sin[:, None, :]


def sweep_query_blocks(fn, *qs):
    b, s = qs[0].shape[:2]
    nb = s // Q_BLOCK
    blocks = tuple(jnp.moveaxis(q.reshape(b, nb, Q_BLOCK, *q.shape[2:]), 1, 0) for q in qs)
    out = lax.map(lambda qb: fn(*qb), blocks)
    return jnp.moveaxis(out, 0, 1).reshape(b, s, *out.shape[3:])


def gla_chunked(q, k, v, g, state0):
    b_, l_, h_, dk = q.shape
    dv = v.shape[-1]
    n = l_ // GLA_CHUNK

    def chunks(a):
        return a.reshape(b_, n, GLA_CHUNK, h_, a.shape[-1]).transpose(1, 0, 3, 2, 4)

    qc, kc, vc, gc = chunks(q), chunks(k), chunks(v), chunks(g)
    cum = jnp.cumsum(gc, axis=3)
    cum_last = cum[:, :, :, -1:, :]
    cum_mid = cum[:, :, :, GLA_CHUNK // 2 - 1:GLA_CHUNK // 2, :]
    a = jnp.einsum('nbhid,nbhjd->nbhij', qc * jnp.exp(cum - cum_mid), kc * jnp.exp(cum_mid - cum))
    mask = jnp.tril(jnp.ones((GLA_CHUNK, GLA_CHUNK), dtype=bool))
    o_intra = jnp.einsum('nbhij,nbhje->nbhie', jnp.where(mask, a, 0.0), vc)
    q_inter = qc * jnp.exp(cum)
    k_carry = kc * jnp.exp(cum_last - cum)
    decay = jnp.exp(cum_last[:, :, :, 0, :])

    def step(state, xs):
        qi, ki, vi, di = xs
        o = jnp.einsum('bhcd,bhde->bhce', qi, state)
        state = state * di[..., None] + jnp.einsum('bhcd,bhce->bhde', ki, vi)
        return state, o

    state_final, o_inter = lax.scan(step, state0, (q_inter, k_carry, vc, decay))
    o = (o_intra + o_inter).transpose(1, 0, 3, 2, 4).reshape(b_, l_, h_, dv)
    return o, state_final


def gla_mixer(h_lat, h_ctx, w_in, wg_f, bg_f, wg_b, bg_b, out_norm, w_out, ctx_out):
    def project(h):
        b_, l_, _ = h.shape
        q, k, v, r, zf, zb = jnp.split(h @ w_in, GLA_SPLITS, axis=-1)
        heads = lambda a, d: a.astype(jnp.float32).reshape(b_, l_, GLA_HEADS, d)
        gate = lambda z, w, bias: (jax.nn.log_sigmoid((z @ w + bias).astype(jnp.float32)) / GLA_TAU
                                   ).reshape(b_, l_, GLA_HEADS, GLA_DK)
        return (heads(q, GLA_DK) * GLA_DK ** -0.5, heads(k, GLA_DK), heads(v, GLA_DV), r,
                gate(zf, wg_f, bg_f), gate(zb, wg_b, bg_b))

    flip = lambda a: a[:, ::-1]

    def bidir(q, k, v, gf, gb, s_f, s_b):
        o_f, s_f = gla_chunked(q, k, v, gf, s_f)
        o_b, s_b = gla_chunked(flip(q), flip(k), flip(v), flip(gb), s_b)
        return o_f + flip(o_b), s_f, s_b

    def finish(o, r):
        b_, l_ = r.shape[:2]
        o = rms_norm(o, out_norm).reshape(b_, l_, D_MODEL).astype(r.dtype)
        return (o * jax.nn.silu(r)) @ w_out

    qc, kc, vc, rc, gcf, gcb = project(h_ctx)
    zero = jnp.zeros((h_ctx.shape[0], GLA_HEADS, GLA_DK, GLA_DV), jnp.float32)
    o_c, s_f, s_b = bidir(qc, kc, vc, gcf, gcb, zero, zero)
    ql, kl, vl, rl, glf, glb = project(h_lat)
    o_l, _, _ = bidir(ql, kl, vl, glf, glb, s_f, s_b)
    y_ctx = finish(o_c, rc) if ctx_out else None
    return finish(o_l, rl), y_ctx


def gqa_attend(q, k, v):
    s = jnp.einsum('bqhgd,bkhd->bhgqk', q, k).astype(jnp.float32) * HEAD_DIM ** -0.5
    p = jax.nn.softmax(s, axis=-1).astype(v.dtype)
    return jnp.einsum('bhgqk,bkhd->bqhgd', p, v)


def gqa_mixer(h_lat, h_ctx, w_in, q_norm, k_norm, w_out, ctx_out):
    b_, s_, _ = h_lat.shape

    def project(h):
        l_ = h.shape[1]
        q, k, v = jnp.split(h @ w_in, (GQA_HEADS * HEAD_DIM, (GQA_HEADS + GQA_KV_HEADS) * HEAD_DIM), axis=-1)
        q = rms_norm(q.reshape(b_, l_, GQA_HEADS, HEAD_DIM), q_norm)
        k = rms_norm(k.reshape(b_, l_, GQA_KV_HEADS, HEAD_DIM), k_norm)
        return q, k, v.reshape(b_, l_, GQA_KV_HEADS, HEAD_DIM)

    group = lambda q: q.reshape(b_, q.shape[1], GQA_KV_HEADS, GQA_GROUP, HEAD_DIM)
    q_c, k_c, v_c = project(h_ctx)
    q_l, k_l, v_l = project(h_lat)
    cos, sin = axial_rope_tables(s_, HEAD_DIM, q_l.dtype)
    q_l, k_l = apply_axial_rope(q_l, cos, sin), apply_axial_rope(k_l, cos, sin)
    k_all = jnp.concatenate([k_c, k_l], axis=1)
    v_all = jnp.concatenate([v_c, v_l], axis=1)
    o_l = sweep_query_blocks(lambda qb: gqa_attend(qb, k_all, v_all), group(q_l))
    y_lat = o_l.reshape(b_, s_, D_MODEL) @ w_out
    y_ctx = None
    if ctx_out:
        y_ctx = gqa_attend(group(q_c), k_c, v_c).reshape(b_, q_c.shape[1], D_MODEL) @ w_out
    return y_lat, y_ctx


def diff_attend(q, k, v, lam):
    s = jnp.einsum('bqhmd,bkhmd->bhmqk', q, k).astype(jnp.float32) * DIFF_DH ** -0.5
    p = jax.nn.softmax(s, axis=-1)
    w = (p[:, :, 0] - lam * p[:, :, 1]).astype(v.dtype)
    return jnp.einsum('bhqk,bkhe->bqhe', w, v)


def diff_mixer(h_lat, h_ctx, w_in, q_norm, k_norm, lq1, lk1, lq2, lk2, out_norm, w_out, layer_idx, ctx_out):
    b_, s_, _ = h_lat.shape
    lam_init = 0.8 - 0.6 * math.exp(-0.3 * layer_idx)
    f32 = jnp.float32
    lam = (jnp.exp(jnp.sum(lq1.astype(f32) * lk1.astype(f32)))
           - jnp.exp(jnp.sum(lq2.astype(f32) * lk2.astype(f32))) + lam_init)

    def project(h):
        l_ = h.shape[1]
        q, k, v = jnp.split(h @ w_in, (D_MODEL, 2 * D_MODEL), axis=-1)
        q = rms_norm(q.reshape(b_, l_, 2 * DIFF_HEADS, DIFF_DH), q_norm)
        k = rms_norm(k.reshape(b_, l_, 2 * DIFF_HEADS, DIFF_DH), k_norm)
        return q, k, v.reshape(b_, l_, DIFF_HEADS, 2 * DIFF_DH)

    pair = lambda a: a.reshape(b_, a.shape[1], DIFF_HEADS, 2, DIFF_DH)

    def finish(o):
        o = rms_norm(o, out_norm) * (1.0 - lam_init)
        return o.reshape(b_, o.shape[1], D_MODEL) @ w_out

    q_c, k_c, v_c = project(h_ctx)
    q_l, k_l, v_l = project(h_lat)
    cos, sin = axial_rope_tables(s_, DIFF_DH, q_l.dtype)
    q_l, k_l = apply_axial_rope(q_l, cos, sin), apply_axial_rope(k_l, cos, sin)
    k_all = pair(jnp.concatenate([k_c, k_l], axis=1))
    v_all = jnp.concatenate([v_c, v_l], axis=1)
    o_l = sweep_query_blocks(lambda qb: diff_attend(qb, k_all, v_all, lam), pair(q_l))
    y_ctx = finish(diff_attend(pair(q_c), pair(k_c), v_c, lam)) if ctx_out else None
    return finish(o_l), y_ctx


def fnet_mixer(h, w_out):
    b_, l_, _ = h.shape
    hg = h.astype(jnp.float32).reshape(b_, l_, FNET_GROUPS, FNET_GROUP_DIM)
    y = jnp.real(jnp.fft.fftn(hg, axes=(1, 3), norm="ortho"))
    return y.reshape(b_, l_, D_MODEL).astype(h.dtype) @ w_out


def setup_inputs(seed: int = 0) -> dict:
    key = jax.random.key(seed)
    counter = [0]

    def nxt():
        counter[0] += 1
        return jax.random.fold_in(key, counter[0])

    normal = lambda shape: jax.random.normal(nxt(), shape, jnp.float32)
    dense = lambda shape, s=1.0: normal(shape) * (s * shape[0] ** -0.5)
    gain = lambda n: 1.0 + 0.02 * normal((n,))
    small = lambda n, s=0.02: s * normal((n,))

    p = {
        "x": normal((BATCH, SEQ, D_MODEL)),
        "c": normal((BATCH, D_MODEL)),
        "ctx": normal((BATCH, CTX_LEN, D_MODEL)),
        "c_ctx": normal((D_MODEL,)),
    }
    for i in range(DEPTH):
        kind = i % N_MIXERS
        pre = f"l{i}_"
        p[pre + "mod_w"] = dense((D_MODEL, 6 * D_MODEL), 0.5)
        p[pre + "mod_b"] = small(6 * D_MODEL)
        p[pre + "norm1"] = gain(D_MODEL)
        if kind == MIXER_GLA:
            p[pre + "gla_w_in"] = dense((D_MODEL, GLA_IN_DIM))
            p[pre + "gla_wg_f"] = dense((GLA_RANK, GLA_QK))
            p[pre + "gla_bg_f"] = small(GLA_QK, 0.1)
            p[pre + "gla_wg_b"] = dense((GLA_RANK, GLA_QK))
            p[pre + "gla_bg_b"] = small(GLA_QK, 0.1)
            p[pre + "gla_out_norm"] = gain(GLA_DV)
            p[pre + "gla_w_out"] = dense((D_MODEL, D_MODEL))
        elif kind == MIXER_GQA:
            p[pre + "gqa_w_in"] = dense((D_MODEL, GQA_IN_DIM))
            p[pre + "gqa_q_norm"] = gain(HEAD_DIM)
            p[pre + "gqa_k_norm"] = gain(HEAD_DIM)
            p[pre + "gqa_w_out"] = dense((D_MODEL, D_MODEL))
        elif kind == MIXER_DIFF:
            p[pre + "diff_w_in"] = dense((D_MODEL, DIFF_IN_DIM))
            p[pre + "diff_q_norm"] = gain(DIFF_DH)
            p[pre + "diff_k_norm"] = gain(DIFF_DH)
            p[pre + "diff_lq1"] = small(DIFF_DH, 0.1)
            p[pre + "diff_lk1"] = small(DIFF_DH, 0.1)
            p[pre + "diff_lq2"] = small(DIFF_DH, 0.1)
            p[pre + "diff_lk2"] = small(DIFF_DH, 0.1)
            p[pre + "diff_out_norm"] = gain(2 * DIFF_DH)
            p[pre + "diff_w_out"] = dense((D_MODEL, D_MODEL))
        else:
            p[pre + "fnet_w_out"] = dense((D_MODEL, D_MODEL))
        p[pre + "norm2"] = gain(D_MODEL)
        p[pre + "ffn_w_in"] = dense((D_MODEL, 2 * FFN_HIDDEN))
        p[pre + "ffn_w_out"] = dense((FFN_HIDDEN, D_MODEL))
    return p


def reference(x, c, ctx, c_ctx,
              l0_mod_w, l0_mod_b, l0_norm1, l0_gla_w_in, l0_gla_wg_f, l0_gla_bg_f, l0_gla_wg_b, l0_gla_bg_b,
              l0_gla_out_norm, l0_gla_w_out, l0_norm2, l0_ffn_w_in, l0_ffn_w_out,
              l1_mod_w, l1_mod_b, l1_norm1, l1_gqa_w_in, l1_gqa_q_norm, l1_gqa_k_norm, l1_gqa_w_out,
              l1_norm2, l1_ffn_w_in, l1_ffn_w_out,
              l2_mod_w, l2_mod_b, l2_norm1, l2_diff_w_in, l2_diff_q_norm, l2_diff_k_norm, l2_diff_lq1, l2_diff_lk1,
              l2_diff_lq2, l2_diff_lk2, l2_diff_out_norm, l2_diff_w_out, l2_norm2, l2_ffn_w_in, l2_ffn_w_out,
              l3_mod_w, l3_mod_b, l3_norm1, l3_fnet_w_out, l3_norm2, l3_ffn_w_in, l3_ffn_w_out):
    common = [
        (l0_mod_w, l0_mod_b, l0_norm1, l0_norm2, l0_ffn_w_in, l0_ffn_w_out),
        (l1_mod_w, l1_mod_b, l1_norm1, l1_norm2, l1_ffn_w_in, l1_ffn_w_out),
        (l2_mod_w, l2_mod_b, l2_norm1, l2_norm2, l2_ffn_w_in, l2_ffn_w_out),
        (l3_mod_w, l3_mod_b, l3_norm1, l3_norm2, l3_ffn_w_in, l3_ffn_w_out),
    ]
    mixer_params = [
        (l0_gla_w_in, l0_gla_wg_f, l0_gla_bg_f, l0_gla_wg_b, l0_gla_bg_b, l0_gla_out_norm, l0_gla_w_out),
        (l1_gqa_w_in, l1_gqa_q_norm, l1_gqa_k_norm, l1_gqa_w_out),
        (l2_diff_w_in, l2_diff_q_norm, l2_diff_k_norm, l2_diff_lq1, l2_diff_lk1, l2_diff_lq2, l2_diff_lk2,
         l2_diff_out_norm, l2_diff_w_out),
        (l3_fnet_w_out,),
    ]
    x_lat, x_ctx = x, ctx
    s_lat = jax.nn.silu(c)
    s_ctx = jax.nn.silu(c_ctx)
    for i in range(DEPTH):
        kind = i % N_MIXERS
        mod_w, mod_b, n1, n2, f_in, f_out = common[i]
        mp = mixer_params[i]
        ctx_out = any((j % N_MIXERS) != MIXER_FOURIER for j in range(i + 1, DEPTH))
        ctx_in = ctx_out or kind != MIXER_FOURIER
        sh1, sc1, g1, sh2, sc2, g2 = jnp.split((s_lat @ mod_w + mod_b)[:, None, :], 6, axis=-1)
        h_lat = modulate(rms_norm(x_lat, n1), sh1, sc1)
        h_ctx = None
        if ctx_in:
            csh1, csc1, cg1, csh2, csc2, cg2 = jnp.split(s_ctx @ mod_w + mod_b, 6, axis=-1)
            h_ctx = modulate(rms_norm(x_ctx, n1), csh1, csc1)
        if kind == MIXER_GLA:
            y_lat, y_ctx = gla_mixer(h_lat, h_ctx, *mp, ctx_out=ctx_out)
        elif kind == MIXER_GQA:
            y_lat, y_ctx = gqa_mixer(h_lat, h_ctx, *mp, ctx_out=ctx_out)
        elif kind == MIXER_DIFF:
            y_lat, y_ctx = diff_mixer(h_lat, h_ctx, *mp, layer_idx=i, ctx_out=ctx_out)
        else:
            y_lat = fnet_mixer(h_lat, mp[0])
            y_ctx = fnet_mixer(h_ctx, mp[0]) if ctx_out else None
        x_lat = x_lat + g1 * y_lat
        x_lat = x_lat + g2 * swiglu(modulate(rms_norm(x_lat, n2), sh2, sc2), f_in, f_out)
        if ctx_out:
            x_ctx = x_ctx + cg1 * y_ctx
            x_ctx = x_ctx + cg2 * swiglu(modulate(rms_norm(x_ctx, n2), csh2, csc2), f_in, f_out)
    return x_lat
```

```cpp
#include <hip/hip_runtime.h>
#include <cstdio>
#include <cstdint>

#define LAS __attribute__((address_space(3)))
typedef unsigned short bf16_t;
typedef short bf16x8 __attribute__((ext_vector_type(8)));
typedef short s16x4 __attribute__((ext_vector_type(4)));
typedef float f32x4 __attribute__((ext_vector_type(4)));
typedef float f32x2 __attribute__((ext_vector_type(2)));
typedef float f32x16 __attribute__((ext_vector_type(16)));
typedef unsigned u32x4 __attribute__((ext_vector_type(4)));
typedef unsigned u32x2 __attribute__((ext_vector_type(2)));

#ifndef N_LAUNCH_MODE
#define N_LAUNCH_MODE 0
#endif

constexpr int NB = 16, SEQ = 2048, DM = 2048, CTXL = 256, TPB = 2304  , NT = NB * TPB, FF = 5632;
constexpr int NLAT = NB * SEQ;
constexpr float NORM_EPS = 1e-6f;

constexpr size_t MiB = 1u << 20;
constexpr size_t WS_CTL = 0, CTL_ZERO_BYTES = 1 * MiB;
constexpr size_t WS_MODV = 1 * MiB;
constexpr size_t WS_ROPE = 5 * MiB;
constexpr size_t WS_DFT1 = 6 * MiB;
constexpr size_t WS_DFT2 = 7 * MiB;
constexpr size_t WS_W = 24 * MiB;
constexpr size_t W_FFN1 = WS_W, W_FFN2 = WS_W + 44 * MiB, W_IN = WS_W + 66 * MiB, W_OUT = WS_W + 91 * MiB;
constexpr size_t WS_XCTX = 128 * MiB;
constexpr size_t WS_HN = 160 * MiB;
constexpr size_t WS_O = 304 * MiB;
constexpr size_t WS_BIG = 448 * MiB;
constexpr size_t WS_GX = 880 * MiB;
constexpr size_t WS_KTT = WS_GX, WS_CMCL = WS_GX + 144 * MiB, WS_Z = WS_GX + 154 * MiB;
constexpr size_t WS_O32 = 1039 * MiB;
constexpr size_t WS_END = 1327 * MiB;

constexpr int RING_BYTES = 131072;
constexpr int LDS_BYTES = 147456;
constexpr int MISC_OFF = LDS_BYTES - 64;

__device__ __forceinline__ unsigned f2bf(float f) { unsigned u = __builtin_bit_cast(unsigned, f); return (u + 0x7fffu + ((u >> 16) & 1u)) >> 16; }
__device__ __forceinline__ unsigned pk2(float lo, float hi) { return f2bf(lo) | (f2bf(hi) << 16); }
__device__ __forceinline__ float bf2f(unsigned short b) { return __builtin_bit_cast(float, ((unsigned)b) << 16); }
__device__ __forceinline__ float bflo(unsigned w) { return __builtin_bit_cast(float, w << 16); }
__device__ __forceinline__ float bfhi(unsigned w) { return __builtin_bit_cast(float, w & 0xffff0000u); }
__device__ __forceinline__ unsigned cvt_pk_bf16(float lo, float hi) { unsigned r; asm volatile("v_cvt_pk_bf16_f32 %0, %1, %2" : "=v"(r) : "v"(lo), "v"(hi)); return r; }
__device__ __forceinline__ float wave_sum(float v) {
#pragma unroll
    for (int o = 1; o < 64; o <<= 1) v += __shfl_xor(v, o);
    return v;
}
__device__ __forceinline__ float siluf(float v) { return v * __builtin_amdgcn_rcpf(1.f + __expf(-v)); }
#define LDS_WAIT() asm volatile("s_waitcnt lgkmcnt(0)" ::: "memory")
#define VM_WAIT() asm volatile("s_waitcnt vmcnt(0)" ::: "memory")

#define XB_TMO      128
#define XB_XCNT(j)  (256  + 64 * (j))
#define XB_XSUB(j)  (1280 + 64 * (j))
#define XB_XGEN(j)  (2304 + 64 * (j))
#define XB_TOP      3328
#define XB_TOPGEN   3392
#define XCD_BAR_WORDS 3456
#define XB_SPIN_CAP (1u << 24)
__device__ __forceinline__ unsigned xb_ld(unsigned* p)              { return __hip_atomic_load(p, __ATOMIC_RELAXED, __HIP_MEMORY_SCOPE_AGENT); }
__device__ __forceinline__ unsigned xb_add(unsigned* p, unsigned v) { return __hip_atomic_fetch_add(p, v, __ATOMIC_RELAXED, __HIP_MEMORY_SCOPE_AGENT); }
__device__ __forceinline__ unsigned xb_xcc_id() { return (unsigned)__builtin_amdgcn_s_getreg((3 << 11) | 20) & 0xFu; }
#define XB_SPIN(cond, bar) do { unsigned _sp = 0; while (cond) { __builtin_amdgcn_s_sleep(1); \
    if ((++_sp & 255u) == 0u) { if (xb_ld(&(bar)[XB_TMO])) break; if (_sp > XB_SPIN_CAP) { atomicAdd(&(bar)[XB_TMO], 1u); break; } } } } while (0)
struct XcdBarrier { unsigned* bar; unsigned x; volatile LAS unsigned* st; };
__device__ __forceinline__ XcdBarrier xcd_barrier_post(unsigned* bar, volatile LAS unsigned* st) {
    XcdBarrier b; b.bar = bar; b.x = xb_xcc_id(); b.st = st;
    if (threadIdx.x == 0) (void)xb_add(&bar[XB_XCNT(b.x)], 1u);
    return b;
}
__device__ __forceinline__ void xcd_barrier_complete(unsigned* bar, unsigned x, unsigned& nloc, unsigned& nx) {
    const unsigned G = gridDim.x * gridDim.y * gridDim.z;
    unsigned sum, cnt, mine, sp = 0u;
    for (;;) {
        sum = 0u; cnt = 0u; mine = 0u;
#pragma unroll
        for (unsigned j = 0; j < 16; ++j) { const unsigned c = xb_ld(&bar[XB_XCNT(j)]); sum += c; cnt += (c > 0u) ? 1u : 0u; mine = (j == x) ? c : mine; }
        if (sum == G) break;
        __builtin_amdgcn_s_sleep(1);
        if ((++sp & 255u) == 0u) { if (xb_ld(&bar[XB_TMO])) break; if (sp > XB_SPIN_CAP) { atomicAdd(&bar[XB_TMO], 1u); break; } }
    }
    nloc = mine > 0u ? mine : 1u; nx = cnt > 0u ? cnt : 1u;
}
__device__ __forceinline__ void xcd_barrier(const XcdBarrier& b) {
    asm volatile("s_waitcnt vmcnt(0)" ::: "memory");
    __syncthreads();
    if (threadIdx.x == 0) {
        unsigned* bar = b.bar;
        __builtin_amdgcn_s_waitcnt(0);
        unsigned nloc = b.st[0], nx = b.st[1];
        if (nloc == 0u) { xcd_barrier_complete(bar, b.x, nloc, nx); b.st[0] = nloc; b.st[1] = nx; }
        const unsigned old = xb_add(&bar[XB_XSUB(b.x)], 1u);
        const unsigned gen = old / nloc;
        if (old + 1u == (gen + 1u) * nloc) {
            __builtin_amdgcn_fence(__ATOMIC_RELEASE, "agent");
            asm volatile("s_waitcnt vmcnt(0)" ::: "memory");
            const unsigned og = xb_add(&bar[XB_TOP], 1u);
            const unsigned tg = og / nx;
            if (og + 1u == (tg + 1u) * nx) xb_add(&bar[XB_TOPGEN], 1u);
            else XB_SPIN(xb_ld(&bar[XB_TOPGEN]) == tg, bar);
            __builtin_amdgcn_fence(__ATOMIC_ACQUIRE, "agent");
            xb_add(&bar[XB_XGEN(b.x)], 1u);
            asm volatile("s_waitcnt vmcnt(0)" ::: "memory");
        } else {
            XB_SPIN(xb_ld(&bar[XB_XGEN(b.x)]) == gen, bar);
            __builtin_amdgcn_fence(__ATOMIC_ACQUIRE, "agent");
            asm volatile("s_waitcnt vmcnt(0)" ::: "memory");
        }
    }
    __syncthreads();
}

namespace pg8 {
constexpr int BM = 256, BK = 64, HALF = 128, HTB = HALF * BK * 2, STAGE_BYTES = 8 * HTB, NXCD = 8, WGM = 8;
__host__ __device__ __forceinline__ int lds_byte(int r, int c) { const int st = (r >> 4) * 2 + (c >> 5), rr = r & 15, cc = c & 31, ob = rr * 64 + cc * 2; return st * 1024 + (ob ^ (((ob >> 9) & 1) << 5)); }
__host__ __device__ __forceinline__ void stage_rc(int b, int& R, int& C) { const int st = b / 1024, sb = b % 1024, swz = sb ^ (((sb >> 9) & 1) << 5); R = (st >> 1) * 16 + swz / 64; C = (st & 1) * 32 + (swz % 64) / 2; }
__host__ __device__ __forceinline__ int perm32(int rho) { const int n = rho >> 4, i = rho & 15; return 8 * (i >> 2) + 4 * n + (i & 3); }

struct Unit { int pm, pn, z; };
struct UOrder {
    int nM, nN, nZ, nwg, G, c;
    __device__ __forceinline__ void init(int nM_, int nN_, int nZ_, int G_, int c_) { nM = nM_; nN = nN_; nZ = nZ_; nwg = nM_ * nN_ * nZ_; G = G_; c = c_; }
    __device__ __forceinline__ bool next(int i, Unit& u) const {
        const long L = (long)i * G + c; if (L >= nwg) return false;
        int wgid = (int)L; { const int q = nwg / NXCD, r = nwg % NXCD, xcd = wgid % NXCD, off = wgid / NXCD; wgid = (xcd < r ? xcd * (q + 1) : r * (q + 1) + (xcd - r) * q) + off; }
        const int per = nM * nN; u.z = wgid / per; const int w2 = wgid - u.z * per;
        const int nig = WGM * nN, gid = w2 / nig, fm = gid * WGM, gsz = (nM - fm) < WGM ? (nM - fm) : WGM;
        u.pm = fm + ((w2 % nig) % gsz); u.pn = (w2 % nig) / gsz; return true;
    }
};

template <class Prob, class Epi>
__device__ __forceinline__ void gemm_phase(LAS unsigned char* lds, const Prob g, const UOrder& S, const Epi& E) {
    const int tid = threadIdx.x, wid = __builtin_amdgcn_readfirstlane(tid >> 6), lane = tid & 63, wr = wid >> 2, wc = wid & 3, fr = lane & 15, fq = lane >> 4;
    const int K = g.K, nt = K / BK;
    unsigned voffA[2], voffB[2];
#pragma unroll
    for (int i = 0; i < 2; ++i) { int R, C; stage_rc(tid * 16 + i * 8192, R, C); const int Rb = Epi::PERM ? ((R & ~31) + perm32(R & 31)) : R;
        voffA[i] = (unsigned)(R * g.lda + C) * 2u; voffB[i] = (unsigned)(Rb * g.ldb + C) * 2u; }
    const size_t kstep = (size_t)(BK * 2);
    const size_t hstepA = (size_t)HALF * g.lda * 2, hstepB = (size_t)HALF * g.ldb * 2;
    const unsigned ldsw = (unsigned)wid * 1024u;
    const int aoff = lds_byte(wr * 64 + fr, fq * 8), boff = lds_byte(wc * 32 + fr, fq * 8);
#define PG8_SA(b, h) (((b) * 2 + (h)) * HTB)
#define PG8_SB(b, h) ((4 + (b) * 2 + (h)) * HTB)
#define PG8_STAGE(bufoff, gbase, voff) do { _Pragma("unroll") for (int _i = 0; _i < 2; ++_i) \
        __builtin_amdgcn_global_load_lds((const unsigned*)((const char*)(gbase) + (voff)[_i]), (LAS unsigned*)(lds + (bufoff) + ldsw + _i * 8192), 16, 0, 0); } while (0)
#define PG8_LDA(dst, b, h) do { _Pragma("unroll") for (int m = 0; m < 4; ++m) _Pragma("unroll") for (int k = 0; k < 2; ++k) dst[m][k] = *(const LAS bf16x8*)(lds + PG8_SA(b, h) + aoff + m * 2048 + k * 1024); } while (0)
#define PG8_LDB(dst, b, h) do { _Pragma("unroll") for (int n = 0; n < 2; ++n) _Pragma("unroll") for (int k = 0; k < 2; ++k) dst[n][k] = *(const LAS bf16x8*)(lds + PG8_SB(b, h) + boff + n * 2048 + k * 1024); } while (0)
#define PG8_MMA(ai, bj, At, Bt) do { __builtin_amdgcn_s_setprio(1); _Pragma("unroll") for (int m = 0; m < 4; ++m) _Pragma("unroll") for (int n = 0; n < 2; ++n) _Pragma("unroll") for (int k = 0; k < 2; ++k) \
        acc[ai][bj][m][n] = __builtin_amdgcn_mfma_f32_16x16x32_bf16(Bt[n][k], At[m][k], acc[ai][bj][m][n], 0, 0, 0); __builtin_amdgcn_s_setprio(0); } while (0)
#define PG8_WAIT_V(n) asm volatile("s_waitcnt vmcnt(" #n ")" ::: "memory")
#define PG8_WAIT_L(n) asm volatile("s_waitcnt lgkmcnt(" #n ")" ::: "memory")
#define PG8_BAR __builtin_amdgcn_s_barrier()
#define PG8_SCHED __builtin_amdgcn_sched_barrier(0)
    Unit cur, nxt; int ui = 0;
    if (!S.next(0, cur)) return;
    f32x4 acc[2][2][4][2];
#pragma unroll
    for (int a = 0; a < 2; ++a)
#pragma unroll
        for (int b = 0; b < 2; ++b)
#pragma unroll
            for (int m = 0; m < 4; ++m)
#pragma unroll
                for (int n = 0; n < 2; ++n) acc[a][b][m][n] = (f32x4){0.f, 0.f, 0.f, 0.f};
    bf16x8 At[4][2], B0[2][2], B1[2][2];
    const char* cA = g.a_tile(cur); const char* cB = g.b_tile(cur);
    PG8_STAGE(PG8_SB(0, 0), cB, voffB); PG8_STAGE(PG8_SB(0, 1), cB + hstepB, voffB); PG8_STAGE(PG8_SA(0, 0), cA, voffA); PG8_STAGE(PG8_SA(0, 1), cA + hstepA, voffA);
    if (wr == 1) PG8_BAR;
    PG8_WAIT_V(2); PG8_BAR;
    PG8_STAGE(PG8_SB(1, 0), cB + kstep, voffB); PG8_STAGE(PG8_SA(1, 0), cA + kstep, voffA); PG8_STAGE(PG8_SB(1, 1), cB + hstepB + kstep, voffB);
    PG8_WAIT_V(6); PG8_BAR;
    for (;;) {
        const bool has_next = S.next(ui + 1, nxt);
        const char* nA = has_next ? g.a_tile(nxt) : cA; const char* nB = has_next ? g.b_tile(nxt) : cB;
        for (int t = 0; t < nt; t += 2) {
            const bool last = (t == nt - 2);
            const char* a1 = cA + (size_t)(t + 1) * kstep;
            const char* a2 = last ? nA : cA + (size_t)(t + 2) * kstep; const char* b2 = last ? nB : cB + (size_t)(t + 2) * kstep;
            const char* a3 = a2 + kstep; const char* b3 = b2 + kstep;
            PG8_LDB(B0, 0, 0); PG8_LDB(B1, 0, 1); PG8_SCHED; PG8_LDA(At, 0, 0); PG8_STAGE(PG8_SA(1, 1), a1 + hstepA, voffA);
            PG8_WAIT_V(8); PG8_WAIT_L(0); PG8_BAR; PG8_MMA(0, 0, At, B0); PG8_MMA(0, 1, At, B1); PG8_BAR; PG8_SCHED;
            PG8_LDA(At, 0, 1); PG8_STAGE(PG8_SB(0, 0), b2, voffB); PG8_STAGE(PG8_SB(0, 1), b2 + hstepB, voffB); PG8_STAGE(PG8_SA(0, 0), a2, voffA);
            PG8_WAIT_V(8); PG8_WAIT_L(0); PG8_BAR; PG8_MMA(1, 0, At, B0); PG8_MMA(1, 1, At, B1); PG8_BAR; PG8_SCHED;
            PG8_LDB(B0, 1, 0); PG8_LDB(B1, 1, 1); PG8_SCHED; PG8_LDA(At, 1, 0); PG8_STAGE(PG8_SA(0, 1), a2 + hstepA, voffA);
            PG8_WAIT_V(8); PG8_WAIT_L(0); PG8_BAR; PG8_MMA(0, 0, At, B0); PG8_MMA(0, 1, At, B1); PG8_BAR; PG8_SCHED;
            PG8_LDA(At, 1, 1); PG8_STAGE(PG8_SB(1, 0), b3, voffB); PG8_STAGE(PG8_SB(1, 1), b3 + hstepB, voffB); PG8_STAGE(PG8_SA(1, 0), a3, voffA);
            PG8_WAIT_V(8); PG8_WAIT_L(0); PG8_BAR; PG8_MMA(1, 0, At, B0); PG8_MMA(1, 1, At, B1); PG8_BAR; PG8_SCHED;
        }
        if (wr == 0) PG8_BAR;
        E(acc, cur, wr, wc, fr, fq);
        if (!has_next) break;
#pragma unroll
        for (int a = 0; a < 2; ++a)
#pragma unroll
            for (int b = 0; b < 2; ++b)
#pragma unroll
                for (int m = 0; m < 4; ++m)
#pragma unroll
                    for (int n = 0; n < 2; ++n) acc[a][b][m][n] = (f32x4){0.f, 0.f, 0.f, 0.f};
        cur = nxt; cA = nA; cB = nB; ++ui;
        if (wr == 1) PG8_BAR;
    }
    PG8_WAIT_V(0);
    PG8_BAR;
#undef PG8_SA
#undef PG8_SB
#undef PG8_STAGE
#undef PG8_LDA
#undef PG8_LDB
#undef PG8_MMA
#undef PG8_WAIT_V
#undef PG8_WAIT_L
#undef PG8_BAR
#undef PG8_SCHED
}
}
using pg8::Unit;

__device__ __forceinline__ int row_tile(int pm, int amap) { return amap ? 9 * (pm >> 3) + 1 + (pm & 7) : pm; }

struct ProbStd {
    const bf16_t* A; const bf16_t* Bt; int lda, ldb, K, amap;
    __device__ __forceinline__ const char* a_tile(const Unit& u) const { return (const char*)(A + (size_t)row_tile(u.pm, amap) * 256 * lda); }
    __device__ __forceinline__ const char* b_tile(const Unit& u) const { return (const char*)(Bt + (size_t)u.pn * 256 * ldb); }
};
struct ProbF1 {
    const bf16_t* A; const bf16_t* HN; int lda, ldb, K;
    __device__ __forceinline__ const char* a_tile(const Unit& u) const { return (const char*)(A + (size_t)u.pm * 256 * 512); }
    __device__ __forceinline__ const char* b_tile(const Unit& u) const { return (const char*)(HN + ((size_t)(u.z >> 2) * TPB + CTXL + (size_t)u.pn * 256) * DM + (u.z & 3) * 512); }
};
struct ProbF2 {
    const bf16_t* A; const bf16_t* UVT; int lda, ldb, K;
    __device__ __forceinline__ const char* a_tile(const Unit& u) const { return (const char*)(A + (size_t)u.pm * 256 * 4096); }
    __device__ __forceinline__ const char* b_tile(const Unit& u) const { return (const char*)(UVT + ((size_t)u.z * 2048 + (size_t)u.pn * 256) * 4096); }
};

__device__ __forceinline__ void store_tile_bf16(const f32x4 (&acc)[2][2][4][2], bf16_t* base, size_t ldc, int wr, int wc, int fr, int fq) {
#pragma unroll
    for (int ai = 0; ai < 2; ++ai)
#pragma unroll
        for (int m = 0; m < 4; ++m) { bf16_t* rowp = base + (size_t)(ai * 128 + wr * 64 + m * 16 + fr) * ldc + wc * 32 + 8 * fq;
#pragma unroll
            for (int bj = 0; bj < 2; ++bj) { const f32x4 v0 = acc[ai][bj][m][0], v1 = acc[ai][bj][m][1];
                u32x4 w; w.x = cvt_pk_bf16(v0[0], v0[1]); w.y = cvt_pk_bf16(v0[2], v0[3]); w.z = cvt_pk_bf16(v1[0], v1[1]); w.w = cvt_pk_bf16(v1[2], v1[3]);
                *(u32x4*)(rowp + bj * 128) = w; } }
}
struct EpiProj {
    static constexpr bool PERM = true;
    bf16_t* O; int ldc; int zt; float* Z;
    __device__ __forceinline__ void operator()(const f32x4 (&acc)[2][2][4][2], const Unit& u, int wr, int wc, int fr, int fq) const {
        if (u.pn == zt) {
            if (wc == 0) {
#pragma unroll
                for (int ai = 0; ai < 2; ++ai)
#pragma unroll
                    for (int m = 0; m < 4; ++m) { float* zp = Z + (size_t)(u.pm * 256 + ai * 128 + wr * 64 + m * 16 + fr) * 32 + 8 * fq;
                        *(f32x4*)zp = acc[ai][0][m][0]; *(f32x4*)(zp + 4) = acc[ai][0][m][1]; }
            }
            return;
        }
        store_tile_bf16(acc, O + (size_t)u.pm * 256 * ldc + (size_t)u.pn * 256, (size_t)ldc, wr, wc, fr, fq);
    }
};
struct EpiF1 {
    static constexpr bool PERM = true;
    bf16_t* UVT;
    __device__ __forceinline__ void operator()(const f32x4 (&acc)[2][2][4][2], const Unit& u, int wr, int wc, int fr, int fq) const {
        bf16_t* base = UVT + ((size_t)(u.z >> 2) * 2048 + (u.z & 3) * 512 + (u.pm & 1) * 256) * 4096 + (size_t)(u.pm >> 1) * 2048 + (size_t)u.pn * 256;
        store_tile_bf16(acc, base, 4096, wr, wc, fr, fq);
    }
};
struct EpiF2 {
    static constexpr bool PERM = true;
    bf16_t* O;
    __device__ __forceinline__ void operator()(const f32x4 (&acc)[2][2][4][2], const Unit& u, int wr, int wc, int fr, int fq) const {
        bf16_t* base = O + ((size_t)u.z * TPB + CTXL + (size_t)u.pm * 256) * DM + (size_t)u.pn * 256;
        store_tile_bf16(acc, base, DM, wr, wc, fr, fq);
    }
};
struct EpiSwiGLU {
    static constexpr bool PERM = true;
    bf16_t* H; int amap;
    __device__ __forceinline__ void operator()(const f32x4 (&acc)[2][2][4][2], const Unit& u, int wr, int wc, int fr, int fq) const {
        bf16_t* base = H + (size_t)row_tile(u.pm, amap) * 256 * FF + (size_t)u.pn * 128 + wc * 32 + 8 * fq;
#pragma unroll
        for (int ai = 0; ai < 2; ++ai)
#pragma unroll
            for (int m = 0; m < 4; ++m) { bf16_t* rowp = base + (size_t)(ai * 128 + wr * 64 + m * 16 + fr) * FF;
                const f32x4 g0 = acc[ai][0][m][0], g1 = acc[ai][0][m][1], u0 = acc[ai][1][m][0], u1 = acc[ai][1][m][1];
                u32x4 w; w.x = cvt_pk_bf16(siluf(g0[0]) * u0[0], siluf(g0[1]) * u0[1]); w.y = cvt_pk_bf16(siluf(g0[2]) * u0[2], siluf(g0[3]) * u0[3]);
                w.z = cvt_pk_bf16(siluf(g1[0]) * u1[0], siluf(g1[1]) * u1[1]); w.w = cvt_pk_bf16(siluf(g1[2]) * u1[2], siluf(g1[3]) * u1[3]);
                *(u32x4*)rowp = w; }
    }
};
struct EpiRes {
    static constexpr bool PERM = false;
    const float* src_lat; const float* src_ctx; float* dst_lat; float* dst_ctx; const float* modv; int goff; int amap;
    __device__ __forceinline__ void operator()(const f32x4 (&acc)[2][2][4][2], const Unit& u, int wr, int wc, int fr, int fq) const {
        const int rt = row_tile(u.pm, amap), b = rt / 9, j = rt - b * 9;
        const float* sb; float* db; const float* gv;
        if (j == 0) { sb = src_ctx + (size_t)b * CTXL * DM; db = dst_ctx + (size_t)b * CTXL * DM; gv = modv + (size_t)16 * 12288 + goff; }
        else { sb = src_lat + ((size_t)b * SEQ + (size_t)(j - 1) * 256) * DM; db = dst_lat + ((size_t)b * SEQ + (size_t)(j - 1) * 256) * DM; gv = modv + (size_t)b * 12288 + goff; }
        const int col0 = u.pn * 256 + wc * 32 + 4 * fq;
        f32x4 gt[2][2];
#pragma unroll
        for (int bj = 0; bj < 2; ++bj)
#pragma unroll
            for (int n = 0; n < 2; ++n) gt[bj][n] = *(const f32x4*)(gv + col0 + bj * 128 + n * 16);
#pragma unroll
        for (int ai = 0; ai < 2; ++ai)
#pragma unroll
            for (int m = 0; m < 4; ++m) { const size_t off = (size_t)(ai * 128 + wr * 64 + m * 16 + fr) * DM + col0;
#pragma unroll
                for (int bj = 0; bj < 2; ++bj)
#pragma unroll
                    for (int n = 0; n < 2; ++n) { const f32x4 xs = *(const f32x4*)(sb + off + bj * 128 + n * 16);
                        *(f32x4*)(db + off + bj * 128 + n * 16) = xs + gt[bj][n] * acc[ai][bj][m][n]; }
                asm volatile("" ::: "memory"); }
    }
};

struct KArgs { const float* in[49]; float* out; unsigned char* ws; int ph_lo, ph_hi; };
__device__ __forceinline__ int idx_modw(int L) { return L == 0 ? 4 : L == 1 ? 17 : L == 2 ? 27 : 42; }
__device__ __forceinline__ int idx_norm2(int L) { return L == 0 ? 14 : L == 1 ? 24 : L == 2 ? 39 : 46; }

__device__ __forceinline__ void ph_prologue(const KArgs& a, LAS unsigned char* lds, int G, int bid) {
    const int tid = threadIdx.x, lane = tid & 63, wave = __builtin_amdgcn_readfirstlane(tid >> 6);
    LAS float* sl = (LAS float*)lds;
    LAS float* red = (LAS float*)(lds + 139264);
    float* modv = (float*)(a.ws + WS_MODV);
    {
        const float* c = a.in[1]; const float* cc = a.in[3];
        for (int i = tid; i < 17 * 2048; i += 512) { const float v = i < 16 * 2048 ? c[i] : cc[i - 16 * 2048]; sl[i] = v / (1.f + __expf(-v)); }
    }
    __syncthreads();
    for (int u = bid; u < 768; u += G) {
        const int L = u / 192, n0 = (u % 192) * 64;
        const float* W = a.in[idx_modw(L)]; const float* bias = a.in[idx_modw(L) + 1];
        float acc[17];
#pragma unroll
        for (int r = 0; r < 17; ++r) acc[r] = 0.f;
        const int k0 = wave * 256;
#pragma unroll 2
        for (int k = k0; k < k0 + 256; k += 4) {
            const float w0 = W[(size_t)(k + 0) * 12288 + n0 + lane], w1 = W[(size_t)(k + 1) * 12288 + n0 + lane];
            const float w2 = W[(size_t)(k + 2) * 12288 + n0 + lane], w3 = W[(size_t)(k + 3) * 12288 + n0 + lane];
#pragma unroll
            for (int r = 0; r < 17; ++r) { const f32x4 s4 = *(const LAS f32x4*)(sl + r * 2048 + k); acc[r] += s4.x * w0 + s4.y * w1 + s4.z * w2 + s4.w * w3; }
        }
        for (int w = 0; w < 8; ++w) {
            if (wave == w) {
#pragma unroll
                for (int r = 0; r < 17; ++r) red[r * 64 + lane] = (w == 0 ? 0.f : red[r * 64 + lane]) + acc[r];
            }
            __syncthreads();
        }
        for (int i = tid; i < 17 * 64; i += 512) { const int r = i >> 6, l = i & 63; modv[((size_t)L * 17 + r) * 12288 + n0 + l] = red[i] + bias[n0 + l]; }
        __syncthreads();
    }
    const size_t gt = (size_t)bid * 512 + tid, GT = (size_t)G * 512;
    {
        f32x2* rope = (f32x2*)(a.ws + WS_ROPE);
        for (size_t e = gt; e < 2048 * 64; e += GT) {
            const int p = (int)(e >> 6), i = (int)(e & 63), f = i & 31;
            const float inv = exp2f(-(float)(2 * f) * (13.287712379549449f / 64.f));
            const float ang = (float)(i < 32 ? (p >> 6) : (p & 63)) * inv;
            const float kf = rintf(ang * 0.15915494309189535f);
            float r = fmaf(-kf, 6.28318548202514648f, ang); r = fmaf(-kf, -1.7484556000744883e-7f, r);
            rope[e] = (f32x2){cosf(r), sinf(r)};
        }
    }
    {
        bf16_t* d1 = (bf16_t*)(a.ws + WS_DFT1);
        for (size_t e = gt; e < 1024 * 512; e += GT) {
            const int m = (int)(e >> 9), k = (int)(e & 511), part = m >> 9, cp = m & 511;
            const int rr = (k * cp) & 511; const float ang = (float)rr * (6.283185307179586f / 512.f);
            const float v = (part ? sinf(ang) : cosf(ang)) * 0.044194173824159216f;
            d1[e] = (bf16_t)f2bf(v);
        }
        bf16_t* d2 = (bf16_t*)(a.ws + WS_DFT2);
        for (size_t e = gt; e < (size_t)2048 * 4096; e += GT) {
            const int lp = (int)(e >> 12), k = (int)(e & 4095), part = k >> 11, l = k & 2047;
            const int rr = (l * lp) & 2047; const float ang = (float)rr * (6.283185307179586f / 2048.f);
            const float v = (part ? -sinf(ang) : cosf(ang)) * 0.022097086912079608f;
            d2[e] = (bf16_t)f2bf(v);
        }
    }
}

__device__ __forceinline__ void transpose_item(const float* W, int K, int N, bf16_t* WT, int mode, LAS float* scr, int item, int lane) {
    const int nblk = N / 32, kb = item / nblk, nb = item % nblk, k0 = 64 * kb, n0 = 32 * nb;
#pragma unroll 8
    for (int i = 0; i < 32; ++i) { const int kk = 2 * i + (lane >> 5); scr[kk * 33 + (lane & 31)] = W[(size_t)(k0 + kk) * N + n0 + (lane & 31)]; }
    LDS_WAIT(); asm volatile("" ::: "memory");
    const int c = lane & 7;
#pragma unroll
    for (int j = 0; j < 4; ++j) { const int n = (lane >> 3) + 8 * j; const LAS float* s = scr + (8 * c) * 33 + n;
        u32x4 o; o.x = pk2(s[0 * 33], s[1 * 33]); o.y = pk2(s[2 * 33], s[3 * 33]); o.z = pk2(s[4 * 33], s[5 * 33]); o.w = pk2(s[6 * 33], s[7 * 33]);
        int drow = n0 + n;
        if (mode == 1) { const int part = drow >= FF ? 1 : 0, hid = drow - part * FF; drow = 256 * (hid >> 7) + 128 * part + (hid & 127); }
        *(u32x4*)(WT + (size_t)drow * K + k0 + 8 * c) = o; }
    LDS_WAIT(); asm volatile("" ::: "memory");
}
__device__ __forceinline__ void convert_layer(const KArgs& a, LAS unsigned char* lds, int G, int bid, const float* f_in, const float* f_out, const float* wi, int Nin, const float* wo) {
    const int tid = threadIdx.x, lane = tid & 63, wave = __builtin_amdgcn_readfirstlane(tid >> 6);
    LAS float* scr = (LAS float*)(lds + wave * 16384);
    const int gw = bid * 8 + wave, NGW = G * 8;
    const int I1 = (DM / 64) * (2 * FF / 32), I2 = (FF / 64) * (DM / 32), I3 = wi ? (DM / 64) * (Nin / 32) : 0, I4 = (DM / 64) * (DM / 32);
    const int NI = I1 + I2 + I3 + I4;
    for (int it = gw; it < NI; it += NGW) {
        int r = it;
        if (r < I1) { transpose_item(f_in, DM, 2 * FF, (bf16_t*)(a.ws + W_FFN1), 1, scr, r, lane); continue; } r -= I1;
        if (r < I2) { transpose_item(f_out, FF, DM, (bf16_t*)(a.ws + W_FFN2), 0, scr, r, lane); continue; } r -= I2;
        if (r < I3) { transpose_item(wi, DM, Nin, (bf16_t*)(a.ws + W_IN), 0, scr, r, lane); continue; } r -= I3;
        transpose_item(wo, DM, DM, (bf16_t*)(a.ws + W_OUT), 0, scr, r, lane);
    }
}

__device__ __forceinline__ const float* row_src(const float* lat, const float* ctx, int r) {
    const int b = r / TPB, t = r - b * TPB;
    return t < CTXL ? ctx + ((size_t)b * CTXL + t) * DM : lat + ((size_t)b * SEQ + (t - CTXL)) * DM;
}
__device__ __forceinline__ void norm_phase(const float* lat, const float* ctx, const float* gain, const float* modvL, int shoff, int scoff, bf16_t* HN, int lat_only, int G, int bid) {
    const int tid = threadIdx.x, lane = tid & 63, wave = __builtin_amdgcn_readfirstlane(tid >> 6);
    const int nunits = lat_only ? NLAT / 16 : NT / 16;
    for (int u = bid; u < nunits; u += G) {
        int r0;
        if (lat_only) { const int lr = u * 16, b = lr / SEQ; r0 = b * TPB + CTXL + (lr - b * SEQ); } else r0 = u * 16;
#pragma unroll
        for (int rr = 0; rr < 2; ++rr) {
            const int r = r0 + wave * 2 + rr;
            const int b = r / TPB, t = r - b * TPB;
            const float* xr = row_src(lat, ctx, r);
            const float* mv = modvL + (size_t)(t < CTXL ? 16 : b) * 12288;
            f32x4 v[8]; float ss = 0.f;
#pragma unroll
            for (int j = 0; j < 8; ++j) { v[j] = *(const f32x4*)(xr + 4 * lane + 256 * j); ss += (v[j].x * v[j].x + v[j].y * v[j].y) + (v[j].z * v[j].z + v[j].w * v[j].w); }
            const float rstd = 1.0f / sqrtf(wave_sum(ss) * (1.f / DM) + NORM_EPS);
            bf16_t* orow = HN + (size_t)r * DM;
#pragma unroll
            for (int j = 0; j < 8; ++j) {
                const int c = 4 * lane + 256 * j;
                const f32x4 g = *(const f32x4*)(gain + c), sc = *(const f32x4*)(mv + scoff + c), sh = *(const f32x4*)(mv + shoff + c);
                const f32x4 o = v[j] * rstd * g * (1.f + sc) + sh;
                u32x2 w; w.x = cvt_pk_bf16(o.x, o.y); w.y = cvt_pk_bf16(o.z, o.w);
                *(u32x2*)(orow + c) = w;
            }
        }
    }
}

__device__ __forceinline__ void qknorm_rope_phase(bf16_t* P, int ld, int nh, const float* qn, const float* kn, const f32x2* rope, int G, int bid) {
    const int tid = threadIdx.x, lane = tid & 63, wave = __builtin_amdgcn_readfirstlane(tid >> 6);
    const int nq = nh >> 2, sub = lane >> 4, li = lane & 15, quarter = li >> 2;
    const long total = (long)NT * nq;
    for (long id = (long)bid * 8 + wave; id < total; id += (long)G * 8) {
        const int r = (int)(id / nq), quad = (int)(id - (long)r * nq), hi = quad * 4 + sub;
        bf16_t* p = P + (size_t)r * ld + hi * 128 + 8 * li;
        const u32x4 w = *(const u32x4*)p;
        float x[8] = {bflo(w.x), bfhi(w.x), bflo(w.y), bfhi(w.y), bflo(w.z), bfhi(w.z), bflo(w.w), bfhi(w.w)};
        float ss = 0.f;
#pragma unroll
        for (int e = 0; e < 8; ++e) ss += x[e] * x[e];
        ss += __shfl_xor(ss, 1); ss += __shfl_xor(ss, 2); ss += __shfl_xor(ss, 4); ss += __shfl_xor(ss, 8);
        const float rstd = 1.0f / sqrtf(ss * (1.f / 128.f) + NORM_EPS);
        const float* gp = (hi < 16 ? qn : kn) + 8 * li;
        const f32x4 g0 = *(const f32x4*)gp, g1 = *(const f32x4*)(gp + 4);
        x[0] *= rstd * g0.x; x[1] *= rstd * g0.y; x[2] *= rstd * g0.z; x[3] *= rstd * g0.w;
        x[4] *= rstd * g1.x; x[5] *= rstd * g1.y; x[6] *= rstd * g1.z; x[7] *= rstd * g1.w;
        const int t = r % TPB;
        if (t >= CTXL) {
            const int pos = t - CTXL;
            const f32x2* rp = rope + (size_t)pos * 64 + (quarter >> 1) * 32 + (li & 3) * 8;
            const float sgn = (quarter & 1) ? 1.f : -1.f;
#pragma unroll
            for (int e = 0; e < 8; ++e) { const f32x2 cs = rp[e]; const float pv = __shfl_xor(x[e], 4); x[e] = x[e] * cs.x + sgn * pv * cs.y; }
        }
        u32x4 o; o.x = cvt_pk_bf16(x[0], x[1]); o.y = cvt_pk_bf16(x[2], x[3]); o.z = cvt_pk_bf16(x[4], x[5]); o.w = cvt_pk_bf16(x[6], x[7]);
        *(u32x4*)p = o;
    }
}

namespace att {
constexpr int D = 128, NW = 8, QBLK = 32, KVBLK = 64;
constexpr float SCALE = 0.088388347648318440f;
constexpr float THR = 8.f;
constexpr size_t SHM_V = KVBLK * D * 2, SHM_K = KVBLK * D * 2, SHM_ATTN = 2 * SHM_V + 2 * SHM_K + NW * 64 * 4;
#define KSWZ(row, colB) ((row) * 256 + ((colB) ^ (((row) & 7) << 4)))
#define SBAR() __builtin_amdgcn_sched_barrier(0)
__device__ __forceinline__ int crow(int r, int hi) { return (r & 3) + 8 * (r >> 2) + 4 * hi; }
__device__ __forceinline__ void partialSM(f32x16& p0, f32x16& p1, float& m_reg, float& mn, float& alpha) {
  constexpr float C = SCALE * 1.4426950408889634f;
  float pmax = p0[0]; for (int r = 1; r < 16; ++r) pmax = fmaxf(pmax, p0[r]); for (int r = 0; r < 16; ++r) pmax = fmaxf(pmax, p1[r]);
  { auto rr = __builtin_amdgcn_permlane32_swap(__float_as_uint(pmax), __float_as_uint(pmax), false, false);
    pmax = fmaxf(__uint_as_float(rr[0]), __uint_as_float(rr[1])); }
  if (__builtin_expect(__all(pmax - m_reg <= THR / SCALE), 1)) { mn = m_reg; alpha = 1.f; }
  else { mn = fmaxf(m_reg, pmax); alpha = __builtin_amdgcn_exp2f((m_reg - mn) * C); m_reg = mn; }
  float mnC = -mn * C;
  for (int r = 0; r < 16; ++r) p0[r] = fmaf(p0[r], C, mnC); for (int r = 0; r < 16; ++r) p1[r] = fmaf(p1[r], C, mnC);
  for (int r = 0; r < 16; ++r) p0[r] = __builtin_amdgcn_exp2f(p0[r]);
}
__device__ __forceinline__ void finishSM(f32x16& p0, f32x16& p1, float alpha, float& l_reg, bf16x8& pa0, bf16x8& pa1, bf16x8& pa2, bf16x8& pa3) {
  for (int r = 0; r < 16; ++r) p1[r] = __builtin_amdgcn_exp2f(p1[r]);
  float ps = 0; for (int r = 0; r < 16; ++r) ps += p0[r]; for (int r = 0; r < 16; ++r) ps += p1[r];
  { auto rr = __builtin_amdgcn_permlane32_swap(__float_as_uint(ps), __float_as_uint(ps), false, false);
    ps = __uint_as_float(rr[0]) + __uint_as_float(rr[1]); }
  l_reg = l_reg * alpha + ps;
#define PK4(P, BASE, OUT) do { unsigned a0 = cvt_pk_bf16(P[BASE + 0], P[BASE + 1]), a1 = cvt_pk_bf16(P[BASE + 2], P[BASE + 3]);   \
    unsigned b0 = cvt_pk_bf16(P[BASE + 4], P[BASE + 5]), b1 = cvt_pk_bf16(P[BASE + 6], P[BASE + 7]);                              \
    auto r0 = __builtin_amdgcn_permlane32_swap(a0, b0, false, false); auto r1 = __builtin_amdgcn_permlane32_swap(a1, b1, false, false); \
    u32x4 w = {r0[0], r1[0], r0[1], r1[1]}; OUT = *reinterpret_cast<bf16x8*>(&w); } while (0)
  PK4(p0, 0, pa0); PK4(p0, 8, pa1); PK4(p1, 0, pa2); PK4(p1, 8, pa3);
#undef PK4
}
__device__ __forceinline__ void qkt(f32x16& p0, f32x16& p1, const bf16_t* Ks, const bf16x8* qr, int r32, int hi) {
  p0 = f32x16{}; p1 = f32x16{};
  for (int d0 = 0; d0 < 8; ++d0) { int cb = (d0 * 16 + hi * 8) * 2;
    bf16x8 b0 = *reinterpret_cast<const bf16x8*>((const char*)Ks + KSWZ(r32, cb));
    bf16x8 b1 = *reinterpret_cast<const bf16x8*>((const char*)Ks + KSWZ(32 + r32, cb));
    p0 = __builtin_amdgcn_mfma_f32_32x32x16_bf16(b0, qr[d0], p0, 0, 0, 0);
    p1 = __builtin_amdgcn_mfma_f32_32x32x16_bf16(b1, qr[d0], p1, 0, 0, 0); }
}
__device__ __forceinline__ int v_st(int k, int c) { const int kk = (k & ~0xC) | ((k & 4) << 1) | ((k & 8) >> 1); return ((kk >> 3) * 4 + (c >> 5)) * 512 + ((kk & 7) * 32 + (c & 31)) * 2; }
__device__ __forceinline__ int v_rd_base(int lane) { return ((lane & 3) << 3) | (((lane >> 2) & 3) << 6) | (((lane >> 4) & 1) << 5) | (((lane >> 5) & 1) << 8); }
constexpr int v_rd_off(int d0, int ks, int half) { return d0 * 512 + ks * 4096 + half * 2048; }
template <int OFF> __device__ __forceinline__ s16x4 tr_read(int vb) {
  s16x4 r; asm volatile("ds_read_b64_tr_b16 %0, %1 offset:%2" : "=&v"(r) : "v"(vb), "i"(OFF) : "memory"); return r;
}
template <int D0> __device__ __forceinline__ void pv_one(f32x16& od, int vb, bf16x8 pa0, bf16x8 pa1, bf16x8 pa2, bf16x8 pa3) {
  const s16x4 l0 = tr_read<v_rd_off(D0, 0, 0)>(vb), h0 = tr_read<v_rd_off(D0, 0, 1)>(vb), l1 = tr_read<v_rd_off(D0, 1, 0)>(vb), h1 = tr_read<v_rd_off(D0, 1, 1)>(vb);
  const s16x4 l2 = tr_read<v_rd_off(D0, 2, 0)>(vb), h2 = tr_read<v_rd_off(D0, 2, 1)>(vb), l3 = tr_read<v_rd_off(D0, 3, 0)>(vb), h3 = tr_read<v_rd_off(D0, 3, 1)>(vb);
  asm volatile("s_waitcnt lgkmcnt(0)" ::: "memory"); SBAR();
#define PK(L, H) (bf16x8){L[0], L[1], L[2], L[3], H[0], H[1], H[2], H[3]}
  od = __builtin_amdgcn_mfma_f32_32x32x16_bf16(pa0, PK(l0, h0), od, 0, 0, 0);
  od = __builtin_amdgcn_mfma_f32_32x32x16_bf16(pa1, PK(l1, h1), od, 0, 0, 0);
  od = __builtin_amdgcn_mfma_f32_32x32x16_bf16(pa2, PK(l2, h2), od, 0, 0, 0);
  od = __builtin_amdgcn_mfma_f32_32x32x16_bf16(pa3, PK(l3, h3), od, 0, 0, 0);
#undef PK
}
__device__ __forceinline__ void pv_d0(f32x16* o, int vb, bf16x8 pa0, bf16x8 pa1, bf16x8 pa2, bf16x8 pa3) {
  pv_one<0>(o[0], vb, pa0, pa1, pa2, pa3); pv_one<1>(o[1], vb, pa0, pa1, pa2, pa3); pv_one<2>(o[2], vb, pa0, pa1, pa2, pa3); pv_one<3>(o[3], vb, pa0, pa1, pa2, pa3);
}
template <int LDQ, int LDK, int LDO>
__device__ __forceinline__ void attn_dense_body(const bf16_t* __restrict__ Qb, const bf16_t* __restrict__ Kh, const bf16_t* __restrict__ Vh,
                                                bf16_t* __restrict__ Ob, int seq, char* lds) {
  const int tid = threadIdx.x, wid = tid >> 6, lane = tid & 63, r32 = lane & 31, hi = lane >> 5;
  bf16_t* V_lds = (bf16_t*)lds; bf16_t* K_lds = (bf16_t*)(lds + 2 * SHM_V);
  float* ws = (float*)(lds + 2 * SHM_V + 2 * SHM_K) + wid * 64; float* li_l = ws; float* al_l = ws + 32;
  float m_reg = -1e30f, l_reg = 0; f32x16 o[4] = {}; bf16x8 qr[8];
  const bf16_t* Qw = Qb + (long)(wid * QBLK + r32) * LDQ + hi * 8;
#pragma unroll
  for (int d0 = 0; d0 < 8; ++d0) qr[d0] = *reinterpret_cast<const bf16x8*>(Qw + d0 * 16);
  const int sr = tid >> 4, sc = (tid & 15) * 8, vst0 = v_st(sr, sc), vst1 = v_st(32 + sr, sc);
  const int vb0 = (int)(uintptr_t)V_lds + v_rd_base(lane);
  struct { bf16x8 vs0, vs1, ks0, ks1; } sr_[2];
  const unsigned goff0 = (unsigned)(sr * LDK + sc) * 2u, goff1 = (unsigned)((32 + sr) * LDK + sc) * 2u;
  const __amdgpu_buffer_rsrc_t rsK = __builtin_amdgcn_make_buffer_rsrc((void*)Kh, (short)0, seq * (LDK * 2), 0x00020000);
  const __amdgpu_buffer_rsrc_t rsV = __builtin_amdgcn_make_buffer_rsrc((void*)Vh, (short)0, seq * (LDK * 2), 0x00020000);
#define SLOAD(i, k0) do { const unsigned so_ = (unsigned)(k0) * (unsigned)(LDK * 2); \
    sr_[i].vs0 = __builtin_bit_cast(bf16x8, __builtin_amdgcn_raw_buffer_load_b128(rsV, goff0, so_, 0)); sr_[i].vs1 = __builtin_bit_cast(bf16x8, __builtin_amdgcn_raw_buffer_load_b128(rsV, goff1, so_, 0)); \
    sr_[i].ks0 = __builtin_bit_cast(bf16x8, __builtin_amdgcn_raw_buffer_load_b128(rsK, goff0, so_, 0)); sr_[i].ks1 = __builtin_bit_cast(bf16x8, __builtin_amdgcn_raw_buffer_load_b128(rsK, goff1, so_, 0)); } while (0)
#define SWRITE(b, i) do { *(bf16x8*)((char*)V_lds + (b) * SHM_V + vst0) = sr_[i].vs0;          \
    *(bf16x8*)((char*)V_lds + (b) * SHM_V + vst1) = sr_[i].vs1; int kc = sc * 2;               \
    *(bf16x8*)((char*)K_lds + (b) * SHM_K + KSWZ(sr, kc)) = sr_[i].ks0;                       \
    *(bf16x8*)((char*)K_lds + (b) * SHM_K + KSWZ(32 + sr, kc)) = sr_[i].ks1; } while (0)
#define SWAIT() asm volatile("s_waitcnt vmcnt(4)" ::: "memory")
#define RESC(a) do { if (__any((a) < 1.f)) { if (hi == 0) al_l[r32] = (a); asm volatile("s_waitcnt lgkmcnt(0)" ::: "memory"); \
    for (int d = 0; d < 4; ++d) for (int r = 0; r < 16; ++r) o[d][r] *= al_l[crow(r, hi)]; } } while (0)
  f32x16 pA0, pA1, pB0, pB1; float mnA, mnB, alA, alB; bf16x8 pa0, pa1, pa2, pa3; const int NTL = seq / KVBLK;
  constexpr int SE = 0, SO = 1;
  SLOAD(SE, 0); asm volatile("s_waitcnt vmcnt(0)" ::: "memory"); SWRITE(0, SE); __syncthreads();
  qkt(pA0, pA1, K_lds, qr, r32, hi); partialSM(pA0, pA1, m_reg, mnA, alA);
  SLOAD(SO, KVBLK); if (2 < NTL) SLOAD(SE, 2 * KVBLK);
  SWAIT(); SWRITE(1, SO); __syncthreads();
  for (int j = 1; j + 1 < NTL; j += 2) {
    SBAR(); qkt(pB0, pB1, (bf16_t*)((char*)K_lds + SHM_K), qr, r32, hi);
    finishSM(pA0, pA1, alA, l_reg, pa0, pa1, pa2, pa3); SBAR();
    SLOAD(SO, (j + 2) * KVBLK); SBAR();
    pv_d0(o, vb0, pa0, pa1, pa2, pa3); partialSM(pB0, pB1, m_reg, mnB, alB);
    __syncthreads(); SWAIT(); SWRITE(0, SE);
    RESC(alB); __syncthreads();
    SBAR(); qkt(pA0, pA1, K_lds, qr, r32, hi);
    finishSM(pB0, pB1, alB, l_reg, pa0, pa1, pa2, pa3); SBAR();
    if (j + 3 < NTL) SLOAD(SE, (j + 3) * KVBLK); SBAR();
    pv_d0(o, vb0 + (int)SHM_V, pa0, pa1, pa2, pa3); partialSM(pA0, pA1, m_reg, mnA, alA);
    __syncthreads(); SWAIT(); SWRITE(1, SO);
    RESC(alA); __syncthreads();
  }
  SBAR(); qkt(pB0, pB1, (bf16_t*)((char*)K_lds + SHM_K), qr, r32, hi);
  finishSM(pA0, pA1, alA, l_reg, pa0, pa1, pa2, pa3); SBAR();
  pv_d0(o, vb0, pa0, pa1, pa2, pa3); partialSM(pB0, pB1, m_reg, mnB, alB);
  __syncthreads(); RESC(alB);
  finishSM(pB0, pB1, alB, l_reg, pa0, pa1, pa2, pa3); SBAR();
  pv_d0(o, vb0 + (int)SHM_V, pa0, pa1, pa2, pa3);
  if (hi == 0) li_l[r32] = l_reg; asm volatile("s_waitcnt lgkmcnt(0)" ::: "memory");
  float rli[16];
#pragma unroll
  for (int r = 0; r < 16; ++r) rli[r] = __builtin_amdgcn_rcpf(li_l[crow(r, hi)]);
  bf16_t* Ow = Ob + (long)(wid * QBLK) * LDO;
#pragma unroll
  for (int r = 0; r < 16; ++r) { int orow = crow(r, hi);
    for (int d0 = 0; d0 < 4; ++d0) Ow[(long)orow * LDO + d0 * 32 + r32] = (bf16_t)f2bf(o[d0][r] * rli[r]); }
  __syncthreads();
#undef SLOAD
#undef SWRITE
#undef SWAIT
#undef RESC
}
}

__device__ __forceinline__ void gqa_attn_phase(const bf16_t* P, bf16_t* O, char* lds, int G, int bid) {
    constexpr int NBIG = 2048, NSMALL = 256;
    for (int L = bid; L < NBIG + NSMALL; L += G) {
        int b, hq, q0, seq;
        if (L < NBIG) { const int xcd = L & 7, j = (L >> 3) & 31, rnd = L >> 8, bk = rnd * 8 + xcd; b = bk >> 2; const int kvh = bk & 3; hq = kvh * 4 + (j >> 3); q0 = CTXL + (j & 7) * 256; seq = TPB; }
        else { const int l2 = L - NBIG; b = l2 >> 4; hq = l2 & 15; q0 = 0; seq = CTXL; }
        const int kvh = hq >> 2;
        const bf16_t* base = P + (size_t)b * TPB * 3072;
        att::attn_dense_body<3072, 3072, 2048>(base + (size_t)q0 * 3072 + hq * 128, base + 2048 + kvh * 128, base + 2560 + kvh * 128,
                                               O + ((size_t)b * TPB + q0) * DM + hq * 128, seq, lds);
    }
}
__device__ __forceinline__ void diff_attn_phase(const bf16_t* P, bf16_t* OD, char* lds, int G, int bid) {
    for (int L = bid; L < 4096; L += G) {
        const int xcd = L & 7, j = (L >> 3) & 31, rnd = L >> 8, bh = rnd * 8 + xcd, b = bh >> 3, h = bh & 7, qb = j & 7, m = (j >> 3) & 1, half = j >> 4;
        const bf16_t* base = P + (size_t)b * TPB * 6144;
        att::attn_dense_body<6144, 6144, 4096>(base + (size_t)(CTXL + qb * 256) * 6144 + (2 * h + m) * 128, base + 2048 + (2 * h + m) * 128, base + 4096 + h * 256 + half * 128,
                                               OD + ((size_t)b * SEQ + qb * 256) * 4096 + (2 * h + m) * 256 + half * 128, TPB, lds);
    }
}
__device__ __forceinline__ void diff_combine_phase(const bf16_t* OD, bf16_t* O, const float* lq1, const float* lk1, const float* lq2, const float* lk2, const float* gain, int G, int bid) {
    const int tid = threadIdx.x, lane = tid & 63, wave = __builtin_amdgcn_readfirstlane(tid >> 6);
    const float lam_init = 0.8f - 0.6f * 0.54881163609402643f;
    const float d1 = wave_sum(lq1[lane] * lk1[lane] + lq1[lane + 64] * lk1[lane + 64]);
    const float d2 = wave_sum(lq2[lane] * lk2[lane] + lq2[lane + 64] * lk2[lane + 64]);
    const float lam = expf(d1) - expf(d2) + lam_init;
    const float oscale = 1.f - lam_init;
    const int sub = lane >> 5, li = lane & 31;
    const f32x4 g0 = *(const f32x4*)(gain + 8 * li), g1 = *(const f32x4*)(gain + 8 * li + 4);
    const long total = (long)NLAT * 4;
    for (long id = (long)bid * 8 + wave; id < total; id += (long)G * 8) {
        const int lr = (int)(id >> 2), h = (int)(id & 3) * 2 + sub;
        const bf16_t* p = OD + (size_t)lr * 4096 + (2 * h) * 256 + 8 * li;
        const u32x4 a = *(const u32x4*)p, c = *(const u32x4*)(p + 256);
        float x[8] = {bflo(a.x) - lam * bflo(c.x), bfhi(a.x) - lam * bfhi(c.x), bflo(a.y) - lam * bflo(c.y), bfhi(a.y) - lam * bfhi(c.y),
                      bflo(a.z) - lam * bflo(c.z), bfhi(a.z) - lam * bfhi(c.z), bflo(a.w) - lam * bflo(c.w), bfhi(a.w) - lam * bfhi(c.w)};
        float ss = 0.f;
#pragma unroll
        for (int e = 0; e < 8; ++e) ss += x[e] * x[e];
        ss += __shfl_xor(ss, 1); ss += __shfl_xor(ss, 2); ss += __shfl_xor(ss, 4); ss += __shfl_xor(ss, 8); ss += __shfl_xor(ss, 16);
        const float rs = oscale / sqrtf(ss * (1.f / 256.f) + NORM_EPS);
        const int b = lr / SEQ, t = lr - b * SEQ;
        bf16_t* op = O + ((size_t)b * TPB + CTXL + t) * DM + h * 256 + 8 * li;
        u32x4 o; o.x = cvt_pk_bf16(x[0] * rs * g0.x, x[1] * rs * g0.y); o.y = cvt_pk_bf16(x[2] * rs * g0.z, x[3] * rs * g0.w);
        o.z = cvt_pk_bf16(x[4] * rs * g1.x, x[5] * rs * g1.y); o.w = cvt_pk_bf16(x[6] * rs * g1.z, x[7] * rs * g1.w);
        *(u32x4*)op = o;
    }
}

__device__ __forceinline__ float logsigmoidf(float x) { return fminf(x, 0.f) - __logf(1.f + __expf(-fabsf(x))); }
constexpr int G1_ZS = 0, G1_HT = 8192, G1_MS = 12288, G1_QS = 21504, G1_KS = 55296, G1_VS = 21504;
template <int DIR>
__device__ __forceinline__ void gla_prep_dir(const bf16_t* P, const float* wg, const float* bg, bf16_t* QT, bf16_t* KTT, float* CM, float* CL, LAS unsigned char* lds,
                                             int b, int h, int c, int R0, f32x4 (&accOut)[2]) {
    const int tid = threadIdx.x, lane = tid & 63, wave = __builtin_amdgcn_readfirstlane(tid >> 6), d = tid & 255, half = tid >> 8;
    LAS float* ZS = (LAS float*)(lds + G1_ZS); LAS float* HT = (LAS float*)(lds + G1_HT);
    LAS bf16_t* QS = (LAS bf16_t*)(lds + G1_QS); LAS bf16_t* KS = (LAS bf16_t*)(lds + G1_KS);
    float wcol[16];
#pragma unroll
    for (int kk = 0; kk < 16; ++kk) wcol[kk] = wg[kk * 1024 + 256 * h + d];
    const float bias = bg[256 * h + d];
    float cum[32];
#pragma unroll
    for (int ii = 0; ii < 32; ++ii) {
        const LAS float* zr = ZS + (half * 32 + ii) * 32 + DIR * 16;
        const f32x4 z0 = *(const LAS f32x4*)zr, z1 = *(const LAS f32x4*)(zr + 4), z2 = *(const LAS f32x4*)(zr + 8), z3 = *(const LAS f32x4*)(zr + 12);
        float x = bias;
        x += z0.x * wcol[0] + z0.y * wcol[1] + z0.z * wcol[2] + z0.w * wcol[3];
        x += z1.x * wcol[4] + z1.y * wcol[5] + z1.z * wcol[6] + z1.w * wcol[7];
        x += z2.x * wcol[8] + z2.y * wcol[9] + z2.z * wcol[10] + z2.w * wcol[11];
        x += z3.x * wcol[12] + z3.y * wcol[13] + z3.z * wcol[14] + z3.w * wcol[15];
        cum[ii] = logsigmoidf(x) * 0.0625f;
    }
    float total;
    if (DIR == 0) {
#pragma unroll
        for (int ii = 1; ii < 32; ++ii) cum[ii] += cum[ii - 1];
        total = cum[31];
    } else {
#pragma unroll
        for (int ii = 30; ii >= 0; --ii) cum[ii] += cum[ii + 1];
        total = cum[0];
    }
    HT[(DIR * 2 + half) * 256 + d] = total;
    __syncthreads();
    const float t0 = HT[(DIR * 2 + 0) * 256 + d], t1 = HT[(DIR * 2 + 1) * 256 + d];
    const float cmid = DIR == 0 ? t0 : t1, clast = t0 + t1;
    const float add = DIR == 0 ? (half == 1 ? t0 : 0.f) : (half == 0 ? t1 : 0.f);
    unsigned kpack[16];
    const bf16_t* qp = P + (size_t)(R0 + half * 32) * 6144 + 256 * h + d;
    bf16_t* qtp = QT + ((size_t)DIR * NT + R0 + half * 32) * 1024 + 256 * h + d;
#pragma unroll
    for (int ii = 0; ii < 32; ++ii) {
        const float cu = cum[ii] + add;
        const float qv = bf2f(qp[(size_t)ii * 6144]), kv = bf2f(qp[(size_t)ii * 6144 + 1024]);
        const unsigned qb = f2bf(qv * 0.0625f * __expf(cu - cmid)), kb = f2bf(kv * __expf(cmid - cu));
        qtp[(size_t)ii * 1024] = (bf16_t)qb;
        QS[(half * 32 + ii) * 264 + d] = (bf16_t)qb; KS[(half * 32 + ii) * 264 + d] = (bf16_t)kb;
        if (ii & 1) kpack[ii >> 1] |= kb << 16; else kpack[ii >> 1] = kb;
        if ((ii & 3) == 3) asm volatile("" ::: "memory");
    }
    {
        bf16_t* kt = KTT + (((((size_t)DIR * NB + b) * 36 + c) * 4 + h) * 256 + d) * 64 + half * 32;
#pragma unroll
        for (int q = 0; q < 4; ++q) *(u32x4*)(kt + 8 * q) = (u32x4){kpack[4 * q], kpack[4 * q + 1], kpack[4 * q + 2], kpack[4 * q + 3]};
    }
    if (half == 0) { const size_t vi = (((size_t)DIR * NB + b) * 36 + c) * 1024 + 256 * h + d; CM[vi] = cmid; CL[vi] = clast; }
    __syncthreads();
    const int ti = wave >> 1, tj0 = (wave & 1) * 2, fr = lane & 15, fq = lane >> 4;
#pragma unroll
    for (int x = 0; x < 2; ++x) {
        f32x4 acc = {0.f, 0.f, 0.f, 0.f};
#pragma unroll
        for (int ks = 0; ks < 8; ++ks) {
            const bf16x8 av = *(const LAS bf16x8*)(QS + (16 * ti + fr) * 264 + 32 * ks + 8 * fq);
            const bf16x8 bv = *(const LAS bf16x8*)(KS + (16 * (tj0 + x) + fr) * 264 + 32 * ks + 8 * fq);
            acc = __builtin_amdgcn_mfma_f32_16x16x32_bf16(av, bv, acc, 0, 0, 0);
        }
        accOut[x] = acc;
    }
    __syncthreads();
}
__device__ __forceinline__ void gla_prep_phase(const bf16_t* P, const float* Z, const float* wgf, const float* bgf, const float* wgb, const float* bgb,
                                               bf16_t* QT, bf16_t* KTT, bf16_t* VT, float* CM, float* CL, float* O32, LAS unsigned char* lds, int G, int bid) {
    const int tid = threadIdx.x, lane = tid & 63, wave = __builtin_amdgcn_readfirstlane(tid >> 6), fr = lane & 15, fq = lane >> 4;
    LAS float* ZS = (LAS float*)(lds + G1_ZS);
    LAS bf16_t* MS = (LAS bf16_t*)(lds + G1_MS);
    LAS bf16_t* VSw = (LAS bf16_t*)(lds + G1_VS) + wave * (64 * 72);
    for (int u = bid; u < NB * 4 * 36; u += G) {
        const int b = u / 144, rem = u - b * 144, h = rem / 36, c = rem - h * 36, R0 = b * TPB + 64 * c;
        { const int row = tid >> 3, c4 = (tid & 7) * 4; *(LAS f32x4*)(ZS + row * 32 + c4) = *(const f32x4*)(Z + (size_t)(R0 + row) * 32 + c4); }
        __syncthreads();
        f32x4 accF[2], accB[2];
        gla_prep_dir<0>(P, wgf, bgf, QT, KTT, CM, CL, lds, b, h, c, R0, accF);
        gla_prep_dir<1>(P, wgb, bgb, QT, KTT, CM, CL, lds, b, h, c, R0, accB);
        const int ti = wave >> 1, tj0 = (wave & 1) * 2;
#pragma unroll
        for (int x = 0; x < 2; ++x)
#pragma unroll
            for (int r = 0; r < 4; ++r) { const int i = 16 * ti + 4 * fq + r, j = 16 * (tj0 + x) + fr;
                const float m = (j <= i ? accF[x][r] : 0.f) + (j >= i ? accB[x][r] : 0.f);
                MS[i * 72 + j] = (bf16_t)f2bf(m); }
#pragma unroll
        for (int it = 0; it < 8; ++it) { const int q = it * 64 + lane, j = q >> 3, ec = (q & 7) * 8;
            const u32x4 w = *(const u32x4*)(P + (size_t)(R0 + j) * 6144 + 2048 + 512 * h + 64 * wave + ec);
            VSw[(ec + 0) * 72 + j] = (bf16_t)(w.x & 0xffff); VSw[(ec + 1) * 72 + j] = (bf16_t)(w.x >> 16);
            VSw[(ec + 2) * 72 + j] = (bf16_t)(w.y & 0xffff); VSw[(ec + 3) * 72 + j] = (bf16_t)(w.y >> 16);
            VSw[(ec + 4) * 72 + j] = (bf16_t)(w.z & 0xffff); VSw[(ec + 5) * 72 + j] = (bf16_t)(w.z >> 16);
            VSw[(ec + 6) * 72 + j] = (bf16_t)(w.w & 0xffff); VSw[(ec + 7) * 72 + j] = (bf16_t)(w.w >> 16); }
        __syncthreads();
        {
            bf16_t* vt = VT + ((((size_t)b * 36 + c) * 4 + h) * 512 + 64 * wave) * 64;
#pragma unroll
            for (int it = 0; it < 8; ++it) { const int q = it * 64 + lane, e = q >> 3, jc = (q & 7) * 8;
                *(u32x4*)(vt + (size_t)e * 64 + jc) = *(const LAS u32x4*)(VSw + e * 72 + jc); }
        }
        f32x4 oacc[4][4];
#pragma unroll
        for (int a = 0; a < 4; ++a)
#pragma unroll
            for (int bb = 0; bb < 4; ++bb) oacc[a][bb] = (f32x4){0.f, 0.f, 0.f, 0.f};
#pragma unroll
        for (int ks = 0; ks < 2; ++ks) {
            bf16x8 av[4], bv[4];
#pragma unroll
            for (int t = 0; t < 4; ++t) { av[t] = *(const LAS bf16x8*)(MS + (16 * t + fr) * 72 + 32 * ks + 8 * fq); bv[t] = *(const LAS bf16x8*)(VSw + (16 * t + fr) * 72 + 32 * ks + 8 * fq); }
#pragma unroll
            for (int a = 0; a < 4; ++a)
#pragma unroll
                for (int bb = 0; bb < 4; ++bb) oacc[a][bb] = __builtin_amdgcn_mfma_f32_16x16x32_bf16(av[a], bv[bb], oacc[a][bb], 0, 0, 0);
        }
#pragma unroll
        for (int a = 0; a < 4; ++a)
#pragma unroll
            for (int r = 0; r < 4; ++r) { float* op = O32 + (size_t)(R0 + 16 * a + 4 * fq + r) * 2048 + 512 * h + 64 * wave + fr;
#pragma unroll
                for (int bb = 0; bb < 4; ++bb) op[16 * bb] = oacc[a][bb][r]; }
        __syncthreads();
    }
}
__device__ __forceinline__ void gla_scan_phase(const bf16_t* QT, const bf16_t* KTT, const bf16_t* VT, const float* CM, const float* CL, float* O32, LAS unsigned char* lds, int G, int bid) {
    const int tid = threadIdx.x, lane = tid & 63, wave = __builtin_amdgcn_readfirstlane(tid >> 6), fr = lane & 15, fq = lane >> 4;
    const int ti = wave >> 1, tj0 = (wave & 1) * 2;
    for (int u = bid; u < 512; u += G) {
        const int b = u >> 5, h = (u >> 3) & 3, sl = u & 7;
        for (int dir = 0; dir < 2; ++dir) {
            f32x4 S[2][4];
#pragma unroll
            for (int t = 0; t < 2; ++t)
#pragma unroll
                for (int uu = 0; uu < 4; ++uu) S[t][uu] = (f32x4){0.f, 0.f, 0.f, 0.f};
            for (int s = 0; s < 36; ++s) {
                const int c = dir == 0 ? s : (s < 4 ? 3 - s : 39 - s);
                const int R0 = b * TPB + 64 * c;
                const size_t vb = (((size_t)dir * NB + b) * 36 + c) * 1024 + 256 * h + 32 * wave + 4 * fq;
                f32x4 cm[2], cl[2];
#pragma unroll
                for (int t = 0; t < 2; ++t) { cm[t] = *(const f32x4*)(CM + vb + 16 * t); cl[t] = *(const f32x4*)(CL + vb + 16 * t); }
                LAS bf16_t* STb = (LAS bf16_t*)lds + (s & 1) * (64 * 264);
#pragma unroll
                for (int t = 0; t < 2; ++t) { const f32x4 e = {__expf(cm[t].x), __expf(cm[t].y), __expf(cm[t].z), __expf(cm[t].w)};
#pragma unroll
                    for (int uu = 0; uu < 4; ++uu) { const f32x4 v = S[t][uu] * e; u32x2 w; w.x = cvt_pk_bf16(v.x, v.y); w.y = cvt_pk_bf16(v.z, v.w);
                        *(LAS u32x2*)(STb + (16 * uu + fr) * 264 + 32 * wave + 16 * t + 4 * fq) = w; } }
                __syncthreads();
                f32x4 oa[2] = {(f32x4){0.f, 0.f, 0.f, 0.f}, (f32x4){0.f, 0.f, 0.f, 0.f}};
                const bf16_t* qrow = QT + ((size_t)dir * NT + R0 + 16 * ti + fr) * 1024 + 256 * h + 8 * fq;
#pragma unroll
                for (int ks = 0; ks < 8; ++ks) { const bf16x8 av = *(const bf16x8*)(qrow + 32 * ks);
#pragma unroll
                    for (int x = 0; x < 2; ++x) { const bf16x8 bv = *(const LAS bf16x8*)(STb + (16 * (tj0 + x) + fr) * 264 + 32 * ks + 8 * fq);
                        oa[x] = __builtin_amdgcn_mfma_f32_16x16x32_bf16(av, bv, oa[x], 0, 0, 0); } }
#pragma unroll
                for (int x = 0; x < 2; ++x)
#pragma unroll
                    for (int r = 0; r < 4; ++r) { float* op = O32 + (size_t)(R0 + 16 * ti + 4 * fq + r) * 2048 + 512 * h + 64 * sl + 16 * (tj0 + x) + fr; *op += oa[x][r]; }
                f32x4 Pm[2][4];
#pragma unroll
                for (int t = 0; t < 2; ++t)
#pragma unroll
                    for (int uu = 0; uu < 4; ++uu) Pm[t][uu] = (f32x4){0.f, 0.f, 0.f, 0.f};
                const bf16_t* kb = KTT + (((((size_t)dir * NB + b) * 36 + c) * 4 + h) * 256 + 32 * wave + fr) * 64 + 8 * fq;
                const bf16_t* vbp = VT + ((((size_t)b * 36 + c) * 4 + h) * 512 + 64 * sl + fr) * 64 + 8 * fq;
#pragma unroll
                for (int ks = 0; ks < 2; ++ks) {
                    bf16x8 av[2], bv[4];
#pragma unroll
                    for (int t = 0; t < 2; ++t) av[t] = *(const bf16x8*)(kb + t * 1024 + 32 * ks);
#pragma unroll
                    for (int uu = 0; uu < 4; ++uu) bv[uu] = *(const bf16x8*)(vbp + uu * 1024 + 32 * ks);
#pragma unroll
                    for (int t = 0; t < 2; ++t)
#pragma unroll
                        for (int uu = 0; uu < 4; ++uu) Pm[t][uu] = __builtin_amdgcn_mfma_f32_16x16x32_bf16(av[t], bv[uu], Pm[t][uu], 0, 0, 0);
                }
#pragma unroll
                for (int t = 0; t < 2; ++t) {
                    const f32x4 dec = {__expf(cl[t].x), __expf(cl[t].y), __expf(cl[t].z), __expf(cl[t].w)};
                    const f32x4 ksc = {__expf(cl[t].x - cm[t].x), __expf(cl[t].y - cm[t].y), __expf(cl[t].z - cm[t].z), __expf(cl[t].w - cm[t].w)};
#pragma unroll
                    for (int uu = 0; uu < 4; ++uu) S[t][uu] = S[t][uu] * dec + Pm[t][uu] * ksc;
                }
            }
            __syncthreads();
        }
    }
}
__device__ __forceinline__ void gla_finish_phase(const float* O32, const bf16_t* P, const float* gain, bf16_t* O, int G, int bid) {
    const int tid = threadIdx.x, lane = tid & 63, wave = __builtin_amdgcn_readfirstlane(tid >> 6);
    const f32x4 g0 = *(const f32x4*)(gain + 8 * lane), g1 = *(const f32x4*)(gain + 8 * lane + 4);
    const long total = (long)NT * 4;
    for (long id = (long)bid * 8 + wave; id < total; id += (long)G * 8) {
        const int r = (int)(id >> 2), h = (int)(id & 3);
        const float* op = O32 + (size_t)r * 2048 + 512 * h + 8 * lane;
        const f32x4 a = *(const f32x4*)op, c = *(const f32x4*)(op + 4);
        const float ss = wave_sum((a.x * a.x + a.y * a.y) + (a.z * a.z + a.w * a.w) + (c.x * c.x + c.y * c.y) + (c.z * c.z + c.w * c.w));
        const float rs = 1.0f / sqrtf(ss * (1.f / 512.f) + NORM_EPS);
        const u32x4 rw = *(const u32x4*)(P + (size_t)r * 6144 + 4096 + 512 * h + 8 * lane);
        u32x4 o;
        o.x = cvt_pk_bf16(a.x * rs * g0.x * siluf(bflo(rw.x)), a.y * rs * g0.y * siluf(bfhi(rw.x)));
        o.y = cvt_pk_bf16(a.z * rs * g0.z * siluf(bflo(rw.y)), a.w * rs * g0.w * siluf(bfhi(rw.y)));
        o.z = cvt_pk_bf16(c.x * rs * g1.x * siluf(bflo(rw.z)), c.y * rs * g1.y * siluf(bfhi(rw.z)));
        o.w = cvt_pk_bf16(c.z * rs * g1.z * siluf(bflo(rw.w)), c.w * rs * g1.w * siluf(bfhi(rw.w)));
        *(u32x4*)(O + (size_t)r * DM + 512 * h + 8 * lane) = o;
    }
}

constexpr int NPH = 34;
template <int L> __device__ __forceinline__ int c_in(int which) {
    constexpr int base = L == 0 ? 4 : L == 1 ? 17 : L == 2 ? 27 : 42;
    constexpr int n2 = L == 0 ? 14 : L == 1 ? 24 : L == 2 ? 39 : 46;
    return which < 3 ? base + which : n2 + (which - 3);
}
__global__ void __launch_bounds__(512, 2) fwd_kernel(KArgs a) {
    extern __shared__ __attribute__((aligned(16))) unsigned char lds_raw[];
    LAS unsigned char* lds = (LAS unsigned char*)lds_raw;
    const int tid = threadIdx.x, G = gridDim.x, bid = blockIdx.x;
    if (tid < 16) ((LAS unsigned*)(lds + MISC_OFF))[tid] = 0u;
    __syncthreads();
    unsigned* barw = (unsigned*)(a.ws + WS_CTL) + 4096;
    XcdBarrier bar; bar.bar = barw; bar.x = 0; bar.st = (volatile LAS unsigned*)(lds + MISC_OFF);
    if (N_LAUNCH_MODE == 1) bar = xcd_barrier_post(barw, (volatile LAS unsigned*)(lds + MISC_OFF));
    const int lo = a.ph_lo, hi = a.ph_hi;
#ifndef PHSEL
#define PHSEL -1
#endif
#define IN(k) ((PHSEL < 0 || PHSEL == (k)) && lo <= (k) && (k) < hi)
#define SEAM(k) do { if (IN(k) && IN((k) + 1)) xcd_barrier(bar); } while (0)

#define p_ws (a.ws)
#define p_modv ((float*)(a.ws + WS_MODV))
#define p_rope ((const f32x2*)(a.ws + WS_ROPE))
#define p_DFT1 ((bf16_t*)(a.ws + WS_DFT1))
#define p_DFT2 ((bf16_t*)(a.ws + WS_DFT2))
#define p_Wf1 ((bf16_t*)(a.ws + W_FFN1))
#define p_Wf2 ((bf16_t*)(a.ws + W_FFN2))
#define p_Win ((bf16_t*)(a.ws + W_IN))
#define p_Wout ((bf16_t*)(a.ws + W_OUT))
#define p_xctx ((float*)(a.ws + WS_XCTX))
#define p_HN ((bf16_t*)(a.ws + WS_HN))
#define p_OB ((bf16_t*)(a.ws + WS_O))
#define p_BIG ((bf16_t*)(a.ws + WS_BIG))
#define p_out (a.out)

#define PH_PREP(k, L, WI, NIN, WO, LATONLY) if (IN(k)) { \
        convert_layer(a, lds, G, bid, a.in[c_in<L>(4)], a.in[c_in<L>(5)], WI, NIN, WO); \
        norm_phase(L == 0 ? a.in[0] : p_out, L == 0 ? a.in[2] : p_xctx, a.in[c_in<L>(2)], p_modv + (size_t)L * 17 * 12288, 0, 2048, p_HN, LATONLY, G, bid); } SEAM(k)
#define PH_PROJ(k, NN, LDC, ZT, ZP) if (IN(k)) { \
        ProbStd g{p_HN, p_Win, DM, DM, DM, 0}; pg8::UOrder S; S.init(144, NN, 1, G, bid); EpiProj E{p_BIG, LDC, ZT, ZP}; \
        pg8::gemm_phase<ProbStd, EpiProj>(lds, g, S, E); } SEAM(k)
#define PH_OUT(k, L, AMAP) if (IN(k)) { \
        ProbStd g{p_OB, p_Wout, DM, DM, DM, AMAP}; pg8::UOrder S; S.init(AMAP ? 128 : 144, 8, 1, G, bid); \
        EpiRes E{L == 0 ? a.in[0] : p_out, L == 0 ? a.in[2] : p_xctx, p_out, p_xctx, p_modv + (size_t)L * 17 * 12288, 4096, AMAP}; \
        pg8::gemm_phase<ProbStd, EpiRes>(lds, g, S, E); } SEAM(k)
#define PH_NORM2(k, L, AMAP) if (IN(k)) { \
        norm_phase(p_out, p_xctx, a.in[c_in<L>(3)], p_modv + (size_t)L * 17 * 12288, 6144, 8192, p_HN, AMAP, G, bid); } SEAM(k)
#define PH_FFN1(k, L, AMAP) if (IN(k)) { \
        ProbStd g{p_HN, p_Wf1, DM, DM, DM, AMAP}; pg8::UOrder S; S.init(AMAP ? 128 : 144, 44, 1, G, bid); EpiSwiGLU E{p_BIG, AMAP}; \
        pg8::gemm_phase<ProbStd, EpiSwiGLU>(lds, g, S, E); } SEAM(k)
#define PH_FFN2(k, L, AMAP) if (IN(k)) { \
        ProbStd g{p_BIG, p_Wf2, FF, FF, FF, AMAP}; pg8::UOrder S; S.init(AMAP ? 128 : 144, 8, 1, G, bid); \
        EpiRes E{p_out, p_xctx, p_out, p_xctx, p_modv + (size_t)L * 17 * 12288, 10240, AMAP}; \
        pg8::gemm_phase<ProbStd, EpiRes>(lds, g, S, E); } SEAM(k)

    if (IN(0)) { ph_prologue(a, lds, G, bid); } SEAM(0);

    PH_PREP(1, 0, a.in[7], 6176, a.in[13], 0);
    PH_PROJ(2, 25, 6144, 24, (float*)(p_ws + WS_Z));
    {
        bf16_t* QT = (bf16_t*)(p_ws + WS_O); bf16_t* KTT = (bf16_t*)(p_ws + WS_KTT); bf16_t* VT = (bf16_t*)(p_ws + WS_HN);
        float* CM = (float*)(p_ws + WS_CMCL); float* CL = CM + (size_t)2 * NB * 36 * 1024; float* O32 = (float*)(p_ws + WS_O32);
        if (IN(3)) { gla_prep_phase(p_BIG, (const float*)(p_ws + WS_Z), a.in[8], a.in[9], a.in[10], a.in[11], QT, KTT, VT, CM, CL, O32, lds, G, bid); } SEAM(3);
        if (IN(4)) { gla_scan_phase(QT, KTT, VT, CM, CL, O32, lds, G, bid); } SEAM(4);
        if (IN(5)) { gla_finish_phase(O32, p_BIG, a.in[12], p_OB, G, bid); } SEAM(5);
    }
    PH_OUT(6, 0, 0);
    PH_NORM2(7, 0, 0);
    PH_FFN1(8, 0, 0);
    PH_FFN2(9, 0, 0);

    PH_PREP(10, 1, a.in[20], 3072, a.in[23], 0);
    PH_PROJ(11, 12, 3072, -1, nullptr);
    if (IN(12)) { qknorm_rope_phase(p_BIG, 3072, 20, a.in[21], a.in[22], p_rope, G, bid); } SEAM(12);
    if (IN(13)) { gqa_attn_phase(p_BIG, p_OB, (char*)lds_raw, G, bid); } SEAM(13);
    PH_OUT(14, 1, 0);
    PH_NORM2(15, 1, 0);
    PH_FFN1(16, 1, 0);
    PH_FFN2(17, 1, 0);

    PH_PREP(18, 2, a.in[30], 6144, a.in[38], 0);
    PH_PROJ(19, 24, 6144, -1, nullptr);
    if (IN(20)) { qknorm_rope_phase(p_BIG, 6144, 32, a.in[31], a.in[32], p_rope, G, bid); } SEAM(20);
    if (IN(21)) { diff_attn_phase(p_BIG, (bf16_t*)(p_ws + WS_GX), (char*)lds_raw, G, bid); } SEAM(21);
    if (IN(22)) { diff_combine_phase((const bf16_t*)(p_ws + WS_GX), p_OB, a.in[33], a.in[34], a.in[35], a.in[36], a.in[37], G, bid); } SEAM(22);
    PH_OUT(23, 2, 1);
    PH_NORM2(24, 2, 1);
    PH_FFN1(25, 2, 1);
    PH_FFN2(26, 2, 1);

    PH_PREP(27, 3, nullptr, 0, a.in[45], 1);
    if (IN(28)) { ProbF1 g{p_DFT1, p_HN, 512, DM, 512}; pg8::UOrder S; S.init(4, 8, 64, G, bid); EpiF1 E{p_BIG}; pg8::gemm_phase<ProbF1, EpiF1>(lds, g, S, E); } SEAM(28);
    if (IN(29)) { ProbF2 g{p_DFT2, p_BIG, 4096, 4096, 4096}; pg8::UOrder S; S.init(8, 8, 16, G, bid); EpiF2 E{p_OB}; pg8::gemm_phase<ProbF2, EpiF2>(lds, g, S, E); } SEAM(29);
    PH_OUT(30, 3, 1);
    PH_NORM2(31, 3, 1);
    PH_FFN1(32, 3, 1);
    PH_FFN2(33, 3, 1);
#undef IN
#undef SEAM
#undef p_ws
#undef p_modv
#undef p_rope
#undef p_DFT1
#undef p_DFT2
#undef p_Wf1
#undef p_Wf2
#undef p_Win
#undef p_Wout
#undef p_xctx
#undef p_HN
#undef p_OB
#undef p_BIG
#undef p_out
}

extern "C" void kernel_launch(void* const* d_in, const int* in_sizes, int n_in, void* d_out, int out_size, void* d_ws, size_t ws_size, hipStream_t stream) {
    static int grid = 0;
    if (grid == 0) {
        if (n_in != 49 || out_size != NLAT * DM || ws_size < WS_END) { fprintf(stderr, "kernel_launch: unexpected shapes: n_in %d out %d ws %zu (need >= %zu)\n", n_in, out_size, ws_size, (size_t)WS_END); grid = -1; return; }
        int dev = 0, cus = 0, per_cu = 0;
        if (hipGetDevice(&dev) != hipSuccess || hipDeviceGetAttribute(&cus, hipDeviceAttributeMultiprocessorCount, dev) != hipSuccess) { grid = -1; return; }
        if (hipFuncSetAttribute((const void*)fwd_kernel, hipFuncAttributeMaxDynamicSharedMemorySize, LDS_BYTES) != hipSuccess) { fprintf(stderr, "kernel_launch: hipFuncSetAttribute failed\n"); grid = -1; return; }
        if (hipOccupancyMaxActiveBlocksPerMultiprocessor(&per_cu, (const void*)fwd_kernel, 512, LDS_BYTES) != hipSuccess || per_cu < 1) { fprintf(stderr, "kernel_launch: occupancy query says %d\n", per_cu); }
        (void)hipGetLastError();
        grid = cus;
    }
    if (grid < 0) return;
    (void)hipMemsetAsync((char*)d_ws + WS_CTL, 0, CTL_ZERO_BYTES, stream);
    KArgs a{};
    for (int i = 0; i < 49; ++i) a.in[i] = (const float*)d_in[i];
    a.out = (float*)d_out; a.ws = (unsigned char*)d_ws;
#if N_LAUNCH_MODE == 1
    a.ph_lo = 0; a.ph_hi = NPH;
    hipLaunchKernelGGL(fwd_kernel, dim3(grid), dim3(512), LDS_BYTES, stream, a);
#else
    for (int k = 0; k < NPH; ++k) { a.ph_lo = k; a.ph_hi = k + 1; hipLaunchKernelGGL(fwd_kernel, dim3(grid), dim3(512), LDS_BYTES, stream, a); }
#endif
    const hipError_t le = hipPeekAtLastError();
    if (le != hipSuccess) fprintf(stderr, "kernel_launch: launch failed: %s\n", hipGetErrorName(le));
}
```

```cpp
#include <hip/hip_runtime.h>
#include <cstdio>
#include <cstdint>

#define LAS __attribute__((address_space(3)))
typedef unsigned short bf16_t;
typedef short bf16x8 __attribute__((ext_vector_type(8)));
typedef short s16x4 __attribute__((ext_vector_type(4)));
typedef float f32x4 __attribute__((ext_vector_type(4)));
typedef float f32x2 __attribute__((ext_vector_type(2)));
typedef float f32x16 __attribute__((ext_vector_type(16)));
typedef unsigned u32x4 __attribute__((ext_vector_type(4)));
typedef unsigned u32x2 __attribute__((ext_vector_type(2)));

#ifndef N_LAUNCH_MODE
#define N_LAUNCH_MODE 1
#endif

constexpr int NB = 16, SEQ = 2048, DM = 2048, CTXL = 256, TPB = 2304  , NT = NB * TPB, FF = 5632;
constexpr int NLAT = NB * SEQ;
constexpr float NORM_EPS = 1e-6f;

constexpr size_t MiB = 1u << 20;
constexpr size_t WS_CTL = 0, CTL_ZERO_BYTES = 1 * MiB;
constexpr size_t WS_MODV = 1 * MiB;
constexpr size_t WS_ROPE = 5 * MiB;
constexpr size_t WS_DFT1 = 6 * MiB;
constexpr size_t WS_DFT2 = 7 * MiB;
constexpr size_t WS_W = 24 * MiB;
constexpr size_t W_FFN1 = WS_W, W_FFN2 = WS_W + 44 * MiB, W_IN = WS_W + 66 * MiB, W_OUT = WS_W + 91 * MiB;
constexpr size_t WS_XCTX = 128 * MiB;
constexpr size_t WS_HN = 160 * MiB;
constexpr size_t WS_O = 304 * MiB;
constexpr size_t WS_BIG = 448 * MiB;
constexpr size_t WS_GX = 880 * MiB;
constexpr size_t WS_KTT = WS_GX, WS_CMCL = WS_GX + 144 * MiB, WS_Z = WS_GX + 154 * MiB;
constexpr size_t WS_O32 = 1039 * MiB;
constexpr size_t WS_END = 1327 * MiB;

constexpr int RING_BYTES = 131072;
constexpr int LDS_BYTES = 147456;
constexpr int MISC_OFF = LDS_BYTES - 64;

__device__ __forceinline__ unsigned f2bf(float f) { unsigned u = __builtin_bit_cast(unsigned, f); return (u + 0x7fffu + ((u >> 16) & 1u)) >> 16; }
__device__ __forceinline__ unsigned pk2(float lo, float hi) { return f2bf(lo) | (f2bf(hi) << 16); }
__device__ __forceinline__ float bf2f(unsigned short b) { return __builtin_bit_cast(float, ((unsigned)b) << 16); }
__device__ __forceinline__ float bflo(unsigned w) { return __builtin_bit_cast(float, w << 16); }
__device__ __forceinline__ float bfhi(unsigned w) { return __builtin_bit_cast(float, w & 0xffff0000u); }
__device__ __forceinline__ unsigned cvt_pk_bf16(float lo, float hi) { unsigned r; asm volatile("v_cvt_pk_bf16_f32 %0, %1, %2" : "=v"(r) : "v"(lo), "v"(hi)); return r; }
__device__ __forceinline__ float wave_sum(float v) {
#pragma unroll
    for (int o = 1; o < 64; o <<= 1) v += __shfl_xor(v, o);
    return v;
}
__device__ __forceinline__ float siluf(float v) { return v * __builtin_amdgcn_rcpf(1.f + __expf(-v)); }
#define LDS_WAIT() asm volatile("s_waitcnt lgkmcnt(0)" ::: "memory")
#define VM_WAIT() asm volatile("s_waitcnt vmcnt(0)" ::: "memory")

#define XB_TMO      128
#define XB_XCNT(j)  (256  + 64 * (j))
#define XB_XSUB(j)  (1280 + 64 * (j))
#define XB_XGEN(j)  (2304 + 64 * (j))
#define XB_TOP      3328
#define XB_TOPGEN   3392
#define XCD_BAR_WORDS 3456
#define XB_SPIN_CAP (1u << 24)
__device__ __forceinline__ unsigned xb_ld(unsigned* p)              { return __hip_atomic_load(p, __ATOMIC_RELAXED, __HIP_MEMORY_SCOPE_AGENT); }
__device__ __forceinline__ unsigned xb_add(unsigned* p, unsigned v) { return __hip_atomic_fetch_add(p, v, __ATOMIC_RELAXED, __HIP_MEMORY_SCOPE_AGENT); }
__device__ __forceinline__ unsigned xb_xcc_id() { return (unsigned)__builtin_amdgcn_s_getreg((3 << 11) | 20) & 0xFu; }
#define XB_SPIN(cond, bar) do { unsigned _sp = 0; while (cond) { __builtin_amdgcn_s_sleep(1); \
    if ((++_sp & 255u) == 0u) { if (xb_ld(&(bar)[XB_TMO])) break; if (_sp > XB_SPIN_CAP) { atomicAdd(&(bar)[XB_TMO], 1u); break; } } } } while (0)
struct XcdBarrier { unsigned* bar; unsigned x; volatile LAS unsigned* st; };
__device__ __forceinline__ XcdBarrier xcd_barrier_post(unsigned* bar, volatile LAS unsigned* st) {
    XcdBarrier b; b.bar = bar; b.x = xb_xcc_id(); b.st = st;
    if (threadIdx.x == 0) (void)xb_add(&bar[XB_XCNT(b.x)], 1u);
    return b;
}
__device__ __forceinline__ void xcd_barrier_complete(unsigned* bar, unsigned x, unsigned& nloc, unsigned& nx) {
    const unsigned G = gridDim.x * gridDim.y * gridDim.z;
    unsigned sum, cnt, mine, sp = 0u;
    for (;;) {
        sum = 0u; cnt = 0u; mine = 0u;
#pragma unroll
        for (unsigned j = 0; j < 16; ++j) { const unsigned c = xb_ld(&bar[XB_XCNT(j)]); sum += c; cnt += (c > 0u) ? 1u : 0u; mine = (j == x) ? c : mine; }
        if (sum == G) break;
        __builtin_amdgcn_s_sleep(1);
        if ((++sp & 255u) == 0u) { if (xb_ld(&bar[XB_TMO])) break; if (sp > XB_SPIN_CAP) { atomicAdd(&bar[XB_TMO], 1u); break; } }
    }
    nloc = mine > 0u ? mine : 1u; nx = cnt > 0u ? cnt : 1u;
}
__device__ __forceinline__ void xcd_barrier(const XcdBarrier& b) {
    asm volatile("s_waitcnt vmcnt(0)" ::: "memory");
    __syncthreads();
    if (threadIdx.x == 0) {
        unsigned* bar = b.bar;
        __builtin_amdgcn_s_waitcnt(0);
        unsigned nloc = b.st[0], nx = b.st[1];
        if (nloc == 0u) { xcd_barrier_complete(bar, b.x, nloc, nx); b.st[0] = nloc; b.st[1] = nx; }
        const unsigned old = xb_add(&bar[XB_XSUB(b.x)], 1u);
        const unsigned gen = old / nloc;
        if (old + 1u == (gen + 1u) * nloc) {
            __builtin_amdgcn_fence(__ATOMIC_RELEASE, "agent");
            asm volatile("s_waitcnt vmcnt(0)" ::: "memory");
            const unsigned og = xb_add(&bar[XB_TOP], 1u);
            const unsigned tg = og / nx;
            if (og + 1u == (tg + 1u) * nx) xb_add(&bar[XB_TOPGEN], 1u);
            else XB_SPIN(xb_ld(&bar[XB_TOPGEN]) == tg, bar);
            __builtin_amdgcn_fence(__ATOMIC_ACQUIRE, "agent");
            xb_add(&bar[XB_XGEN(b.x)], 1u);
            asm volatile("s_waitcnt vmcnt(0)" ::: "memory");
        } else {
            XB_SPIN(xb_ld(&bar[XB_XGEN(b.x)]) == gen, bar);
            __builtin_amdgcn_fence(__ATOMIC_ACQUIRE, "agent");
            asm volatile("s_waitcnt vmcnt(0)" ::: "memory");
        }
    }
    __syncthreads();
}

namespace pg8 {
constexpr int BM = 256, BK = 64, HALF = 128, HTB = HALF * BK * 2, STAGE_BYTES = 8 * HTB, NXCD = 8, WGM = 8;
__host__ __device__ __forceinline__ int lds_byte(int r, int c) { const int st = (r >> 4) * 2 + (c >> 5), rr = r & 15, cc = c & 31, ob = rr * 64 + cc * 2; return st * 1024 + (ob ^ (((ob >> 9) & 1) << 5)); }
__host__ __device__ __forceinline__ void stage_rc(int b, int& R, int& C) { const int st = b / 1024, sb = b % 1024, swz = sb ^ (((sb >> 9) & 1) << 5); R = (st >> 1) * 16 + swz / 64; C = (st & 1) * 32 + (swz % 64) / 2; }
__host__ __device__ __forceinline__ int perm32(int rho) { const int n = rho >> 4, i = rho & 15; return 8 * (i >> 2) + 4 * n + (i & 3); }

struct Unit { int pm, pn, z; };
struct UOrder {
    int nM, nN, nZ, nwg, G, c;
    __device__ __forceinline__ void init(int nM_, int nN_, int nZ_, int G_, int c_) { nM = nM_; nN = nN_; nZ = nZ_; nwg = nM_ * nN_ * nZ_; G = G_; c = c_; }
    __device__ __forceinline__ bool next(int i, Unit& u) const {
        const long L = (long)i * G + c; if (L >= nwg) return false;
        int wgid = (int)L; { const int q = nwg / NXCD, r = nwg % NXCD, xcd = wgid % NXCD, off = wgid / NXCD; wgid = (xcd < r ? xcd * (q + 1) : r * (q + 1) + (xcd - r) * q) + off; }
        const int per = nM * nN; u.z = wgid / per; const int w2 = wgid - u.z * per;
        const int nig = WGM * nN, gid = w2 / nig, fm = gid * WGM, gsz = (nM - fm) < WGM ? (nM - fm) : WGM;
        u.pm = fm + ((w2 % nig) % gsz); u.pn = (w2 % nig) / gsz; return true;
    }
};

template <class Prob, class Epi>
__device__ __forceinline__ void gemm_phase(LAS unsigned char* lds, const Prob g, const UOrder& S, const Epi& E) {
    const int tid = threadIdx.x, wid = __builtin_amdgcn_readfirstlane(tid >> 6), lane = tid & 63, wr = wid >> 2, wc = wid & 3, fr = lane & 15, fq = lane >> 4;
    const int K = g.K, nt = K / BK;
    unsigned voffA[2], voffB[2];
#pragma unroll
    for (int i = 0; i < 2; ++i) { int R, C; stage_rc(tid * 16 + i * 8192, R, C); const int Rb = Epi::PERM ? ((R & ~31) + perm32(R & 31)) : R;
        voffA[i] = (unsigned)(R * g.lda + C) * 2u; voffB[i] = (unsigned)(Rb * g.ldb + C) * 2u; }
    const size_t kstep = (size_t)(BK * 2);
    const size_t hstepA = (size_t)HALF * g.lda * 2, hstepB = (size_t)HALF * g.ldb * 2;
    const unsigned ldsw = (unsigned)wid * 1024u;
    const int aoff = lds_byte(wr * 64 + fr, fq * 8), boff = lds_byte(wc * 32 + fr, fq * 8);
#define PG8_SA(b, h) (((b) * 2 + (h)) * HTB)
#define PG8_SB(b, h) ((4 + (b) * 2 + (h)) * HTB)
#define PG8_STAGE(bufoff, gbase, voff) do { _Pragma("unroll") for (int _i = 0; _i < 2; ++_i) \
        __builtin_amdgcn_global_load_lds((const unsigned*)((const char*)(gbase) + (voff)[_i]), (LAS unsigned*)(lds + (bufoff) + ldsw + _i * 8192), 16, 0, 0); } while (0)
#define PG8_LDA(dst, b, h) do { _Pragma("unroll") for (int m = 0; m < 4; ++m) _Pragma("unroll") for (int k = 0; k < 2; ++k) dst[m][k] = *(const LAS bf16x8*)(lds + PG8_SA(b, h) + aoff + m * 2048 + k * 1024); } while (0)
#define PG8_LDB(dst, b, h) do { _Pragma("unroll") for (int n = 0; n < 2; ++n) _Pragma("unroll") for (int k = 0; k < 2; ++k) dst[n][k] = *(const LAS bf16x8*)(lds + PG8_SB(b, h) + boff + n * 2048 + k * 1024); } while (0)
#define PG8_MMA(ai, bj, At, Bt) do { __builtin_amdgcn_s_setprio(1); _Pragma("unroll") for (int m = 0; m < 4; ++m) _Pragma("unroll") for (int n = 0; n < 2; ++n) _Pragma("unroll") for (int k = 0; k < 2; ++k) \
        acc[ai][bj][m][n] = __builtin_amdgcn_mfma_f32_16x16x32_bf16(Bt[n][k], At[m][k], acc[ai][bj][m][n], 0, 0, 0); __builtin_amdgcn_s_setprio(0); } while (0)
#define PG8_WAIT_V(n) asm volatile("s_waitcnt vmcnt(" #n ")" ::: "memory")
#define PG8_WAIT_L(n) asm volatile("s_waitcnt lgkmcnt(" #n ")" ::: "memory")
#define PG8_BAR __builtin_amdgcn_s_barrier()
#define PG8_SCHED __builtin_amdgcn_sched_barrier(0)
    Unit cur, nxt; int ui = 0;
    if (!S.next(0, cur)) return;
    f32x4 acc[2][2][4][2];
#pragma unroll
    for (int a = 0; a < 2; ++a)
#pragma unroll
        for (int b = 0; b < 2; ++b)
#pragma unroll
            for (int m = 0; m < 4; ++m)
#pragma unroll
                for (int n = 0; n < 2; ++n) acc[a][b][m][n] = (f32x4){0.f, 0.f, 0.f, 0.f};
    bf16x8 At[4][2], B0[2][2], B1[2][2];
    const char* cA = g.a_tile(cur); const char* cB = g.b_tile(cur);
    PG8_STAGE(PG8_SB(0, 0), cB, voffB); PG8_STAGE(PG8_SB(0, 1), cB + hstepB, voffB); PG8_STAGE(PG8_SA(0, 0), cA, voffA); PG8_STAGE(PG8_SA(0, 1), cA + hstepA, voffA);
    if (wr == 1) PG8_BAR;
    PG8_WAIT_V(2); PG8_BAR;
    PG8_STAGE(PG8_SB(1, 0), cB + kstep, voffB); PG8_STAGE(PG8_SA(1, 0), cA + kstep, voffA); PG8_STAGE(PG8_SB(1, 1), cB + hstepB + kstep, voffB);
    PG8_WAIT_V(6); PG8_BAR;
    for (;;) {
        const bool has_next = S.next(ui + 1, nxt);
        const char* nA = has_next ? g.a_tile(nxt) : cA; const char* nB = has_next ? g.b_tile(nxt) : cB;
        for (int t = 0; t < nt; t += 2) {
            const bool last = (t == nt - 2);
            const char* a1 = cA + (size_t)(t + 1) * kstep;
            const char* a2 = last ? nA : cA + (size_t)(t + 2) * kstep; const char* b2 = last ? nB : cB + (size_t)(t + 2) * kstep;
            const char* a3 = a2 + kstep; const char* b3 = b2 + kstep;
            PG8_LDB(B0, 0, 0); PG8_LDB(B1, 0, 1); PG8_SCHED; PG8_LDA(At, 0, 0); PG8_STAGE(PG8_SA(1, 1), a1 + hstepA, voffA);
            PG8_WAIT_V(8); PG8_WAIT_L(0); PG8_BAR; PG8_MMA(0, 0, At, B0); PG8_MMA(0, 1, At, B1); PG8_BAR; PG8_SCHED;
            PG8_LDA(At, 0, 1); PG8_STAGE(PG8_SB(0, 0), b2, voffB); PG8_STAGE(PG8_SB(0, 1), b2 + hstepB, voffB); PG8_STAGE(PG8_SA(0, 0), a2, voffA);
            PG8_WAIT_V(8); PG8_WAIT_L(0); PG8_BAR; PG8_MMA(1, 0, At, B0); PG8_MMA(1, 1, At, B1); PG8_BAR; PG8_SCHED;
            PG8_LDB(B0, 1, 0); PG8_LDB(B1, 1, 1); PG8_SCHED; PG8_LDA(At, 1, 0); PG8_STAGE(PG8_SA(0, 1), a2 + hstepA, voffA);
            PG8_WAIT_V(8); PG8_WAIT_L(0); PG8_BAR; PG8_MMA(0, 0, At, B0); PG8_MMA(0, 1, At, B1); PG8_BAR; PG8_SCHED;
            PG8_LDA(At, 1, 1); PG8_STAGE(PG8_SB(1, 0), b3, voffB); PG8_STAGE(PG8_SB(1, 1), b3 + hstepB, voffB); PG8_STAGE(PG8_SA(1, 0), a3, voffA);
            PG8_WAIT_V(8); PG8_WAIT_L(0); PG8_BAR; PG8_MMA(1, 0, At, B0); PG8_MMA(1, 1, At, B1); PG8_BAR; PG8_SCHED;
        }
        if (wr == 0) PG8_BAR;
        E(acc, cur, wr, wc, fr, fq);
        if (!has_next) break;
#pragma unroll
        for (int a = 0; a < 2; ++a)
#pragma unroll
            for (int b = 0; b < 2; ++b)
#pragma unroll
                for (int m = 0; m < 4; ++m)
#pragma unroll
                    for (int n = 0; n < 2; ++n) acc[a][b][m][n] = (f32x4){0.f, 0.f, 0.f, 0.f};
        cur = nxt; cA = nA; cB = nB; ++ui;
        if (wr == 1) PG8_BAR;
    }
    PG8_WAIT_V(0);
    PG8_BAR;
#undef PG8_SA
#undef PG8_SB
#undef PG8_STAGE
#undef PG8_LDA
#undef PG8_LDB
#undef PG8_MMA
#undef PG8_WAIT_V
#undef PG8_WAIT_L
#undef PG8_BAR
#undef PG8_SCHED
}
}
using pg8::Unit;

__device__ __forceinline__ int row_tile(int pm, int amap) { return amap ? 9 * (pm >> 3) + 1 + (pm & 7) : pm; }

struct ProbStd {
    const bf16_t* A; const bf16_t* Bt; int lda, ldb, K, amap;
    __device__ __forceinline__ const char* a_tile(const Unit& u) const { return (const char*)(A + (size_t)row_tile(u.pm, amap) * 256 * lda); }
    __device__ __forceinline__ const char* b_tile(const Unit& u) const { return (const char*)(Bt + (size_t)u.pn * 256 * ldb); }
};
struct ProbF1 {
    const bf16_t* A; const bf16_t* HN; int lda, ldb, K;
    __device__ __forceinline__ const char* a_tile(const Unit& u) const { return (const char*)(A + (size_t)u.pm * 256 * 512); }
    __device__ __forceinline__ const char* b_tile(const Unit& u) const { return (const char*)(HN + ((size_t)(u.z >> 2) * TPB + CTXL + (size_t)u.pn * 256) * DM + (u.z & 3) * 512); }
};
struct ProbF2 {
    const bf16_t* A; const bf16_t* UVT; int lda, ldb, K;
    __device__ __forceinline__ const char* a_tile(const Unit& u) const { return (const char*)(A + (size_t)u.pm * 256 * 4096); }
    __device__ __forceinline__ const char* b_tile(const Unit& u) const { return (const char*)(UVT + ((size_t)u.z * 2048 + (size_t)u.pn * 256) * 4096); }
};

__device__ __forceinline__ void store_tile_bf16(const f32x4 (&acc)[2][2][4][2], bf16_t* base, size_t ldc, int wr, int wc, int fr, int fq) {
#pragma unroll
    for (int ai = 0; ai < 2; ++ai)
#pragma unroll
        for (int m = 0; m < 4; ++m) { bf16_t* rowp = base + (size_t)(ai * 128 + wr * 64 + m * 16 + fr) * ldc + wc * 32 + 8 * fq;
#pragma unroll
            for (int bj = 0; bj < 2; ++bj) { const f32x4 v0 = acc[ai][bj][m][0], v1 = acc[ai][bj][m][1];
                u32x4 w; w.x = cvt_pk_bf16(v0[0], v0[1]); w.y = cvt_pk_bf16(v0[2], v0[3]); w.z = cvt_pk_bf16(v1[0], v1[1]); w.w = cvt_pk_bf16(v1[2], v1[3]);
                *(u32x4*)(rowp + bj * 128) = w; } }
}
struct EpiProj {
    static constexpr bool PERM = true;
    bf16_t* O; int ldc; int zt; float* Z;
    __device__ __forceinline__ void operator()(const f32x4 (&acc)[2][2][4][2], const Unit& u, int wr, int wc, int fr, int fq) const {
        if (u.pn == zt) {
            if (wc == 0) {
#pragma unroll
                for (int ai = 0; ai < 2; ++ai)
#pragma unroll
                    for (int m = 0; m < 4; ++m) { float* zp = Z + (size_t)(u.pm * 256 + ai * 128 + wr * 64 + m * 16 + fr) * 32 + 8 * fq;
                        *(f32x4*)zp = acc[ai][0][m][0]; *(f32x4*)(zp + 4) = acc[ai][0][m][1]; }
            }
            return;
        }
        store_tile_bf16(acc, O + (size_t)u.pm * 256 * ldc + (size_t)u.pn * 256, (size_t)ldc, wr, wc, fr, fq);
    }
};
struct EpiF1 {
    static constexpr bool PERM = true;
    bf16_t* UVT;
    __device__ __forceinline__ void operator()(const f32x4 (&acc)[2][2][4][2], const Unit& u, int wr, int wc, int fr, int fq) const {
        bf16_t* base = UVT + ((size_t)(u.z >> 2) * 2048 + (u.z & 3) * 512 + (u.pm & 1) * 256) * 4096 + (size_t)(u.pm >> 1) * 2048 + (size_t)u.pn * 256;
        store_tile_bf16(acc, base, 4096, wr, wc, fr, fq);
    }
};
struct EpiF2 {
    static constexpr bool PERM = true;
    bf16_t* O;
    __device__ __forceinline__ void operator()(const f32x4 (&acc)[2][2][4][2], const Unit& u, int wr, int wc, int fr, int fq) const {
        bf16_t* base = O + ((size_t)u.z * TPB + CTXL + (size_t)u.pm * 256) * DM + (size_t)u.pn * 256;
        store_tile_bf16(acc, base, DM, wr, wc, fr, fq);
    }
};
struct EpiSwiGLU {
    static constexpr bool PERM = true;
    bf16_t* H; int amap;
    __device__ __forceinline__ void operator()(const f32x4 (&acc)[2][2][4][2], const Unit& u, int wr, int wc, int fr, int fq) const {
        bf16_t* base = H + (size_t)row_tile(u.pm, amap) * 256 * FF + (size_t)u.pn * 128 + wc * 32 + 8 * fq;
#pragma unroll
        for (int ai = 0; ai < 2; ++ai)
#pragma unroll
            for (int m = 0; m < 4; ++m) { bf16_t* rowp = base + (size_t)(ai * 128 + wr * 64 + m * 16 + fr) * FF;
                const f32x4 g0 = acc[ai][0][m][0], g1 = acc[ai][0][m][1], u0 = acc[ai][1][m][0], u1 = acc[ai][1][m][1];
                u32x4 w; w.x = cvt_pk_bf16(siluf(g0[0]) * u0[0], siluf(g0[1]) * u0[1]); w.y = cvt_pk_bf16(siluf(g0[2]) * u0[2], siluf(g0[3]) * u0[3]);
                w.z = cvt_pk_bf16(siluf(g1[0]) * u1[0], siluf(g1[1]) * u1[1]); w.w = cvt_pk_bf16(siluf(g1[2]) * u1[2], siluf(g1[3]) * u1[3]);
                *(u32x4*)rowp = w; }
    }
};
struct EpiRes {
    static constexpr bool PERM = false;
    const float* src_lat; const float* src_ctx; float* dst_lat; float* dst_ctx; const float* modv; int goff; int amap;
    __device__ __forceinline__ void operator()(const f32x4 (&acc)[2][2][4][2], const Unit& u, int wr, int wc, int fr, int fq) const {
        const int rt = row_tile(u.pm, amap), b = rt / 9, j = rt - b * 9;
        const float* sb; float* db; const float* gv;
        if (j == 0) { sb = src_ctx + (size_t)b * CTXL * DM; db = dst_ctx + (size_t)b * CTXL * DM; gv = modv + (size_t)16 * 12288 + goff; }
        else { sb = src_lat + ((size_t)b * SEQ + (size_t)(j - 1) * 256) * DM; db = dst_lat + ((size_t)b * SEQ + (size_t)(j - 1) * 256) * DM; gv = modv + (size_t)b * 12288 + goff; }
        const int col0 = u.pn * 256 + wc * 32 + 4 * fq;
        f32x4 gt[2][2];
#pragma unroll
        for (int bj = 0; bj < 2; ++bj)
#pragma unroll
            for (int n = 0; n < 2; ++n) gt[bj][n] = *(const f32x4*)(gv + col0 + bj * 128 + n * 16);
#pragma unroll
        for (int ai = 0; ai < 2; ++ai)
#pragma unroll
            for (int m = 0; m < 4; ++m) { const size_t off = (size_t)(ai * 128 + wr * 64 + m * 16 + fr) * DM + col0;
#pragma unroll
                for (int bj = 0; bj < 2; ++bj)
#pragma unroll
                    for (int n = 0; n < 2; ++n) { const f32x4 xs = *(const f32x4*)(sb + off + bj * 128 + n * 16);
                        *(f32x4*)(db + off + bj * 128 + n * 16) = xs + gt[bj][n] * acc[ai][bj][m][n]; }
                asm volatile("" ::: "memory"); }
    }
};

struct KArgs { const float* in[49]; float* out; unsigned char* ws; int ph_lo, ph_hi; };
__device__ __forceinline__ int idx_modw(int L) { return L == 0 ? 4 : L == 1 ? 17 : L == 2 ? 27 : 42; }
__device__ __forceinline__ int idx_norm2(int L) { return L == 0 ? 14 : L == 1 ? 24 : L == 2 ? 39 : 46; }

__device__ __forceinline__ void ph_prologue(const KArgs& a, LAS unsigned char* lds, int G, int bid) {
    const int tid = threadIdx.x, lane = tid & 63, wave = __builtin_amdgcn_readfirstlane(tid >> 6);
    LAS float* sl = (LAS float*)lds;
    LAS float* red = (LAS float*)(lds + 139264);
    float* modv = (float*)(a.ws + WS_MODV);
    {
        const float* c = a.in[1]; const float* cc = a.in[3];
        for (int i = tid; i < 17 * 2048; i += 512) { const float v = i < 16 * 2048 ? c[i] : cc[i - 16 * 2048]; sl[i] = v / (1.f + __expf(-v)); }
    }
    __syncthreads();
    for (int u = bid; u < 768; u += G) {
        const int L = u / 192, n0 = (u % 192) * 64;
        const float* W = a.in[idx_modw(L)]; const float* bias = a.in[idx_modw(L) + 1];
        float acc[17];
#pragma unroll
        for (int r = 0; r < 17; ++r) acc[r] = 0.f;
        const int k0 = wave * 256;
#pragma unroll 2
        for (int k = k0; k < k0 + 256; k += 4) {
            const float w0 = W[(size_t)(k + 0) * 12288 + n0 + lane], w1 = W[(size_t)(k + 1) * 12288 + n0 + lane];
            const float w2 = W[(size_t)(k + 2) * 12288 + n0 + lane], w3 = W[(size_t)(k + 3) * 12288 + n0 + lane];
#pragma unroll
            for (int r = 0; r < 17; ++r) { const f32x4 s4 = *(const LAS f32x4*)(sl + r * 2048 + k); acc[r] += s4.x * w0 + s4.y * w1 + s4.z * w2 + s4.w * w3; }
        }
        for (int w = 0; w < 8; ++w) {
            if (wave == w) {
#pragma unroll
                for (int r = 0; r < 17; ++r) red[r * 64 + lane] = (w == 0 ? 0.f : red[r * 64 + lane]) + acc[r];
            }
            __syncthreads();
        }
        for (int i = tid; i < 17 * 64; i += 512) { const int r = i >> 6, l = i & 63; modv[((size_t)L * 17 + r) * 12288 + n0 + l] = red[i] + bias[n0 + l]; }
        __syncthreads();
    }
    const size_t gt = (size_t)bid * 512 + tid, GT = (size_t)G * 512;
    {
        f32x2* rope = (f32x2*)(a.ws + WS_ROPE);
        for (size_t e = gt; e < 2048 * 64; e += GT) {
            const int p = (int)(e >> 6), i = (int)(e & 63), f = i & 31;
            const float inv = exp2f(-(float)(2 * f) * (13.287712379549449f / 64.f));
            const float ang = (float)(i < 32 ? (p >> 6) : (p & 63)) * inv;
            const float kf = rintf(ang * 0.15915494309189535f);
            float r = fmaf(-kf, 6.28318548202514648f, ang); r = fmaf(-kf, -1.7484556000744883e-7f, r);
            rope[e] = (f32x2){cosf(r), sinf(r)};
        }
    }
    {
        bf16_t* d1 = (bf16_t*)(a.ws + WS_DFT1);
        for (size_t e = gt; e < 1024 * 512; e += GT) {
            const int m = (int)(e >> 9), k = (int)(e & 511), part = m >> 9, cp = m & 511;
            const int rr = (k * cp) & 511; const float ang = (float)rr * (6.283185307179586f / 512.f);
            const float v = (part ? sinf(ang) : cosf(ang)) * 0.044194173824159216f;
            d1[e] = (bf16_t)f2bf(v);
        }
        bf16_t* d2 = (bf16_t*)(a.ws + WS_DFT2);
        for (size_t e = gt; e < (size_t)2048 * 4096; e += GT) {
            const int lp = (int)(e >> 12), k = (int)(e & 4095), part = k >> 11, l = k & 2047;
            const int rr = (l * lp) & 2047; const float ang = (float)rr * (6.283185307179586f / 2048.f);
            const float v = (part ? -sinf(ang) : cosf(ang)) * 0.022097086912079608f;
            d2[e] = (bf16_t)f2bf(v);
        }
    }
}

__device__ __forceinline__ void transpose_item(const float* W, int K, int N, bf16_t* WT, int mode, LAS float* scr, int item, int lane) {
    const int nblk = N / 32, kb = item / nblk, nb = item % nblk, k0 = 64 * kb, n0 = 32 * nb;
#pragma unroll 8
    for (int i = 0; i < 32; ++i) { const int kk = 2 * i + (lane >> 5); scr[kk * 33 + (lane & 31)] = W[(size_t)(k0 + kk) * N + n0 + (lane & 31)]; }
    LDS_WAIT(); asm volatile("" ::: "memory");
    const int c = lane & 7;
#pragma unroll
    for (int j = 0; j < 4; ++j) { const int n = (lane >> 3) + 8 * j; const LAS float* s = scr + (8 * c) * 33 + n;
        u32x4 o; o.x = pk2(s[0 * 33], s[1 * 33]); o.y = pk2(s[2 * 33], s[3 * 33]); o.z = pk2(s[4 * 33], s[5 * 33]); o.w = pk2(s[6 * 33], s[7 * 33]);
        int drow = n0 + n;
        if (mode == 1) { const int part = drow >= FF ? 1 : 0, hid = drow - part * FF; drow = 256 * (hid >> 7) + 128 * part + (hid & 127); }
        *(u32x4*)(WT + (size_t)drow * K + k0 + 8 * c) = o; }
    LDS_WAIT(); asm volatile("" ::: "memory");
}
__device__ __forceinline__ void convert_layer(const KArgs& a, LAS unsigned char* lds, int G, int bid, const float* f_in, const float* f_out, const float* wi, int Nin, const float* wo) {
    const int tid = threadIdx.x, lane = tid & 63, wave = __builtin_amdgcn_readfirstlane(tid >> 6);
    LAS float* scr = (LAS float*)(lds + wave * 16384);
    const int gw = bid * 8 + wave, NGW = G * 8;
    const int I1 = (DM / 64) * (2 * FF / 32), I2 = (FF / 64) * (DM / 32), I3 = wi ? (DM / 64) * (Nin / 32) : 0, I4 = (DM / 64) * (DM / 32);
    const int NI = I1 + I2 + I3 + I4;
    for (int it = gw; it < NI; it += NGW) {
        int r = it;
        if (r < I1) { transpose_item(f_in, DM, 2 * FF, (bf16_t*)(a.ws + W_FFN1), 1, scr, r, lane); continue; } r -= I1;
        if (r < I2) { transpose_item(f_out, FF, DM, (bf16_t*)(a.ws + W_FFN2), 0, scr, r, lane); continue; } r -= I2;
        if (r < I3) { transpose_item(wi, DM, Nin, (bf16_t*)(a.ws + W_IN), 0, scr, r, lane); continue; } r -= I3;
        transpose_item(wo, DM, DM, (bf16_t*)(a.ws + W_OUT), 0, scr, r, lane);
    }
}

__device__ __forceinline__ const float* row_src(const float* lat, const float* ctx, int r) {
    const int b = r / TPB, t = r - b * TPB;
    return t < CTXL ? ctx + ((size_t)b * CTXL + t) * DM : lat + ((size_t)b * SEQ + (t - CTXL)) * DM;
}
__device__ __forceinline__ void norm_phase(const float* lat, const float* ctx, const float* gain, const float* modvL, int shoff, int scoff, bf16_t* HN, int lat_only, int G, int bid) {
    const int tid = threadIdx.x, lane = tid & 63, wave = __builtin_amdgcn_readfirstlane(tid >> 6);
    const int nunits = lat_only ? NLAT / 16 : NT / 16;
    for (int u = bid; u < nunits; u += G) {
        int r0;
        if (lat_only) { const int lr = u * 16, b = lr / SEQ; r0 = b * TPB + CTXL + (lr - b * SEQ); } else r0 = u * 16;
#pragma unroll
        for (int rr = 0; rr < 2; ++rr) {
            const int r = r0 + wave * 2 + rr;
            const int b = r / TPB, t = r - b * TPB;
            const float* xr = row_src(lat, ctx, r);
            const float* mv = modvL + (size_t)(t < CTXL ? 16 : b) * 12288;
            f32x4 v[8]; float ss = 0.f;
#pragma unroll
            for (int j = 0; j < 8; ++j) { v[j] = *(const f32x4*)(xr + 4 * lane + 256 * j); ss += (v[j].x * v[j].x + v[j].y * v[j].y) + (v[j].z * v[j].z + v[j].w * v[j].w); }
            const float rstd = 1.0f / sqrtf(wave_sum(ss) * (1.f / DM) + NORM_EPS);
            bf16_t* orow = HN + (size_t)r * DM;
#pragma unroll
            for (int j = 0; j < 8; ++j) {
                const int c = 4 * lane + 256 * j;
                const f32x4 g = *(const f32x4*)(gain + c), sc = *(const f32x4*)(mv + scoff + c), sh = *(const f32x4*)(mv + shoff + c);
                const f32x4 o = v[j] * rstd * g * (1.f + sc) + sh;
                u32x2 w; w.x = cvt_pk_bf16(o.x, o.y); w.y = cvt_pk_bf16(o.z, o.w);
                *(u32x2*)(orow + c) = w;
            }
        }
    }
}

__device__ __forceinline__ void qknorm_rope_phase(bf16_t* P, int ld, int nh, const float* qn, const float* kn, const f32x2* rope, int G, int bid) {
    const int tid = threadIdx.x, lane = tid & 63, wave = __builtin_amdgcn_readfirstlane(tid >> 6);
    const int nq = nh >> 2, sub = lane >> 4, li = lane & 15, quarter = li >> 2;
    const long total = (long)NT * nq;
    for (long id = (long)bid * 8 + wave; id < total; id += (long)G * 8) {
        const int r = (int)(id / nq), quad = (int)(id - (long)r * nq), hi = quad * 4 + sub;
        bf16_t* p = P + (size_t)r * ld + hi * 128 + 8 * li;
        const u32x4 w = *(const u32x4*)p;
        float x[8] = {bflo(w.x), bfhi(w.x), bflo(w.y), bfhi(w.y), bflo(w.z), bfhi(w.z), bflo(w.w), bfhi(w.w)};
        float ss = 0.f;
#pragma unroll
        for (int e = 0; e < 8; ++e) ss += x[e] * x[e];
        ss += __shfl_xor(ss, 1); ss += __shfl_xor(ss, 2); ss += __shfl_xor(ss, 4); ss += __shfl_xor(ss, 8);
        const float rstd = 1.0f / sqrtf(ss * (1.f / 128.f) + NORM_EPS);
        const float* gp = (hi < 16 ? qn : kn) + 8 * li;
        const f32x4 g0 = *(const f32x4*)gp, g1 = *(const f32x4*)(gp + 4);
        x[0] *= rstd * g0.x; x[1] *= rstd * g0.y; x[2] *= rstd * g0.z; x[3] *= rstd * g0.w;
        x[4] *= rstd * g1.x; x[5] *= rstd * g1.y; x[6] *= rstd * g1.z; x[7] *= rstd * g1.w;
        const int t = r % TPB;
        if (t >= CTXL) {
            const int pos = t - CTXL;
            const f32x2* rp = rope + (size_t)pos * 64 + (quarter >> 1) * 32 + (li & 3) * 8;
            const float sgn = (quarter & 1) ? 1.f : -1.f;
#pragma unroll
            for (int e = 0; e < 8; ++e) { const f32x2 cs = rp[e]; const float pv = __shfl_xor(x[e], 4); x[e] = x[e] * cs.x + sgn * pv * cs.y; }
        }
        u32x4 o; o.x = cvt_pk_bf16(x[0], x[1]); o.y = cvt_pk_bf16(x[2], x[3]); o.z = cvt_pk_bf16(x[4], x[5]); o.w = cvt_pk_bf16(x[6], x[7]);
        *(u32x4*)p = o;
    }
}

namespace att {
constexpr int D = 128, NW = 8, QBLK = 32, KVBLK = 64;
constexpr float SCALE = 0.088388347648318440f;
constexpr float THR = 8.f;
constexpr size_t SHM_V = KVBLK * D * 2, SHM_K = KVBLK * D * 2, SHM_ATTN = 2 * SHM_V + 2 * SHM_K + NW * 64 * 4;
#define KSWZ(row, colB) ((row) * 256 + ((colB) ^ (((row) & 7) << 4)))
#define SBAR() __builtin_amdgcn_sched_barrier(0)
__device__ __forceinline__ int crow(int r, int hi) { return (r & 3) + 8 * (r >> 2) + 4 * hi; }
__device__ __forceinline__ void partialSM(f32x16& p0, f32x16& p1, float& m_reg, float& mn, float& alpha) {
  constexpr float C = SCALE * 1.4426950408889634f;
  float pmax = p0[0]; for (int r = 1; r < 16; ++r) pmax = fmaxf(pmax, p0[r]); for (int r = 0; r < 16; ++r) pmax = fmaxf(pmax, p1[r]);
  { auto rr = __builtin_amdgcn_permlane32_swap(__float_as_uint(pmax), __float_as_uint(pmax), false, false);
    pmax = fmaxf(__uint_as_float(rr[0]), __uint_as_float(rr[1])); }
  if (__builtin_expect(__all(pmax - m_reg <= THR / SCALE), 1)) { mn = m_reg; alpha = 1.f; }
  else { mn = fmaxf(m_reg, pmax); alpha = __builtin_amdgcn_exp2f((m_reg - mn) * C); m_reg = mn; }
  float mnC = -mn * C;
  for (int r = 0; r < 16; ++r) p0[r] = fmaf(p0[r], C, mnC); for (int r = 0; r < 16; ++r) p1[r] = fmaf(p1[r], C, mnC);
  for (int r = 0; r < 16; ++r) p0[r] = __builtin_amdgcn_exp2f(p0[r]);
}
__device__ __forceinline__ void finishSM(f32x16& p0, f32x16& p1, float alpha, float& l_reg, bf16x8& pa0, bf16x8& pa1, bf16x8& pa2, bf16x8& pa3) {
  for (int r = 0; r < 16; ++r) p1[r] = __builtin_amdgcn_exp2f(p1[r]);
  float ps = 0; for (int r = 0; r < 16; ++r) ps += p0[r]; for (int r = 0; r < 16; ++r) ps += p1[r];
  { auto rr = __builtin_amdgcn_permlane32_swap(__float_as_uint(ps), __float_as_uint(ps), false, false);
    ps = __uint_as_float(rr[0]) + __uint_as_float(rr[1]); }
  l_reg = l_reg * alpha + ps;
#define PK4(P, BASE, OUT) do { unsigned a0 = cvt_pk_bf16(P[BASE + 0], P[BASE + 1]), a1 = cvt_pk_bf16(P[BASE + 2], P[BASE + 3]);   \
    unsigned b0 = cvt_pk_bf16(P[BASE + 4], P[BASE + 5]), b1 = cvt_pk_bf16(P[BASE + 6], P[BASE + 7]);                              \
    auto r0 = __builtin_amdgcn_permlane32_swap(a0, b0, false, false); auto r1 = __builtin_amdgcn_permlane32_swap(a1, b1, false, false); \
    u32x4 w = {r0[0], r1[0], r0[1], r1[1]}; OUT = *reinterpret_cast<bf16x8*>(&w); } while (0)
  PK4(p0, 0, pa0); PK4(p0, 8, pa1); PK4(p1, 0, pa2); PK4(p1, 8, pa3);
#undef PK4
}
__device__ __forceinline__ void qkt(f32x16& p0, f32x16& p1, const bf16_t* Ks, const bf16x8* qr, int r32, int hi) {
  p0 = f32x16{}; p1 = f32x16{};
  for (int d0 = 0; d0 < 8; ++d0) { int cb = (d0 * 16 + hi * 8) * 2;
    bf16x8 b0 = *reinterpret_cast<const bf16x8*>((const char*)Ks + KSWZ(r32, cb));
    bf16x8 b1 = *reinterpret_cast<const bf16x8*>((const char*)Ks + KSWZ(32 + r32, cb));
    p0 = __builtin_amdgcn_mfma_f32_32x32x16_bf16(b0, qr[d0], p0, 0, 0, 0);
    p1 = __builtin_amdgcn_mfma_f32_32x32x16_bf16(b1, qr[d0], p1, 0, 0, 0); }
}
__device__ __forceinline__ int v_st(int k, int c) { const int kk = (k & ~0xC) | ((k & 4) << 1) | ((k & 8) >> 1); return ((kk >> 3) * 4 + (c >> 5)) * 512 + ((kk & 7) * 32 + (c & 31)) * 2; }
__device__ __forceinline__ int v_rd_base(int lane) { return ((lane & 3) << 3) | (((lane >> 2) & 3) << 6) | (((lane >> 4) & 1) << 5) | (((lane >> 5) & 1) << 8); }
constexpr int v_rd_off(int d0, int ks, int half) { return d0 * 512 + ks * 4096 + half * 2048; }
template <int OFF> __device__ __forceinline__ s16x4 tr_read(int vb) {
  s16x4 r; asm volatile("ds_read_b64_tr_b16 %0, %1 offset:%2" : "=&v"(r) : "v"(vb), "i"(OFF) : "memory"); return r;
}
template <int D0> __device__ __forceinline__ void pv_one(f32x16& od, int vb, bf16x8 pa0, bf16x8 pa1, bf16x8 pa2, bf16x8 pa3) {
  const s16x4 l0 = tr_read<v_rd_off(D0, 0, 0)>(vb), h0 = tr_read<v_rd_off(D0, 0, 1)>(vb), l1 = tr_read<v_rd_off(D0, 1, 0)>(vb), h1 = tr_read<v_rd_off(D0, 1, 1)>(vb);
  const s16x4 l2 = tr_read<v_rd_off(D0, 2, 0)>(vb), h2 = tr_read<v_rd_off(D0, 2, 1)>(vb), l3 = tr_read<v_rd_off(D0, 3, 0)>(vb), h3 = tr_read<v_rd_off(D0, 3, 1)>(vb);
  asm volatile("s_waitcnt lgkmcnt(0)" ::: "memory"); SBAR();
#define PK(L, H) (bf16x8){L[0], L[1], L[2], L[3], H[0], H[1], H[2], H[3]}
  od = __builtin_amdgcn_mfma_f32_32x32x16_bf16(pa0, PK(l0, h0), od, 0, 0, 0);
  od = __builtin_amdgcn_mfma_f32_32x32x16_bf16(pa1, PK(l1, h1), od, 0, 0, 0);
  od = __builtin_amdgcn_mfma_f32_32x32x16_bf16(pa2, PK(l2, h2), od, 0, 0, 0);
  od = __builtin_amdgcn_mfma_f32_32x32x16_bf16(pa3, PK(l3, h3), od, 0, 0, 0);
#undef PK
}
__device__ __forceinline__ void pv_d0(f32x16* o, int vb, bf16x8 pa0, bf16x8 pa1, bf16x8 pa2, bf16x8 pa3) {
  pv_one<0>(o[0], vb, pa0, pa1, pa2, pa3); pv_one<1>(o[1], vb, pa0, pa1, pa2, pa3); pv_one<2>(o[2], vb, pa0, pa1, pa2, pa3); pv_one<3>(o[3], vb, pa0, pa1, pa2, pa3);
}
template <int LDQ, int LDK, int LDO>
__device__ __forceinline__ void attn_dense_body(const bf16_t* __restrict__ Qb, const bf16_t* __restrict__ Kh, const bf16_t* __restrict__ Vh,
                                                bf16_t* __restrict__ Ob, int seq, char* lds) {
  const int tid = threadIdx.x, wid = tid >> 6, lane = tid & 63, r32 = lane & 31, hi = lane >> 5;
  bf16_t* V_lds = (bf16_t*)lds; bf16_t* K_lds = (bf16_t*)(lds + 2 * SHM_V);
  float* ws = (float*)(lds + 2 * SHM_V + 2 * SHM_K) + wid * 64; float* li_l = ws; float* al_l = ws + 32;
  float m_reg = -1e30f, l_reg = 0; f32x16 o[4] = {}; bf16x8 qr[8];
  const bf16_t* Qw = Qb + (long)(wid * QBLK + r32) * LDQ + hi * 8;
#pragma unroll
  for (int d0 = 0; d0 < 8; ++d0) qr[d0] = *reinterpret_cast<const bf16x8*>(Qw + d0 * 16);
  const int sr = tid >> 4, sc = (tid & 15) * 8, vst0 = v_st(sr, sc), vst1 = v_st(32 + sr, sc);
  const int vb0 = (int)(uintptr_t)V_lds + v_rd_base(lane);
  struct { bf16x8 vs0, vs1, ks0, ks1; } sr_[2];
  const unsigned goff0 = (unsigned)(sr * LDK + sc) * 2u, goff1 = (unsigned)((32 + sr) * LDK + sc) * 2u;
  const __amdgpu_buffer_rsrc_t rsK = __builtin_amdgcn_make_buffer_rsrc((void*)Kh, (short)0, seq * (LDK * 2), 0x00020000);
  const __amdgpu_buffer_rsrc_t rsV = __builtin_amdgcn_make_buffer_rsrc((void*)Vh, (short)0, seq * (LDK * 2), 0x00020000);
#define SLOAD(i, k0) do { const unsigned so_ = (unsigned)(k0) * (unsigned)(LDK * 2); \
    sr_[i].vs0 = __builtin_bit_cast(bf16x8, __builtin_amdgcn_raw_buffer_load_b128(rsV, goff0, so_, 0)); sr_[i].vs1 = __builtin_bit_cast(bf16x8, __builtin_amdgcn_raw_buffer_load_b128(rsV, goff1, so_, 0)); \
    sr_[i].ks0 = __builtin_bit_cast(bf16x8, __builtin_amdgcn_raw_buffer_load_b128(rsK, goff0, so_, 0)); sr_[i].ks1 = __builtin_bit_cast(bf16x8, __builtin_amdgcn_raw_buffer_load_b128(rsK, goff1, so_, 0)); } while (0)
#define SWRITE(b, i) do { *(bf16x8*)((char*)V_lds + (b) * SHM_V + vst0) = sr_[i].vs0;          \
    *(bf16x8*)((char*)V_lds + (b) * SHM_V + vst1) = sr_[i].vs1; int kc = sc * 2;               \
    *(bf16x8*)((char*)K_lds + (b) * SHM_K + KSWZ(sr, kc)) = sr_[i].ks0;                       \
    *(bf16x8*)((char*)K_lds + (b) * SHM_K + KSWZ(32 + sr, kc)) = sr_[i].ks1; } while (0)
#define SWAIT() asm volatile("s_waitcnt vmcnt(4)" ::: "memory")
#define RESC(a) do { if (__any((a) < 1.f)) { if (hi == 0) al_l[r32] = (a); asm volatile("s_waitcnt lgkmcnt(0)" ::: "memory"); \
    for (int d = 0; d < 4; ++d) for (int r = 0; r < 16; ++r) o[d][r] *= al_l[crow(r, hi)]; } } while (0)
  f32x16 pA0, pA1, pB0, pB1; float mnA, mnB, alA, alB; bf16x8 pa0, pa1, pa2, pa3; const int NTL = seq / KVBLK;
  constexpr int SE = 0, SO = 1;
  SLOAD(SE, 0); asm volatile("s_waitcnt vmcnt(0)" ::: "memory"); SWRITE(0, SE); __syncthreads();
  qkt(pA0, pA1, K_lds, qr, r32, hi); partialSM(pA0, pA1, m_reg, mnA, alA);
  SLOAD(SO, KVBLK); if (2 < NTL) SLOAD(SE, 2 * KVBLK);
  SWAIT(); SWRITE(1, SO); __syncthreads();
  for (int j = 1; j + 1 < NTL; j += 2) {
    SBAR(); qkt(pB0, pB1, (bf16_t*)((char*)K_lds + SHM_K), qr, r32, hi);
    finishSM(pA0, pA1, alA, l_reg, pa0, pa1, pa2, pa3); SBAR();
    SLOAD(SO, (j + 2) * KVBLK); SBAR();
    pv_d0(o, vb0, pa0, pa1, pa2, pa3); partialSM(pB0, pB1, m_reg, mnB, alB);
    __syncthreads(); SWAIT(); SWRITE(0, SE);
    RESC(alB); __syncthreads();
    SBAR(); qkt(pA0, pA1, K_lds, qr, r32, hi);
    finishSM(pB0, pB1, alB, l_reg, pa0, pa1, pa2, pa3); SBAR();
    if (j + 3 < NTL) SLOAD(SE, (j + 3) * KVBLK); SBAR();
    pv_d0(o, vb0 + (int)SHM_V, pa0, pa1, pa2, pa3); partialSM(pA0, pA1, m_reg, mnA, alA);
    __syncthreads(); SWAIT(); SWRITE(1, SO);
    RESC(alA); __syncthreads();
  }
  SBAR(); qkt(pB0, pB1, (bf16_t*)((char*)K_lds + SHM_K), qr, r32, hi);
  finishSM(pA0, pA1, alA, l_reg, pa0, pa1, pa2, pa3); SBAR();
  pv_d0(o, vb0, pa0, pa1, pa2, pa3); partialSM(pB0, pB1, m_reg, mnB, alB);
  __syncthreads(); RESC(alB);
  finishSM(pB0, pB1, alB, l_reg, pa0, pa1, pa2, pa3); SBAR();
  pv_d0(o, vb0 + (int)SHM_V, pa0, pa1, pa2, pa3);
  if (hi == 0) li_l[r32] = l_reg; asm volatile("s_waitcnt lgkmcnt(0)" ::: "memory");
  float rli[16];
#pragma unroll
  for (int r = 0; r < 16; ++r) rli[r] = __builtin_amdgcn_rcpf(li_l[crow(r, hi)]);
  bf16_t* Ow = Ob + (long)(wid * QBLK) * LDO;
#pragma unroll
  for (int r = 0; r < 16; ++r) { int orow = crow(r, hi);
    for (int d0 = 0; d0 < 4; ++d0) Ow[(long)orow * LDO + d0 * 32 + r32] = (bf16_t)f2bf(o[d0][r] * rli[r]); }
  __syncthreads();
#undef SLOAD
#undef SWRITE
#undef SWAIT
#undef RESC
}
}

__device__ __forceinline__ void gqa_attn_phase(const bf16_t* P, bf16_t* O, char* lds, int G, int bid) {
    constexpr int NBIG = 2048, NSMALL = 256;
    for (int L = bid; L < NBIG + NSMALL; L += G) {
        int b, hq, q0, seq;
        if (L < NBIG) { const int xcd = L & 7, j = (L >> 3) & 31, rnd = L >> 8, bk = rnd * 8 + xcd; b = bk >> 2; const int kvh = bk & 3; hq = kvh * 4 + (j >> 3); q0 = CTXL + (j & 7) * 256; seq = TPB; }
        else { const int l2 = L - NBIG; b = l2 >> 4; hq = l2 & 15; q0 = 0; seq = CTXL; }
        const int kvh = hq >> 2;
        const bf16_t* base = P + (size_t)b * TPB * 3072;
        att::attn_dense_body<3072, 3072, 2048>(base + (size_t)q0 * 3072 + hq * 128, base + 2048 + kvh * 128, base + 2560 + kvh * 128,
                                               O + ((size_t)b * TPB + q0) * DM + hq * 128, seq, lds);
    }
}
__device__ __forceinline__ void diff_attn_phase(const bf16_t* P, bf16_t* OD, char* lds, int G, int bid) {
    for (int L = bid; L < 4096; L += G) {
        const int xcd = L & 7, j = (L >> 3) & 31, rnd = L >> 8, bh = rnd * 8 + xcd, b = bh >> 3, h = bh & 7, qb = j & 7, m = (j >> 3) & 1, half = j >> 4;
        const bf16_t* base = P + (size_t)b * TPB * 6144;
        att::attn_dense_body<6144, 6144, 4096>(base + (size_t)(CTXL + qb * 256) * 6144 + (2 * h + m) * 128, base + 2048 + (2 * h + m) * 128, base + 4096 + h * 256 + half * 128,
                                               OD + ((size_t)b * SEQ + qb * 256) * 4096 + (2 * h + m) * 256 + half * 128, TPB, lds);
    }
}
__device__ __forceinline__ void diff_combine_phase(const bf16_t* OD, bf16_t* O, const float* lq1, const float* lk1, const float* lq2, const float* lk2, const float* gain, int G, int bid) {
    const int tid = threadIdx.x, lane = tid & 63, wave = __builtin_amdgcn_readfirstlane(tid >> 6);
    const float lam_init = 0.8f - 0.6f * 0.54881163609402643f;
    const float d1 = wave_sum(lq1[lane] * lk1[lane] + lq1[lane + 64] * lk1[lane + 64]);
    const float d2 = wave_sum(lq2[lane] * lk2[lane] + lq2[lane + 64] * lk2[lane + 64]);
    const float lam = expf(d1) - expf(d2) + lam_init;
    const float oscale = 1.f - lam_init;
    const int sub = lane >> 5, li = lane & 31;
    const f32x4 g0 = *(const f32x4*)(gain + 8 * li), g1 = *(const f32x4*)(gain + 8 * li + 4);
    const long total = (long)NLAT * 4;
    for (long id = (long)bid * 8 + wave; id < total; id += (long)G * 8) {
        const int lr = (int)(id >> 2), h = (int)(id & 3) * 2 + sub;
        const bf16_t* p = OD + (size_t)lr * 4096 + (2 * h) * 256 + 8 * li;
        const u32x4 a = *(const u32x4*)p, c = *(const u32x4*)(p + 256);
        float x[8] = {bflo(a.x) - lam * bflo(c.x), bfhi(a.x) - lam * bfhi(c.x), bflo(a.y) - lam * bflo(c.y), bfhi(a.y) - lam * bfhi(c.y),
                      bflo(a.z) - lam * bflo(c.z), bfhi(a.z) - lam * bfhi(c.z), bflo(a.w) - lam * bflo(c.w), bfhi(a.w) - lam * bfhi(c.w)};
        float ss = 0.f;
#pragma unroll
        for (int e = 0; e < 8; ++e) ss += x[e] * x[e];
        ss += __shfl_xor(ss, 1); ss += __shfl_xor(ss, 2); ss += __shfl_xor(ss, 4); ss += __shfl_xor(ss, 8); ss += __shfl_xor(ss, 16);
        const float rs = oscale / sqrtf(ss * (1.f / 256.f) + NORM_EPS);
        const int b = lr / SEQ, t = lr - b * SEQ;
        bf16_t* op = O + ((size_t)b * TPB + CTXL + t) * DM + h * 256 + 8 * li;
        u32x4 o; o.x = cvt_pk_bf16(x[0] * rs * g0.x, x[1] * rs * g0.y); o.y = cvt_pk_bf16(x[2] * rs * g0.z, x[3] * rs * g0.w);
        o.z = cvt_pk_bf16(x[4] * rs * g1.x, x[5] * rs * g1.y); o.w = cvt_pk_bf16(x[6] * rs * g1.z, x[7] * rs * g1.w);
        *(u32x4*)op = o;
    }
}

__device__ __forceinline__ float logsigmoidf(float x) { return fminf(x, 0.f) - __logf(1.f + __expf(-fabsf(x))); }
constexpr int G1_ZS = 0, G1_HT = 8192, G1_MS = 12288, G1_QS = 21504, G1_KS = 55296, G1_VS = 21504;
template <int DIR>
__device__ __forceinline__ void gla_prep_dir(const bf16_t* P, const float* wg, const float* bg, bf16_t* QT, bf16_t* KTT, float* CM, float* CL, LAS unsigned char* lds,
                                             int b, int h, int c, int R0, f32x4 (&accOut)[2]) {
    const int tid = threadIdx.x, lane = tid & 63, wave = __builtin_amdgcn_readfirstlane(tid >> 6), d = tid & 255, half = tid >> 8;
    LAS float* ZS = (LAS float*)(lds + G1_ZS); LAS float* HT = (LAS float*)(lds + G1_HT);
    LAS bf16_t* QS = (LAS bf16_t*)(lds + G1_QS); LAS bf16_t* KS = (LAS bf16_t*)(lds + G1_KS);
    float wcol[16];
#pragma unroll
    for (int kk = 0; kk < 16; ++kk) wcol[kk] = wg[kk * 1024 + 256 * h + d];
    const float bias = bg[256 * h + d];
    float cum[32];
#pragma unroll
    for (int ii = 0; ii < 32; ++ii) {
        const LAS float* zr = ZS + (half * 32 + ii) * 32 + DIR * 16;
        const f32x4 z0 = *(const LAS f32x4*)zr, z1 = *(const LAS f32x4*)(zr + 4), z2 = *(const LAS f32x4*)(zr + 8), z3 = *(const LAS f32x4*)(zr + 12);
        float x = bias;
        x += z0.x * wcol[0] + z0.y * wcol[1] + z0.z * wcol[2] + z0.w * wcol[3];
        x += z1.x * wcol[4] + z1.y * wcol[5] + z1.z * wcol[6] + z1.w * wcol[7];
        x += z2.x * wcol[8] + z2.y * wcol[9] + z2.z * wcol[10] + z2.w * wcol[11];
        x += z3.x * wcol[12] + z3.y * wcol[13] + z3.z * wcol[14] + z3.w * wcol[15];
        cum[ii] = logsigmoidf(x) * 0.0625f;
    }
    float total;
    if (DIR == 0) {
#pragma unroll
        for (int ii = 1; ii < 32; ++ii) cum[ii] += cum[ii - 1];
        total = cum[31];
    } else {
#pragma unroll
        for (int ii = 30; ii >= 0; --ii) cum[ii] += cum[ii + 1];
        total = cum[0];
    }
    HT[(DIR * 2 + half) * 256 + d] = total;
    __syncthreads();
    const float t0 = HT[(DIR * 2 + 0) * 256 + d], t1 = HT[(DIR * 2 + 1) * 256 + d];
    const float cmid = DIR == 0 ? t0 : t1, clast = t0 + t1;
    const float add = DIR == 0 ? (half == 1 ? t0 : 0.f) : (half == 0 ? t1 : 0.f);
    unsigned kpack[16];
    const bf16_t* qp = P + (size_t)(R0 + half * 32) * 6144 + 256 * h + d;
    bf16_t* qtp = QT + ((size_t)DIR * NT + R0 + half * 32) * 1024 + 256 * h + d;
#pragma unroll
    for (int ii = 0; ii < 32; ++ii) {
        const float cu = cum[ii] + add;
        const float qv = bf2f(qp[(size_t)ii * 6144]), kv = bf2f(qp[(size_t)ii * 6144 + 1024]);
        const unsigned qb = f2bf(qv * 0.0625f * __expf(cu - cmid)), kb = f2bf(kv * __expf(cmid - cu));
        qtp[(size_t)ii * 1024] = (bf16_t)qb;
        QS[(half * 32 + ii) * 264 + d] = (bf16_t)qb; KS[(half * 32 + ii) * 264 + d] = (bf16_t)kb;
        if (ii & 1) kpack[ii >> 1] |= kb << 16; else kpack[ii >> 1] = kb;
        if ((ii & 3) == 3) asm volatile("" ::: "memory");
    }
    {
        bf16_t* kt = KTT + (((((size_t)DIR * NB + b) * 36 + c) * 4 + h) * 256 + d) * 64 + half * 32;
#pragma unroll
        for (int q = 0; q < 4; ++q) *(u32x4*)(kt + 8 * q) = (u32x4){kpack[4 * q], kpack[4 * q + 1], kpack[4 * q + 2], kpack[4 * q + 3]};
    }
    if (half == 0) { const size_t vi = (((size_t)DIR * NB + b) * 36 + c) * 1024 + 256 * h + d; CM[vi] = cmid; CL[vi] = clast; }
    __syncthreads();
    const int ti = wave >> 1, tj0 = (wave & 1) * 2, fr = lane & 15, fq = lane >> 4;
#pragma unroll
    for (int x = 0; x < 2; ++x) {
        f32x4 acc = {0.f, 0.f, 0.f, 0.f};
#pragma unroll
        for (int ks = 0; ks < 8; ++ks) {
            const bf16x8 av = *(const LAS bf16x8*)(QS + (16 * ti + fr) * 264 + 32 * ks + 8 * fq);
            const bf16x8 bv = *(const LAS bf16x8*)(KS + (16 * (tj0 + x) + fr) * 264 + 32 * ks + 8 * fq);
            acc = __builtin_amdgcn_mfma_f32_16x16x32_bf16(av, bv, acc, 0, 0, 0);
        }
        accOut[x] = acc;
    }
    __syncthreads();
}
__device__ __forceinline__ void gla_prep_phase(const bf16_t* P, const float* Z, const float* wgf, const float* bgf, const float* wgb, const float* bgb,
                                               bf16_t* QT, bf16_t* KTT, bf16_t* VT, float* CM, float* CL, float* O32, LAS unsigned char* lds, int G, int bid) {
    const int tid = threadIdx.x, lane = tid & 63, wave = __builtin_amdgcn_readfirstlane(tid >> 6), fr = lane & 15, fq = lane >> 4;
    LAS float* ZS = (LAS float*)(lds + G1_ZS);
    LAS bf16_t* MS = (LAS bf16_t*)(lds + G1_MS);
    LAS bf16_t* VSw = (LAS bf16_t*)(lds + G1_VS) + wave * (64 * 72);
    for (int u = bid; u < NB * 4 * 36; u += G) {
        const int b = u / 144, rem = u - b * 144, h = rem / 36, c = rem - h * 36, R0 = b * TPB + 64 * c;
        { const int row = tid >> 3, c4 = (tid & 7) * 4; *(LAS f32x4*)(ZS + row * 32 + c4) = *(const f32x4*)(Z + (size_t)(R0 + row) * 32 + c4); }
        __syncthreads();
        f32x4 accF[2], accB[2];
        gla_prep_dir<0>(P, wgf, bgf, QT, KTT, CM, CL, lds, b, h, c, R0, accF);
        gla_prep_dir<1>(P, wgb, bgb, QT, KTT, CM, CL, lds, b, h, c, R0, accB);
        const int ti = wave >> 1, tj0 = (wave & 1) * 2;
#pragma unroll
        for (int x = 0; x < 2; ++x)
#pragma unroll
            for (int r = 0; r < 4; ++r) { const int i = 16 * ti + 4 * fq + r, j = 16 * (tj0 + x) + fr;
                const float m = (j <= i ? accF[x][r] : 0.f) + (j >= i ? accB[x][r] : 0.f);
                MS[i * 72 + j] = (bf16_t)f2bf(m); }
#pragma unroll
        for (int it = 0; it < 8; ++it) { const int q = it * 64 + lane, j = q >> 3, ec = (q & 7) * 8;
            const u32x4 w = *(const u32x4*)(P + (size_t)(R0 + j) * 6144 + 2048 + 512 * h + 64 * wave + ec);
            VSw[(ec + 0) * 72 + j] = (bf16_t)(w.x & 0xffff); VSw[(ec + 1) * 72 + j] = (bf16_t)(w.x >> 16);
            VSw[(ec + 2) * 72 + j] = (bf16_t)(w.y & 0xffff); VSw[(ec + 3) * 72 + j] = (bf16_t)(w.y >> 16);
            VSw[(ec + 4) * 72 + j] = (bf16_t)(w.z & 0xffff); VSw[(ec + 5) * 72 + j] = (bf16_t)(w.z >> 16);
            VSw[(ec + 6) * 72 + j] = (bf16_t)(w.w & 0xffff); VSw[(ec + 7) * 72 + j] = (bf16_t)(w.w >> 16); }
        __syncthreads();
        {
            bf16_t* vt = VT + ((((size_t)b * 36 + c) * 4 + h) * 512 + 64 * wave) * 64;
#pragma unroll
            for (int it = 0; it < 8; ++it) { const int q = it * 64 + lane, e = q >> 3, jc = (q & 7) * 8;
                *(u32x4*)(vt + (size_t)e * 64 + jc) = *(const LAS u32x4*)(VSw + e * 72 + jc); }
        }
        f32x4 oacc[4][4];
#pragma unroll
        for (int a = 0; a < 4; ++a)
#pragma unroll
            for (int bb = 0; bb < 4; ++bb) oacc[a][bb] = (f32x4){0.f, 0.f, 0.f, 0.f};
#pragma unroll
        for (int ks = 0; ks < 2; ++ks) {
            bf16x8 av[4], bv[4];
#pragma unroll
            for (int t = 0; t < 4; ++t) { av[t] = *(const LAS bf16x8*)(MS + (16 * t + fr) * 72 + 32 * ks + 8 * fq); bv[t] = *(const LAS bf16x8*)(VSw + (16 * t + fr) * 72 + 32 * ks + 8 * fq); }
#pragma unroll
            for (int a = 0; a < 4; ++a)
#pragma unroll
                for (int bb = 0; bb < 4; ++bb) oacc[a][bb] = __builtin_amdgcn_mfma_f32_16x16x32_bf16(av[a], bv[bb], oacc[a][bb], 0, 0, 0);
        }
#pragma unroll
        for (int a = 0; a < 4; ++a)
#pragma unroll
            for (int r = 0; r < 4; ++r) { float* op = O32 + (size_t)(R0 + 16 * a + 4 * fq + r) * 2048 + 512 * h + 64 * wave + fr;
#pragma unroll
                for (int bb = 0; bb < 4; ++bb) op[16 * bb] = oacc[a][bb][r]; }
        __syncthreads();
    }
}
__device__ __forceinline__ void gla_scan_phase(const bf16_t* QT, const bf16_t* KTT, const bf16_t* VT, const float* CM, const float* CL, float* O32, LAS unsigned char* lds, int G, int bid) {
    const int tid = threadIdx.x, lane = tid & 63, wave = __builtin_amdgcn_readfirstlane(tid >> 6), fr = lane & 15, fq = lane >> 4;
    const int ti = wave >> 1, tj0 = (wave & 1) * 2;
    for (int u = bid; u < 512; u += G) {
        const int b = u >> 5, h = (u >> 3) & 3, sl = u & 7;
        for (int dir = 0; dir < 2; ++dir) {
            f32x4 S[2][4];
#pragma unroll
            for (int t = 0; t < 2; ++t)
#pragma unroll
                for (int uu = 0; uu < 4; ++uu) S[t][uu] = (f32x4){0.f, 0.f, 0.f, 0.f};
            for (int s = 0; s < 36; ++s) {
                const int c = dir == 0 ? s : (s < 4 ? 3 - s : 39 - s);
                const int R0 = b * TPB + 64 * c;
                const size_t vb = (((size_t)dir * NB + b) * 36 + c) * 1024 + 256 * h + 32 * wave + 4 * fq;
                f32x4 cm[2], cl[2];
#pragma unroll
                for (int t = 0; t < 2; ++t) { cm[t] = *(const f32x4*)(CM + vb + 16 * t); cl[t] = *(const f32x4*)(CL + vb + 16 * t); }
                LAS bf16_t* STb = (LAS bf16_t*)lds + (s & 1) * (64 * 264);
#pragma unroll
                for (int t = 0; t < 2; ++t) { const f32x4 e = {__expf(cm[t].x), __expf(cm[t].y), __expf(cm[t].z), __expf(cm[t].w)};
#pragma unroll
                    for (int uu = 0; uu < 4; ++uu) { const f32x4 v = S[t][uu] * e; u32x2 w; w.x = cvt_pk_bf16(v.x, v.y); w.y = cvt_pk_bf16(v.z, v.w);
                        *(LAS u32x2*)(STb + (16 * uu + fr) * 264 + 32 * wave + 16 * t + 4 * fq) = w; } }
                __syncthreads();
                f32x4 oa[2] = {(f32x4){0.f, 0.f, 0.f, 0.f}, (f32x4){0.f, 0.f, 0.f, 0.f}};
                const bf16_t* qrow = QT + ((size_t)dir * NT + R0 + 16 * ti + fr) * 1024 + 256 * h + 8 * fq;
#pragma unroll
                for (int ks = 0; ks < 8; ++ks) { const bf16x8 av = *(const bf16x8*)(qrow + 32 * ks);
#pragma unroll
                    for (int x = 0; x < 2; ++x) { const bf16x8 bv = *(const LAS bf16x8*)(STb + (16 * (tj0 + x) + fr) * 264 + 32 * ks + 8 * fq);
                        oa[x] = __builtin_amdgcn_mfma_f32_16x16x32_bf16(av, bv, oa[x], 0, 0, 0); } }
#pragma unroll
                for (int x = 0; x < 2; ++x)
#pragma unroll
                    for (int r = 0; r < 4; ++r) { float* op = O32 + (size_t)(R0 + 16 * ti + 4 * fq + r) * 2048 + 512 * h + 64 * sl + 16 * (tj0 + x) + fr; *op += oa[x][r]; }
                f32x4 Pm[2][4];
#pragma unroll
                for (int t = 0; t < 2; ++t)
#pragma unroll
                    for (int uu = 0; uu < 4; ++uu) Pm[t][uu] = (f32x4){0.f, 0.f, 0.f, 0.f};
                const bf16_t* kb = KTT + (((((size_t)dir * NB + b) * 36 + c) * 4 + h) * 256 + 32 * wave + fr) * 64 + 8 * fq;
                const bf16_t* vbp = VT + ((((size_t)b * 36 + c) * 4 + h) * 512 + 64 * sl + fr) * 64 + 8 * fq;
#pragma unroll
                for (int ks = 0; ks < 2; ++ks) {
                    bf16x8 av[2], bv[4];
#pragma unroll
                    for (int t = 0; t < 2; ++t) av[t] = *(const bf16x8*)(kb + t * 1024 + 32 * ks);
#pragma unroll
                    for (int uu = 0; uu < 4; ++uu) bv[uu] = *(const bf16x8*)(vbp + uu * 1024 + 32 * ks);
#pragma unroll
                    for (int t = 0; t < 2; ++t)
#pragma unroll
                        for (int uu = 0; uu < 4; ++uu) Pm[t][uu] = __builtin_amdgcn_mfma_f32_16x16x32_bf16(av[t], bv[uu], Pm[t][uu], 0, 0, 0);
                }
#pragma unroll
                for (int t = 0; t < 2; ++t) {
                    const f32x4 dec = {__expf(cl[t].x), __expf(cl[t].y), __expf(cl[t].z), __expf(cl[t].w)};
                    const f32x4 ksc = {__expf(cl[t].x - cm[t].x), __expf(cl[t].y - cm[t].y), __expf(cl[t].z - cm[t].z), __expf(cl[t].w - cm[t].w)};
#pragma unroll
                    for (int uu = 0; uu < 4; ++uu) S[t][uu] = S[t][uu] * dec + Pm[t][uu] * ksc;
                }
            }
            __syncthreads();
        }
    }
}
__device__ __forceinline__ void gla_finish_phase(const float* O32, const bf16_t* P, const float* gain, bf16_t* O, int G, int bid) {
    const int tid = threadIdx.x, lane = tid & 63, wave = __builtin_amdgcn_readfirstlane(tid >> 6);
    const f32x4 g0 = *(const f32x4*)(gain + 8 * lane), g1 = *(const f32x4*)(gain + 8 * lane + 4);
    const long total = (long)NT * 4;
    for (long id = (long)bid * 8 + wave; id < total; id += (long)G * 8) {
        const int r = (int)(id >> 2), h = (int)(id & 3);
        const float* op = O32 + (size_t)r * 2048 + 512 * h + 8 * lane;
        const f32x4 a = *(const f32x4*)op, c = *(const f32x4*)(op + 4);
        const float ss = wave_sum((a.x * a.x + a.y * a.y) + (a.z * a.z + a.w * a.w) + (c.x * c.x + c.y * c.y) + (c.z * c.z + c.w * c.w));
        const float rs = 1.0f / sqrtf(ss * (1.f / 512.f) + NORM_EPS);
        const u32x4 rw = *(const u32x4*)(P + (size_t)r * 6144 + 4096 + 512 * h + 8 * lane);
        u32x4 o;
        o.x = cvt_pk_bf16(a.x * rs * g0.x * siluf(bflo(rw.x)), a.y * rs * g0.y * siluf(bfhi(rw.x)));
        o.y = cvt_pk_bf16(a.z * rs * g0.z * siluf(bflo(rw.y)), a.w * rs * g0.w * siluf(bfhi(rw.y)));
        o.z = cvt_pk_bf16(c.x * rs * g1.x * siluf(bflo(rw.z)), c.y * rs * g1.y * siluf(bfhi(rw.z)));
        o.w = cvt_pk_bf16(c.z * rs * g1.z * siluf(bflo(rw.w)), c.w * rs * g1.w * siluf(bfhi(rw.w)));
        *(u32x4*)(O + (size_t)r * DM + 512 * h + 8 * lane) = o;
    }
}

constexpr int NPH = 34;
template <int L> __device__ __forceinline__ int c_in(int which) {
    constexpr int base = L == 0 ? 4 : L == 1 ? 17 : L == 2 ? 27 : 42;
    constexpr int n2 = L == 0 ? 14 : L == 1 ? 24 : L == 2 ? 39 : 46;
    return which < 3 ? base + which : n2 + (which - 3);
}
__global__ void __launch_bounds__(512, 2) fwd_kernel(KArgs a) {
    extern __shared__ __attribute__((aligned(16))) unsigned char lds_raw[];
    LAS unsigned char* lds = (LAS unsigned char*)lds_raw;
    const int tid = threadIdx.x, G = gridDim.x, bid = blockIdx.x;
    if (tid < 16) ((LAS unsigned*)(lds + MISC_OFF))[tid] = 0u;
    __syncthreads();
    unsigned* barw = (unsigned*)(a.ws + WS_CTL) + 4096;
    XcdBarrier bar; bar.bar = barw; bar.x = 0; bar.st = (volatile LAS unsigned*)(lds + MISC_OFF);
    if (N_LAUNCH_MODE == 1) bar = xcd_barrier_post(barw, (volatile LAS unsigned*)(lds + MISC_OFF));
    const int lo = a.ph_lo, hi = a.ph_hi;
#ifndef PHSEL
#define PHSEL -1
#endif
#define IN(k) ((PHSEL < 0 || PHSEL == (k)) && lo <= (k) && (k) < hi)
#define SEAM(k) do { if (IN(k) && IN((k) + 1)) xcd_barrier(bar); } while (0)

#define p_ws (a.ws)
#define p_modv ((float*)(a.ws + WS_MODV))
#define p_rope ((const f32x2*)(a.ws + WS_ROPE))
#define p_DFT1 ((bf16_t*)(a.ws + WS_DFT1))
#define p_DFT2 ((bf16_t*)(a.ws + WS_DFT2))
#define p_Wf1 ((bf16_t*)(a.ws + W_FFN1))
#define p_Wf2 ((bf16_t*)(a.ws + W_FFN2))
#define p_Win ((bf16_t*)(a.ws + W_IN))
#define p_Wout ((bf16_t*)(a.ws + W_OUT))
#define p_xctx ((float*)(a.ws + WS_XCTX))
#define p_HN ((bf16_t*)(a.ws + WS_HN))
#define p_OB ((bf16_t*)(a.ws + WS_O))
#define p_BIG ((bf16_t*)(a.ws + WS_BIG))
#define p_out (a.out)

#define PH_PREP(k, L, WI, NIN, WO, LATONLY) if (IN(k)) { \
        convert_layer(a, lds, G, bid, a.in[c_in<L>(4)], a.in[c_in<L>(5)], WI, NIN, WO); \
        norm_phase(L == 0 ? a.in[0] : p_out, L == 0 ? a.in[2] : p_xctx, a.in[c_in<L>(2)], p_modv + (size_t)L * 17 * 12288, 0, 2048, p_HN, LATONLY, G, bid); } SEAM(k)
#define PH_PROJ(k, NN, LDC, ZT, ZP) if (IN(k)) { \
        ProbStd g{p_HN, p_Win, DM, DM, DM, 0}; pg8::UOrder S; S.init(144, NN, 1, G, bid); EpiProj E{p_BIG, LDC, ZT, ZP}; \
        pg8::gemm_phase<ProbStd, EpiProj>(lds, g, S, E); } SEAM(k)
#define PH_OUT(k, L, AMAP) if (IN(k)) { \
        ProbStd g{p_OB, p_Wout, DM, DM, DM, AMAP}; pg8::UOrder S; S.init(AMAP ? 128 : 144, 8, 1, G, bid); \
        EpiRes E{L == 0 ? a.in[0] : p_out, L == 0 ? a.in[2] : p_xctx, p_out, p_xctx, p_modv + (size_t)L * 17 * 12288, 4096, AMAP}; \
        pg8::gemm_phase<ProbStd, EpiRes>(lds, g, S, E); } SEAM(k)
#define PH_NORM2(k, L, AMAP) if (IN(k)) { \
        norm_phase(p_out, p_xctx, a.in[c_in<L>(3)], p_modv + (size_t)L * 17 * 12288, 6144, 8192, p_HN, AMAP, G, bid); } SEAM(k)
#define PH_FFN1(k, L, AMAP) if (IN(k)) { \
        ProbStd g{p_HN, p_Wf1, DM, DM, DM, AMAP}; pg8::UOrder S; S.init(AMAP ? 128 : 144, 44, 1, G, bid); EpiSwiGLU E{p_BIG, AMAP}; \
        pg8::gemm_phase<ProbStd, EpiSwiGLU>(lds, g, S, E); } SEAM(k)
#define PH_FFN2(k, L, AMAP) if (IN(k)) { \
        ProbStd g{p_BIG, p_Wf2, FF, FF, FF, AMAP}; pg8::UOrder S; S.init(AMAP ? 128 : 144, 8, 1, G, bid); \
        EpiRes E{p_out, p_xctx, p_out, p_xctx, p_modv + (size_t)L * 17 * 12288, 10240, AMAP}; \
        pg8::gemm_phase<ProbStd, EpiRes>(lds, g, S, E); } SEAM(k)

    if (IN(0)) { ph_prologue(a, lds, G, bid); } SEAM(0);

    PH_PREP(1, 0, a.in[7], 6176, a.in[13], 0);
    PH_PROJ(2, 25, 6144, 24, (float*)(p_ws + WS_Z));
    {
        bf16_t* QT = (bf16_t*)(p_ws + WS_O); bf16_t* KTT = (bf16_t*)(p_ws + WS_KTT); bf16_t* VT = (bf16_t*)(p_ws + WS_HN);
        float* CM = (float*)(p_ws + WS_CMCL); float* CL = CM + (size_t)2 * NB * 36 * 1024; float* O32 = (float*)(p_ws + WS_O32);
        if (IN(3)) { gla_prep_phase(p_BIG, (const float*)(p_ws + WS_Z), a.in[8], a.in[9], a.in[10], a.in[11], QT, KTT, VT, CM, CL, O32, lds, G, bid); } SEAM(3);
        if (IN(4)) { gla_scan_phase(QT, KTT, VT, CM, CL, O32, lds, G, bid); } SEAM(4);
        if (IN(5)) { gla_finish_phase(O32, p_BIG, a.in[12], p_OB, G, bid); } SEAM(5);
    }
    PH_OUT(6, 0, 0);
    PH_NORM2(7, 0, 0);
    PH_FFN1(8, 0, 0);
    PH_FFN2(9, 0, 0);

    PH_PREP(10, 1, a.in[20], 3072, a.in[23], 0);
    PH_PROJ(11, 12, 3072, -1, nullptr);
    if (IN(12)) { qknorm_rope_phase(p_BIG, 3072, 20, a.in[21], a.in[22], p_rope, G, bid); } SEAM(12);
    if (IN(13)) { gqa_attn_phase(p_BIG, p_OB, (char*)lds_raw, G, bid); } SEAM(13);
    PH_OUT(14, 1, 0);
    PH_NORM2(15, 1, 0);
    PH_FFN1(16, 1, 0);
    PH_FFN2(17, 1, 0);

    PH_PREP(18, 2, a.in[30], 6144, a.in[38], 0);
    PH_PROJ(19, 24, 6144, -1, nullptr);
    if (IN(20)) { qknorm_rope_phase(p_BIG, 6144, 32, a.in[31], a.in[32], p_rope, G, bid); } SEAM(20);
    if (IN(21)) { diff_attn_phase(p_BIG, (bf16_t*)(p_ws + WS_GX), (char*)lds_raw, G, bid); } SEAM(21);
    if (IN(22)) { diff_combine_phase((const bf16_t*)(p_ws + WS_GX), p_OB, a.in[33], a.in[34], a.in[35], a.in[36], a.in[37], G, bid); } SEAM(22);
    PH_OUT(23, 2, 1);
    PH_NORM2(24, 2, 1);
    PH_FFN1(25, 2, 1);
    PH_FFN2(26, 2, 1);

    PH_PREP(27, 3, nullptr, 0, a.in[45], 1);
    if (IN(28)) { ProbF1 g{p_DFT1, p_HN, 512, DM, 512}; pg8::UOrder S; S.init(4, 8, 64, G, bid); EpiF1 E{p_BIG}; pg8::gemm_phase<ProbF1, EpiF1>(lds, g, S, E); } SEAM(28);
    if (IN(29)) { ProbF2 g{p_DFT2, p_BIG, 4096, 4096, 4096}; pg8::UOrder S; S.init(8, 8, 16, G, bid); EpiF2 E{p_OB}; pg8::gemm_phase<ProbF2, EpiF2>(lds, g, S, E); } SEAM(29);
    PH_OUT(30, 3, 1);
    PH_NORM2(31, 3, 1);
    PH_FFN1(32, 3, 1);
    PH_FFN2(33, 3, 1);
#undef IN
#undef SEAM
#undef p_ws
#undef p_modv
#undef p_rope
#undef p_DFT1
#undef p_DFT2
#undef p_Wf1
#undef p_Wf2
#undef p_Win
#undef p_Wout
#undef p_xctx
#undef p_HN
#undef p_OB
#undef p_BIG
#undef p_out
}

extern "C" void kernel_launch(void* const* d_in, const int* in_sizes, int n_in, void* d_out, int out_size, void* d_ws, size_t ws_size, hipStream_t stream) {
    static int grid = 0;
    if (grid == 0) {
        if (n_in != 49 || out_size != NLAT * DM || ws_size < WS_END) { fprintf(stderr, "kernel_launch: unexpected shapes: n_in %d out %d ws %zu (need >= %zu)\n", n_in, out_size, ws_size, (size_t)WS_END); grid = -1; return; }
        int dev = 0, cus = 0, per_cu = 0;
        if (hipGetDevice(&dev) != hipSuccess || hipDeviceGetAttribute(&cus, hipDeviceAttributeMultiprocessorCount, dev) != hipSuccess) { grid = -1; return; }
        if (hipFuncSetAttribute((const void*)fwd_kernel, hipFuncAttributeMaxDynamicSharedMemorySize, LDS_BYTES) != hipSuccess) { fprintf(stderr, "kernel_launch: hipFuncSetAttribute failed\n"); grid = -1; return; }
        if (hipOccupancyMaxActiveBlocksPerMultiprocessor(&per_cu, (const void*)fwd_kernel, 512, LDS_BYTES) != hipSuccess || per_cu < 1) { fprintf(stderr, "kernel_launch: occupancy query says %d\n", per_cu); }
        (void)hipGetLastError();
        grid = cus;
    }
    if (grid < 0) return;
    (void)hipMemsetAsync((char*)d_ws + WS_CTL, 0, CTL_ZERO_BYTES, stream);
    KArgs a{};
    for (int i = 0; i < 49; ++i) a.in[i] = (const float*)d_in[i];
    a.out = (float*)d_out; a.ws = (unsigned char*)d_ws;
#if N_LAUNCH_MODE == 1
    a.ph_lo = 0; a.ph_hi = NPH;
    hipLaunchKernelGGL(fwd_kernel, dim3(grid), dim3(512), LDS_BYTES, stream, a);
#else
    for (int k = 0; k < NPH; ++k) { a.ph_lo = k; a.ph_hi = k + 1; hipLaunchKernelGGL(fwd_kernel, dim3(grid), dim3(512), LDS_BYTES, stream, a); }
#endif
    const hipError_t le = hipPeekAtLastError();
    if (le != hipSuccess) fprintf(stderr, "kernel_launch: launch failed: %s\n", hipGetErrorName(le));
}
```

```cpp
#include <hip/hip_runtime.h>
#include <cstdio>
#include <cstdint>

#define LAS __attribute__((address_space(3)))
typedef unsigned short bf16_t;
typedef short bf16x8 __attribute__((ext_vector_type(8)));
typedef short s16x4 __attribute__((ext_vector_type(4)));
typedef float f32x4 __attribute__((ext_vector_type(4)));
typedef float f32x2 __attribute__((ext_vector_type(2)));
typedef float f32x16 __attribute__((ext_vector_type(16)));
typedef unsigned u32x4 __attribute__((ext_vector_type(4)));
typedef unsigned u32x2 __attribute__((ext_vector_type(2)));
typedef _Float16 f16x2 __attribute__((ext_vector_type(2)));

#ifndef N_LAUNCH_MODE
#define N_LAUNCH_MODE 1
#endif

constexpr int NB = 16, SEQ = 2048, DM = 2048, CTXL = 256, TPB = 2304  , NT = NB * TPB, FF = 5632;
constexpr int NLAT = NB * SEQ;
constexpr float NORM_EPS = 1e-6f;

constexpr size_t MiB = 1u << 20;
constexpr size_t WS_CTL = 0, CTL_ZERO_BYTES = 65536;
constexpr size_t WS_MODV = 1 * MiB;
constexpr size_t WS_ROPE = 5 * MiB;
constexpr size_t WS_DFT1 = 6 * MiB;
constexpr size_t WS_DFT2 = 7 * MiB;
constexpr size_t WS_W = 24 * MiB;
constexpr size_t W_FFN1 = WS_W, W_FFN2 = WS_W + 44 * MiB, W_IN = WS_W + 66 * MiB, W_OUT = WS_W + 91 * MiB;
constexpr size_t WS_XCTX = 128 * MiB;
constexpr size_t WS_HN = 160 * MiB;
constexpr size_t WS_O = 304 * MiB;
constexpr size_t WS_BIG = 448 * MiB;
constexpr size_t WS_GX = 880 * MiB;
constexpr size_t WS_KTT = WS_GX, WS_CMCL = WS_GX + 144 * MiB, WS_Z = WS_GX + 154 * MiB;
constexpr size_t WS_O32 = 1039 * MiB;
constexpr size_t WS_W3F1 = 1280 * MiB, WS_W3F2 = 128 * MiB;
constexpr size_t WS_XH = 1136 * MiB;
constexpr size_t WS_XHC = 1264 * MiB;
constexpr size_t WS_END = 1327 * MiB;

constexpr int RING_BYTES = 131072;
constexpr int LDS_BYTES = 147456;
constexpr int MISC_OFF = LDS_BYTES - 64;

__device__ __forceinline__ unsigned f2bf(float f) { unsigned u = __builtin_bit_cast(unsigned, f); return (u + 0x7fffu + ((u >> 16) & 1u)) >> 16; }
__device__ __forceinline__ unsigned pk2(float lo, float hi) { return f2bf(lo) | (f2bf(hi) << 16); }
__device__ __forceinline__ float bf2f(unsigned short b) { return __builtin_bit_cast(float, ((unsigned)b) << 16); }
__device__ __forceinline__ float bflo(unsigned w) { return __builtin_bit_cast(float, w << 16); }
__device__ __forceinline__ float bfhi(unsigned w) { return __builtin_bit_cast(float, w & 0xffff0000u); }
__device__ __forceinline__ unsigned cvt_pk_bf16(float lo, float hi) { unsigned r; asm volatile("v_cvt_pk_bf16_f32 %0, %1, %2" : "=v"(r) : "v"(lo), "v"(hi)); return r; }
__device__ __forceinline__ float wave_sum(float v) {
#pragma unroll
    for (int o = 1; o < 64; o <<= 1) v += __shfl_xor(v, o);
    return v;
}
__device__ __forceinline__ float siluf(float v) { return v * __builtin_amdgcn_rcpf(1.f + __expf(-v)); }
__device__ __forceinline__ int opaque_tid() { int t = threadIdx.x; asm volatile("" : "+v"(t)); return t; }
#define LDS_WAIT() asm volatile("s_waitcnt lgkmcnt(0)" ::: "memory")
#define VM_WAIT() asm volatile("s_waitcnt vmcnt(0)" ::: "memory")

#define XB_TMO      128
#define XB_XCNT(j)  (256  + 64 * (j))
#define XB_XSUB(j)  (1280 + 64 * (j))
#define XB_XGEN(j)  (2304 + 64 * (j))
#define XB_TOP      3328
#define XB_TOPGEN   3392
#define XCD_BAR_WORDS 3456
#define XB_SPIN_CAP (1u << 24)
__device__ __forceinline__ unsigned xb_ld(unsigned* p)              { return __hip_atomic_load(p, __ATOMIC_RELAXED, __HIP_MEMORY_SCOPE_AGENT); }
__device__ __forceinline__ unsigned xb_add(unsigned* p, unsigned v) { return __hip_atomic_fetch_add(p, v, __ATOMIC_RELAXED, __HIP_MEMORY_SCOPE_AGENT); }
__device__ __forceinline__ unsigned xb_xcc_id() { return (unsigned)__builtin_amdgcn_s_getreg((3 << 11) | 20) & 0xFu; }
#define XB_SPIN(cond, bar) do { unsigned _sp = 0; while (cond) { __builtin_amdgcn_s_sleep(1); \
    if ((++_sp & 255u) == 0u) { if (xb_ld(&(bar)[XB_TMO])) break; if (_sp > XB_SPIN_CAP) { atomicAdd(&(bar)[XB_TMO], 1u); break; } } } } while (0)
struct XcdBarrier { unsigned* bar; unsigned x; volatile LAS unsigned* st; };
__device__ __forceinline__ XcdBarrier xcd_barrier_post(unsigned* bar, volatile LAS unsigned* st) {
    XcdBarrier b; b.bar = bar; b.x = xb_xcc_id(); b.st = st;
    if (threadIdx.x == 0) (void)xb_add(&bar[XB_XCNT(b.x)], 1u);
    return b;
}
__device__ __forceinline__ void xcd_barrier_complete(unsigned* bar, unsigned x, unsigned& nloc, unsigned& nx) {
    const unsigned G = gridDim.x * gridDim.y * gridDim.z;
    unsigned sum, cnt, mine, sp = 0u;
    for (;;) {
        sum = 0u; cnt = 0u; mine = 0u;
#pragma unroll
        for (unsigned j = 0; j < 16; ++j) { const unsigned c = xb_ld(&bar[XB_XCNT(j)]); sum += c; cnt += (c > 0u) ? 1u : 0u; mine = (j == x) ? c : mine; }
        if (sum == G) break;
        __builtin_amdgcn_s_sleep(1);
        if ((++sp & 255u) == 0u) { if (xb_ld(&bar[XB_TMO])) break; if (sp > XB_SPIN_CAP) { atomicAdd(&bar[XB_TMO], 1u); break; } }
    }
    nloc = mine > 0u ? mine : 1u; nx = cnt > 0u ? cnt : 1u;
}
__device__ __forceinline__ void xcd_barrier(const XcdBarrier& b) {
    asm volatile("s_waitcnt vmcnt(0)" ::: "memory");
    __syncthreads();
    if (threadIdx.x == 0) {
        unsigned* bar = b.bar;
        __builtin_amdgcn_s_waitcnt(0);
        unsigned nloc = b.st[0], nx = b.st[1];
        if (nloc == 0u) { xcd_barrier_complete(bar, b.x, nloc, nx); b.st[0] = nloc; b.st[1] = nx; }
        const unsigned old = xb_add(&bar[XB_XSUB(b.x)], 1u);
        const unsigned gen = old / nloc;
        if (old + 1u == (gen + 1u) * nloc) {
            __builtin_amdgcn_fence(__ATOMIC_RELEASE, "agent");
            asm volatile("s_waitcnt vmcnt(0)" ::: "memory");
            const unsigned og = xb_add(&bar[XB_TOP], 1u);
            const unsigned tg = og / nx;
            if (og + 1u == (tg + 1u) * nx) xb_add(&bar[XB_TOPGEN], 1u);
            else XB_SPIN(xb_ld(&bar[XB_TOPGEN]) == tg, bar);
            __builtin_amdgcn_fence(__ATOMIC_ACQUIRE, "agent");
            xb_add(&bar[XB_XGEN(b.x)], 1u);
            asm volatile("s_waitcnt vmcnt(0)" ::: "memory");
        } else {
            XB_SPIN(xb_ld(&bar[XB_XGEN(b.x)]) == gen, bar);
            __builtin_amdgcn_fence(__ATOMIC_ACQUIRE, "agent");
            asm volatile("s_waitcnt vmcnt(0)" ::: "memory");
        }
    }
    __syncthreads();
}

namespace pg8 {
constexpr int BM = 256, BK = 64, HALF = 128, HTB = HALF * BK * 2, STAGE_BYTES = 8 * HTB, NXCD = 8, WGM = 8;
__host__ __device__ __forceinline__ int lds_byte(int r, int c) { const int st = (r >> 4) * 2 + (c >> 5), rr = r & 15, cc = c & 31, ob = rr * 64 + cc * 2; return st * 1024 + (ob ^ (((ob >> 9) & 1) << 5)); }
__host__ __device__ __forceinline__ void stage_rc(int b, int& R, int& C) { const int st = b / 1024, sb = b % 1024, swz = sb ^ (((sb >> 9) & 1) << 5); R = (st >> 1) * 16 + swz / 64; C = (st & 1) * 32 + (swz % 64) / 2; }
__host__ __device__ __forceinline__ int perm32(int rho) { const int n = rho >> 4, i = rho & 15; return 8 * (i >> 2) + 4 * n + (i & 3); }

struct Unit { int pm, pn, z; };
struct UOrder {
    int nM, nN, nZ, nwg, G, c, wgm, rev;
    __device__ __forceinline__ void init(int nM_, int nN_, int nZ_, int G_, int c_, int wgm_ = WGM, int rev_ = 0) { nM = nM_; nN = nN_; nZ = nZ_; nwg = nM_ * nN_ * nZ_; G = G_; c = c_; wgm = wgm_; rev = rev_; }
    __device__ __forceinline__ bool next(int i, Unit& u) const {
        const long L = (long)i * G + c; if (L >= nwg) return false;
        int wgid = (int)L; { const int q = nwg / NXCD, r = nwg % NXCD, xcd = wgid % NXCD, off = wgid / NXCD; wgid = (xcd < r ? xcd * (q + 1) : r * (q + 1) + (xcd - r) * q) + off; }
        if (rev) wgid = nwg - 1 - wgid;
        const int per = nM * nN; u.z = wgid / per; const int w2 = wgid - u.z * per;
        const int nig = wgm * nN, gid = w2 / nig, fm = gid * wgm, gsz = (nM - fm) < wgm ? (nM - fm) : wgm;
        u.pm = fm + ((w2 % nig) % gsz); u.pn = (w2 % nig) / gsz; return true;
    }
};

template <class Prob, class Epi>
__device__ __forceinline__ void gemm_phase(LAS unsigned char* lds, const Prob g, const UOrder& S, const Epi& E) {
    const int tid = opaque_tid(), wid = __builtin_amdgcn_readfirstlane(tid >> 6), lane = tid & 63, wr = wid >> 2, wc = wid & 3, fr = lane & 15, fq = lane >> 4;
    const int K = g.K, nt = K / BK;
    unsigned voffA[2], voffB[2];
#pragma unroll
    for (int i = 0; i < 2; ++i) { int R, C; stage_rc(tid * 16 + i * 8192, R, C); const int Rb = Epi::PERM ? ((R & ~31) + perm32(R & 31)) : R;
        voffA[i] = (unsigned)(R * g.lda + C) * 2u; voffB[i] = (unsigned)(Rb * g.ldb + C) * 2u; }
    const size_t kstep = (size_t)(BK * 2);
    const size_t hstepA = (size_t)HALF * g.lda * 2, hstepB = (size_t)HALF * g.ldb * 2;
    const unsigned ldsw = (unsigned)wid * 1024u;
    const int aoff = lds_byte(wr * 64 + fr, fq * 8), boff = lds_byte(wc * 32 + fr, fq * 8);
#define PG8_SA(b, h) (((b) * 2 + (h)) * HTB)
#define PG8_SB(b, h) ((4 + (b) * 2 + (h)) * HTB)
#define PG8_STAGE(bufoff, gbase, voff) do { _Pragma("unroll") for (int _i = 0; _i < 2; ++_i) \
        __builtin_amdgcn_global_load_lds((const unsigned*)((const char*)(gbase) + (voff)[_i]), (LAS unsigned*)(lds + (bufoff) + ldsw + _i * 8192), 16, 0, 0); } while (0)
#define PG8_LDA(dst, b, h) do { _Pragma("unroll") for (int m = 0; m < 4; ++m) _Pragma("unroll") for (int k = 0; k < 2; ++k) dst[m][k] = *(const LAS bf16x8*)(lds + PG8_SA(b, h) + aoff + m * 2048 + k * 1024); } while (0)
#define PG8_LDB(dst, b, h) do { _Pragma("unroll") for (int n = 0; n < 2; ++n) _Pragma("unroll") for (int k = 0; k < 2; ++k) dst[n][k] = *(const LAS bf16x8*)(lds + PG8_SB(b, h) + boff + n * 2048 + k * 1024); } while (0)
#define PG8_MMA(ai, bj, At, Bt) do { __builtin_amdgcn_s_setprio(1); _Pragma("unroll") for (int m = 0; m < 4; ++m) _Pragma("unroll") for (int n = 0; n < 2; ++n) _Pragma("unroll") for (int k = 0; k < 2; ++k) \
        acc[ai][bj][m][n] = __builtin_amdgcn_mfma_f32_16x16x32_bf16(Bt[n][k], At[m][k], acc[ai][bj][m][n], 0, 0, 0); __builtin_amdgcn_s_setprio(0); } while (0)
#define PG8_WAIT_V(n) asm volatile("s_waitcnt vmcnt(" #n ")" ::: "memory")
#define PG8_WAIT_L(n) asm volatile("s_waitcnt lgkmcnt(" #n ")" ::: "memory")
#define PG8_BAR __builtin_amdgcn_s_barrier()
#define PG8_SCHED __builtin_amdgcn_sched_barrier(0)
    Unit cur, nxt; int ui = 0;
    if (!S.next(0, cur)) return;
    f32x4 acc[2][2][4][2];
#pragma unroll
    for (int a = 0; a < 2; ++a)
#pragma unroll
        for (int b = 0; b < 2; ++b)
#pragma unroll
            for (int m = 0; m < 4; ++m)
#pragma unroll
                for (int n = 0; n < 2; ++n) acc[a][b][m][n] = (f32x4){0.f, 0.f, 0.f, 0.f};
    bf16x8 At[4][2], B0[2][2], B1[2][2];
    const char* cA = g.a_tile(cur); const char* cB = g.b_tile(cur);
    PG8_STAGE(PG8_SB(0, 0), cB, voffB); PG8_STAGE(PG8_SB(0, 1), cB + hstepB, voffB); PG8_STAGE(PG8_SA(0, 0), cA, voffA); PG8_STAGE(PG8_SA(0, 1), cA + hstepA, voffA);
    if (wr == 1) PG8_BAR;
    PG8_WAIT_V(2); PG8_BAR;
    PG8_STAGE(PG8_SB(1, 0), cB + kstep, voffB); PG8_STAGE(PG8_SA(1, 0), cA + kstep, voffA); PG8_STAGE(PG8_SB(1, 1), cB + hstepB + kstep, voffB);
    PG8_WAIT_V(6); PG8_BAR;
    for (;;) {
        const bool has_next = S.next(ui + 1, nxt);
        const char* nA = has_next ? g.a_tile(nxt) : cA; const char* nB = has_next ? g.b_tile(nxt) : cB;
        for (int t = 0; t < nt; t += 2) {
            const bool last = (t == nt - 2);
            const char* a1 = cA + (size_t)(t + 1) * kstep;
            const char* a2 = last ? nA : cA + (size_t)(t + 2) * kstep; const char* b2 = last ? nB : cB + (size_t)(t + 2) * kstep;
            const char* a3 = a2 + kstep; const char* b3 = b2 + kstep;
            PG8_LDB(B0, 0, 0); PG8_LDB(B1, 0, 1); PG8_SCHED; PG8_LDA(At, 0, 0); PG8_STAGE(PG8_SA(1, 1), a1 + hstepA, voffA);
            PG8_WAIT_V(8); PG8_WAIT_L(0); PG8_BAR; PG8_MMA(0, 0, At, B0); PG8_MMA(0, 1, At, B1); PG8_BAR; PG8_SCHED;
            PG8_LDA(At, 0, 1); PG8_STAGE(PG8_SB(0, 0), b2, voffB); PG8_STAGE(PG8_SB(0, 1), b2 + hstepB, voffB); PG8_STAGE(PG8_SA(0, 0), a2, voffA);
            PG8_WAIT_V(8); PG8_WAIT_L(0); PG8_BAR; PG8_MMA(1, 0, At, B0); PG8_MMA(1, 1, At, B1); PG8_BAR; PG8_SCHED;
            PG8_LDB(B0, 1, 0); PG8_LDB(B1, 1, 1); PG8_SCHED; PG8_LDA(At, 1, 0); PG8_STAGE(PG8_SA(0, 1), a2 + hstepA, voffA);
            PG8_WAIT_V(8); PG8_WAIT_L(0); PG8_BAR; PG8_MMA(0, 0, At, B0); PG8_MMA(0, 1, At, B1); PG8_BAR; PG8_SCHED;
            PG8_LDA(At, 1, 1); PG8_STAGE(PG8_SB(1, 0), b3, voffB); PG8_STAGE(PG8_SB(1, 1), b3 + hstepB, voffB); PG8_STAGE(PG8_SA(1, 0), a3, voffA);
            PG8_WAIT_V(8); PG8_WAIT_L(0); PG8_BAR; PG8_MMA(1, 0, At, B0); PG8_MMA(1, 1, At, B1); PG8_BAR; PG8_SCHED;
        }
        if (wr == 0) PG8_BAR;
        E(acc, cur, wr, wc, fr, fq);
        if (!has_next) break;
#pragma unroll
        for (int a = 0; a < 2; ++a)
#pragma unroll
            for (int b = 0; b < 2; ++b)
#pragma unroll
                for (int m = 0; m < 4; ++m)
#pragma unroll
                    for (int n = 0; n < 2; ++n) acc[a][b][m][n] = (f32x4){0.f, 0.f, 0.f, 0.f};
        cur = nxt; cA = nA; cB = nB; ++ui;
        if (wr == 1) PG8_BAR;
    }
    PG8_WAIT_V(0);
    PG8_BAR;
#undef PG8_SA
#undef PG8_SB
#undef PG8_STAGE
#undef PG8_LDA
#undef PG8_LDB
#undef PG8_MMA
#undef PG8_WAIT_V
#undef PG8_WAIT_L
#undef PG8_BAR
#undef PG8_SCHED
}
}
using pg8::Unit;

__device__ __forceinline__ int row_tile(int pm, int amap) { return amap ? 9 * (pm >> 3) + 1 + (pm & 7) : pm; }

struct ProbStd {
    const bf16_t* A; const bf16_t* Bt; int lda, ldb, K, amap;
    __device__ __forceinline__ const char* a_tile(const Unit& u) const { return (const char*)(A + (size_t)row_tile(u.pm, amap) * 256 * lda); }
    __device__ __forceinline__ const char* b_tile(const Unit& u) const { return (const char*)(Bt + (size_t)u.pn * 256 * ldb); }
};
struct ProbF1 {
    const bf16_t* A; const bf16_t* HN; int lda, ldb, K;
    __device__ __forceinline__ const char* a_tile(const Unit& u) const { return (const char*)(A + (size_t)u.pm * 256 * 512); }
    __device__ __forceinline__ const char* b_tile(const Unit& u) const { return (const char*)(HN + ((size_t)(u.z >> 2) * TPB + CTXL + (size_t)u.pn * 256) * DM + (u.z & 3) * 512); }
};
struct ProbF2 {
    const bf16_t* A; const bf16_t* UVT; int lda, ldb, K; static constexpr int akstep = 128;
    __device__ __forceinline__ const char* a_tile(const Unit& u) const { return (const char*)(A + (size_t)u.pm * 256 * 4096); }
    __device__ __forceinline__ const char* b_tile(const Unit& u) const { return (const char*)(UVT + ((size_t)u.z * 1024 + (size_t)u.pn * 256) * 4096); }
};

__device__ __forceinline__ void store_tile_bf16(const f32x4 (&acc)[2][2][4][2], bf16_t* base, size_t ldc, int wr, int wc, int fr, int fq) {
#pragma unroll
    for (int ai = 0; ai < 2; ++ai)
#pragma unroll
        for (int m = 0; m < 4; ++m) { bf16_t* rowp = base + (size_t)(ai * 128 + wr * 64 + m * 16 + fr) * ldc + wc * 32 + 8 * fq;
#pragma unroll
            for (int bj = 0; bj < 2; ++bj) { const f32x4 v0 = acc[ai][bj][m][0], v1 = acc[ai][bj][m][1];
                u32x4 w; w.x = cvt_pk_bf16(v0[0], v0[1]); w.y = cvt_pk_bf16(v0[2], v0[3]); w.z = cvt_pk_bf16(v1[0], v1[1]); w.w = cvt_pk_bf16(v1[2], v1[3]);
                *(u32x4*)(rowp + bj * 128) = w; } }
}
struct EpiProj {
    static constexpr bool PERM = true;
    bf16_t* O; int ldc; int zt; float* Z; int k_lo, k_hi; const float* kn; const f32x2* rope;
    __device__ __forceinline__ void operator()(const f32x4 (&acc)[2][2][4][2], const Unit& u, int wr, int wc, int fr, int fq) const {
        if (u.pn == zt) {
            if (wc == 0) {
#pragma unroll
                for (int ai = 0; ai < 2; ++ai)
#pragma unroll
                    for (int m = 0; m < 4; ++m) { float* zp = Z + (size_t)(u.pm * 256 + ai * 128 + wr * 64 + m * 16 + fr) * 32 + 8 * fq;
                        *(f32x4*)zp = acc[ai][0][m][0]; *(f32x4*)(zp + 4) = acc[ai][0][m][1]; }
            }
            return;
        }
        bf16_t* tb = O + (size_t)u.pm * 256 * ldc + (size_t)u.pn * 256;
        store_tile_bf16(acc, tb, (size_t)ldc, wr, wc, fr, fq);
        if (u.pn >= k_lo && u.pn < k_hi) {
            asm volatile("s_waitcnt vmcnt(0)" ::: "memory"); __builtin_amdgcn_s_barrier(); asm volatile("" ::: "memory");
            int ln_ = fq * 16 + fr; asm volatile("" : "+v"(ln_));
            const int wid = wr * 4 + wc, li = ln_ & 15, sub = ln_ >> 4, quarter = li >> 2;
            const float* gp = kn + 8 * li; const f32x4 g0 = *(const f32x4*)gp, g1 = *(const f32x4*)(gp + 4);
#pragma unroll 1
            for (int s0 = 0; s0 < 16; s0 += 4) {
                u32x4 w[4]; bf16_t* pp[4]; int tt[4];
#pragma unroll
                for (int i = 0; i < 4; ++i) { const int item = wid * 64 + (s0 + i) * 4 + sub, row = item >> 1, hd = item & 1;
                    pp[i] = tb + (size_t)row * ldc + hd * 128 + 8 * li; w[i] = *(const u32x4*)pp[i]; tt[i] = (u.pm * 256 + row) % TPB; }
#pragma unroll
                for (int i = 0; i < 4; ++i) {
                    float x[8] = {bflo(w[i].x), bfhi(w[i].x), bflo(w[i].y), bfhi(w[i].y), bflo(w[i].z), bfhi(w[i].z), bflo(w[i].w), bfhi(w[i].w)};
                    float ss = 0.f;
#pragma unroll
                    for (int e = 0; e < 8; ++e) ss += x[e] * x[e];
                    ss += __shfl_xor(ss, 1); ss += __shfl_xor(ss, 2); ss += __shfl_xor(ss, 4); ss += __shfl_xor(ss, 8);
                    const float rstd = 1.0f / sqrtf(ss * (1.f / 128.f) + NORM_EPS);
                    x[0] *= rstd * g0.x; x[1] *= rstd * g0.y; x[2] *= rstd * g0.z; x[3] *= rstd * g0.w;
                    x[4] *= rstd * g1.x; x[5] *= rstd * g1.y; x[6] *= rstd * g1.z; x[7] *= rstd * g1.w;
                    if (tt[i] >= CTXL) {
                        const f32x2* rp = rope + (size_t)(tt[i] - CTXL) * 64 + (quarter >> 1) * 32 + (li & 3) * 8;
                        const float sgn = (quarter & 1) ? 1.f : -1.f;
#pragma unroll
                        for (int e = 0; e < 8; ++e) { const f32x2 cs = rp[e]; const float pv = __shfl_xor(x[e], 4); x[e] = x[e] * cs.x + sgn * pv * cs.y; }
                    }
                    u32x4 o; o.x = cvt_pk_bf16(x[0], x[1]); o.y = cvt_pk_bf16(x[2], x[3]); o.z = cvt_pk_bf16(x[4], x[5]); o.w = cvt_pk_bf16(x[6], x[7]);
                    *(u32x4*)pp[i] = o;
                }
            }
        }
    }
};
struct EpiF1 {
    static constexpr bool PERM = true;
    bf16_t* UVT;
    __device__ __forceinline__ void operator()(const f32x4 (&acc)[2][2][4][2], const Unit& u, int wr, int wc, int fr, int fq) const {
        bf16_t* base = UVT + ((size_t)(u.z >> 2) * 1024 + (u.z & 3) * 256) * 4096 + (size_t)u.pm * 2048 + (size_t)u.pn * 256;
        store_tile_bf16(acc, base, 4096, wr, wc, fr, fq);
    }
};
struct EpiF2P {
    static constexpr bool PERM = true;
    bf16_t* P;
    __device__ __forceinline__ void operator()(const f32x4 (&acc)[2][2][4][2], const Unit& u, int wr, int wc, int fr, int fq) const {
        store_tile_bf16(acc, P + ((size_t)u.z * 1024 + (size_t)u.pm * 256) * 1024 + (size_t)u.pn * 256, 1024, wr, wc, fr, fq);
    }
};
struct EpiF2Q {
    static constexpr bool PERM = true;
    const bf16_t* P; bf16_t* O;
    __device__ __forceinline__ void store_mirror(bf16_t* om, const u32x4& y, bool t0) const {
        if (!t0) *(u32x4*)om = y;
        else { om[1] = (bf16_t)(y.x >> 16); *(unsigned*)(om + 2) = y.y; *(unsigned*)(om + 4) = y.z; *(unsigned*)(om + 6) = y.w; }
    }
    __device__ __forceinline__ void operator()(const f32x4 (&acc)[2][2][4][2], const Unit& u, int wr, int wc, int fr, int fq) const {
        const bf16_t* pb = P + ((size_t)u.z * 1024 + (size_t)u.pm * 256) * 1024 + (size_t)u.pn * 256 + wc * 32 + 8 * fq;
        bf16_t* ob = O + ((size_t)u.z * TPB + CTXL) * DM + (size_t)u.pn * 512 + wc * 32 + 8 * fq;
#pragma unroll
        for (int ai = 0; ai < 2; ++ai)
#pragma unroll
            for (int m = 0; m < 4; ++m) { const int row = ai * 128 + wr * 64 + m * 16 + fr, lp = u.pm * 256 + row;
                u32x4 pw[2];
#pragma unroll
                for (int bj = 0; bj < 2; ++bj) pw[bj] = *(const u32x4*)(pb + (size_t)row * 1024 + bj * 128);
#pragma unroll
                for (int bj = 0; bj < 2; ++bj) { const f32x4 q0 = acc[ai][bj][m][0], q1 = acc[ai][bj][m][1];
                    const float p[8] = {bflo(pw[bj].x), bfhi(pw[bj].x), bflo(pw[bj].y), bfhi(pw[bj].y), bflo(pw[bj].z), bfhi(pw[bj].z), bflo(pw[bj].w), bfhi(pw[bj].w)};
                    const bool t0 = (bj == 0) && (wc == 0) && (fq == 0);
                    u32x4 yd, ym;
                    yd.x = cvt_pk_bf16(t0 ? p[0] : p[0] + q0[0], p[1] + q0[1]); yd.y = cvt_pk_bf16(p[2] + q0[2], p[3] + q0[3]);
                    yd.z = cvt_pk_bf16(p[4] + q1[0], p[5] + q1[1]); yd.w = cvt_pk_bf16(p[6] + q1[2], p[7] + q1[3]);
                    ym.x = cvt_pk_bf16(t0 ? p[0] : p[0] - q0[0], p[1] - q0[1]); ym.y = cvt_pk_bf16(p[2] - q0[2], p[3] - q0[3]);
                    ym.z = cvt_pk_bf16(p[4] - q1[0], p[5] - q1[1]); ym.w = cvt_pk_bf16(p[6] - q1[2], p[7] - q1[3]);
                    bf16_t* od = ob + (size_t)lp * DM + bj * 128;
                    *(u32x4*)od = yd; store_mirror(od + 256, ym, t0);
                    if (lp != 0) { bf16_t* o2 = ob + (size_t)(2048 - lp) * DM + bj * 128; *(u32x4*)o2 = ym; store_mirror(o2 + 256, yd, t0); }
                } }
    }
};
__device__ __forceinline__ f32x4 swiglu4(const f32x4 g, const f32x4 u) {
    const f32x4 t = g * -1.4426950408889634f;
    const f32x4 e = {__builtin_amdgcn_exp2f(t.x), __builtin_amdgcn_exp2f(t.y), __builtin_amdgcn_exp2f(t.z), __builtin_amdgcn_exp2f(t.w)};
    const f32x4 d = e + 1.0f;
    const f32x4 r = {__builtin_amdgcn_rcpf(d.x), __builtin_amdgcn_rcpf(d.y), __builtin_amdgcn_rcpf(d.z), __builtin_amdgcn_rcpf(d.w)};
    return (g * u) * r;
}
struct EpiSwiGLU {
    static constexpr bool PERM = true;
    bf16_t* H; int amap;
    __device__ __forceinline__ void operator()(const f32x4 (&acc)[2][2][4][2], const Unit& u, int wr, int wc, int fr, int fq) const {
        bf16_t* base = H + (size_t)row_tile(u.pm, amap) * 256 * FF + (size_t)u.pn * 128 + wc * 32 + 8 * fq;
#pragma unroll
        for (int ai = 0; ai < 2; ++ai)
#pragma unroll
            for (int m = 0; m < 4; ++m) { bf16_t* rowp = base + (size_t)(ai * 128 + wr * 64 + m * 16 + fr) * FF;
                const f32x4 g0 = acc[ai][0][m][0], g1 = acc[ai][0][m][1], u0 = acc[ai][1][m][0], u1 = acc[ai][1][m][1];
                const f32x4 s0 = swiglu4(g0, u0), s1 = swiglu4(g1, u1);
                u32x4 w; w.x = cvt_pk_bf16(s0.x, s0.y); w.y = cvt_pk_bf16(s0.z, s0.w); w.z = cvt_pk_bf16(s1.x, s1.y); w.w = cvt_pk_bf16(s1.z, s1.w);
                *(u32x4*)rowp = w; }
    }
};
__device__ __forceinline__ unsigned pk_f16(float a, float b) { const f16x2 p = {(_Float16)a, (_Float16)b}; return __builtin_bit_cast(unsigned, p); }
__device__ __forceinline__ float f16lo(unsigned u) { return (float)__builtin_bit_cast(f16x2, u).x; }
__device__ __forceinline__ float f16hi(unsigned u) { return (float)__builtin_bit_cast(f16x2, u).y; }
template <bool SRC16, bool DST16>
struct EpiResT {
    static constexpr bool PERM = false;
    const void* src_lat; const void* src_ctx; void* dst_lat; void* dst_ctx; const float* modv; int goff; int amap;
    __device__ __forceinline__ void operator()(const f32x4 (&acc)[2][2][4][2], const Unit& u, int wr, int wc, int fr, int fq) const {
        const int rt = row_tile(u.pm, amap & 1), b = rt / 9, j = rt - b * 9;
        const size_t eoff = (j == 0) ? (size_t)b * CTXL * DM : ((size_t)b * SEQ + (size_t)(j - 1) * 256) * DM;
        const char* sb = (const char*)(j == 0 ? src_ctx : src_lat) + eoff * (SRC16 ? 2 : 4);
        char* db = (char*)(j == 0 ? dst_ctx : dst_lat) + eoff * (DST16 ? 2 : 4);
        const float* gv = modv + (size_t)(j == 0 ? 16 : b) * 12288 + goff;
        const int lane = fq * 16 + fr;
        if constexpr (DST16) {
            const int scol = u.pn * 256 + wc * 32 + 4 * fq;
            f32x4 gt[2][2];
#pragma unroll
            for (int bj = 0; bj < 2; ++bj)
#pragma unroll
                for (int n = 0; n < 2; ++n) gt[bj][n] = *(const f32x4*)(gv + scol + bj * 128 + n * 16);
            const int prow = lane >> 2, pc = lane & 3; const bool nj = (pc & 2) != 0;
            const int addrA = ((((pc & 1) * 2) << 4) | prow) << 2, addrB = addrA + 64;
            const int dcol = u.pn * 256 + wc * 32 + 8 * pc;
            constexpr int MB = SRC16 ? 4 : 2;
#pragma unroll
            for (int ai = 0; ai < 2; ++ai)
#pragma unroll
              for (int m0 = 0; m0 < 4; m0 += MB) {
                u32x4 xb[MB][2]; f32x4 xfb[MB][2][2];
#pragma unroll
                for (int mm = 0; mm < MB; ++mm)
#pragma unroll
                    for (int bj = 0; bj < 2; ++bj) { const char* xp = sb + ((size_t)(ai * 128 + wr * 64 + (m0 + mm) * 16 + prow) * DM + dcol + bj * 128) * (SRC16 ? 2 : 4);
                        if constexpr (SRC16) xb[mm][bj] = *(const u32x4*)xp;
                        else { xfb[mm][bj][0] = *(const f32x4*)xp; xfb[mm][bj][1] = *(const f32x4*)(xp + 16); } }
#pragma unroll
                for (int mm = 0; mm < MB; ++mm) { const int m = m0 + mm; const size_t roff = (size_t)(ai * 128 + wr * 64 + m * 16 + prow) * DM + dcol;
                    u32x4 xh[2]; f32x4 xf[2][2];
#pragma unroll
                    for (int bj = 0; bj < 2; ++bj) {
                        if constexpr (SRC16) xh[bj] = xb[mm][bj];
                        else { xf[bj][0] = xfb[mm][bj][0]; xf[bj][1] = xfb[mm][bj][1]; } }
#pragma unroll
                    for (int bj = 0; bj < 2; ++bj) { unsigned P[2][2], o[4];
#pragma unroll
                        for (int n = 0; n < 2; ++n) { const f32x4 up = gt[bj][n] * acc[ai][bj][m][n]; P[n][0] = pk_f16(up.x, up.y); P[n][1] = pk_f16(up.z, up.w); }
#pragma unroll
                        for (int k = 0; k < 4; ++k) { const int ad = (k & 2) ? addrB : addrA;
                            const int v0 = __builtin_amdgcn_ds_bpermute(ad, (int)P[0][k & 1]), v1 = __builtin_amdgcn_ds_bpermute(ad, (int)P[1][k & 1]); o[k] = (unsigned)(nj ? v1 : v0); }
                        float x[8];
                        if constexpr (SRC16) { x[0] = f16lo(xh[bj].x); x[1] = f16hi(xh[bj].x); x[2] = f16lo(xh[bj].y); x[3] = f16hi(xh[bj].y); x[4] = f16lo(xh[bj].z); x[5] = f16hi(xh[bj].z); x[6] = f16lo(xh[bj].w); x[7] = f16hi(xh[bj].w); }
                        else { x[0] = xf[bj][0].x; x[1] = xf[bj][0].y; x[2] = xf[bj][0].z; x[3] = xf[bj][0].w; x[4] = xf[bj][1].x; x[5] = xf[bj][1].y; x[6] = xf[bj][1].z; x[7] = xf[bj][1].w; }
                        u32x4 w; w.x = pk_f16(x[0] + f16lo(o[0]), x[1] + f16hi(o[0])); w.y = pk_f16(x[2] + f16lo(o[1]), x[3] + f16hi(o[1]));
                        w.z = pk_f16(x[4] + f16lo(o[2]), x[5] + f16hi(o[2])); w.w = pk_f16(x[6] + f16lo(o[3]), x[7] + f16hi(o[3]));
                        *(u32x4*)(db + (roff + bj * 128) * 2) = w; }
                    asm volatile("" ::: "memory"); }
            }
        } else {
            const int prow = lane >> 3, pch = lane & 7, paddr = (((lane & 3) << 4) | (((lane >> 2) & 1) << 3) | prow) << 2;
            const bool lo = (fr & 8) == 0;
            const int col0 = u.pn * 256 + wc * 32 + 4 * pch;
            f32x4 gt[2];
#pragma unroll
            for (int bj = 0; bj < 2; ++bj) gt[bj] = *(const f32x4*)(gv + col0 + bj * 128);
#pragma unroll
            for (int ai = 0; ai < 2; ++ai)
#pragma unroll
                for (int m = 0; m < 4; ++m) { const size_t off = (size_t)(ai * 128 + wr * 64 + m * 16 + prow) * DM + col0;
                    f32x4 xs[2][2];
#pragma unroll
                    for (int bj = 0; bj < 2; ++bj)
#pragma unroll
                        for (int h = 0; h < 2; ++h) {
                            if constexpr (SRC16) { const u32x2 r = *(const u32x2*)(sb + (off + (size_t)h * 8 * DM + bj * 128) * 2); xs[bj][h] = (f32x4){f16lo(r.x), f16hi(r.x), f16lo(r.y), f16hi(r.y)}; }
                            else xs[bj][h] = *(const f32x4*)(sb + (off + (size_t)h * 8 * DM + bj * 128) * 4); }
#pragma unroll
                    for (int bj = 0; bj < 2; ++bj) { const f32x4 a0 = acc[ai][bj][m][0], a1 = acc[ai][bj][m][1]; f32x4 o0, o1;
#pragma unroll
                        for (int c = 0; c < 4; ++c) { const int send = __float_as_int(lo ? a1[c] : a0[c]);
                            const int recv = __builtin_amdgcn_mov_dpp(send, 0x128, 0xf, 0xf, false);
                            const int t0 = lo ? __float_as_int(a0[c]) : recv, t1 = lo ? recv : __float_as_int(a1[c]);
                            o0[c] = __int_as_float(__builtin_amdgcn_ds_bpermute(paddr, t0)); o1[c] = __int_as_float(__builtin_amdgcn_ds_bpermute(paddr, t1)); }
                        *(f32x4*)(db + (off + bj * 128) * 4) = xs[bj][0] + gt[bj] * o0; *(f32x4*)(db + (off + (size_t)8 * DM + bj * 128) * 4) = xs[bj][1] + gt[bj] * o1; }
                    asm volatile("" ::: "memory"); }
        }
    }
};

struct KArgs { const float* in[49]; float* out; unsigned char* ws; int ph_lo, ph_hi; };
__device__ __forceinline__ int idx_modw(int L) { return L == 0 ? 4 : L == 1 ? 17 : L == 2 ? 27 : 42; }
__device__ __forceinline__ int idx_norm2(int L) { return L == 0 ? 14 : L == 1 ? 24 : L == 2 ? 39 : 46; }

__device__ __forceinline__ void ph_prologue(const KArgs& a, LAS unsigned char* lds, int G, int bid) {
    const int tid = threadIdx.x, lane = tid & 63, wave = __builtin_amdgcn_readfirstlane(tid >> 6);
    LAS float* sl = (LAS float*)lds;
    LAS float* red = (LAS float*)(lds + 139264);
    float* modv = (float*)(a.ws + WS_MODV);
    {
        const float* c = a.in[1]; const float* cc = a.in[3];
        for (int i = tid; i < 17 * 2048; i += 512) { const float v = i < 16 * 2048 ? c[i] : cc[i - 16 * 2048]; sl[i] = v / (1.f + __expf(-v)); }
    }
    __syncthreads();
    for (int u = bid; u < 768; u += G) {
        const int L = u / 192, n0 = (u % 192) * 64;
        const float* W = a.in[idx_modw(L)]; const float* bias = a.in[idx_modw(L) + 1];
        float acc[17];
#pragma unroll
        for (int r = 0; r < 17; ++r) acc[r] = 0.f;
        const int k0 = wave * 256;
        const float* Wp = W + (size_t)k0 * 12288 + n0 + lane;
        float wv[16];
#pragma unroll
        for (int kk = 0; kk < 16; ++kk) wv[kk] = Wp[(size_t)kk * 12288];
        for (int k = 0; k < 256; k += 16) {
            float wn[16];
            const float* Wn = Wp + (size_t)(k + 16 < 256 ? k + 16 : k) * 12288;
#pragma unroll
            for (int kk = 0; kk < 16; ++kk) wn[kk] = Wn[(size_t)kk * 12288];
#pragma unroll
            for (int q = 0; q < 4; ++q)
#pragma unroll
                for (int r = 0; r < 17; ++r) { const f32x4 s4 = *(const LAS f32x4*)(sl + r * 2048 + k0 + k + 4 * q);
                    acc[r] += s4.x * wv[4 * q] + s4.y * wv[4 * q + 1] + s4.z * wv[4 * q + 2] + s4.w * wv[4 * q + 3]; }
#pragma unroll
            for (int kk = 0; kk < 16; ++kk) wv[kk] = wn[kk];
        }
        for (int w = 0; w < 8; ++w) {
            if (wave == w) {
#pragma unroll
                for (int r = 0; r < 17; ++r) red[r * 64 + lane] = (w == 0 ? 0.f : red[r * 64 + lane]) + acc[r];
            }
            __syncthreads();
        }
        for (int i = tid; i < 17 * 64; i += 512) { const int r = i >> 6, l = i & 63; modv[((size_t)L * 17 + r) * 12288 + n0 + l] = red[i] + bias[n0 + l]; }
        __syncthreads();
    }
    const size_t gt = (size_t)bid * 512 + tid, GT = (size_t)G * 512;
    {
        f32x2* rope = (f32x2*)(a.ws + WS_ROPE);
        for (size_t e = gt; e < 2048 * 64; e += GT) {
            const int p = (int)(e >> 6), i = (int)(e & 63), f = i & 31;
            const float inv = exp2f(-(float)(2 * f) * (13.287712379549449f / 64.f));
            const float ang = (float)(i < 32 ? (p >> 6) : (p & 63)) * inv;
            const float kf = rintf(ang * 0.15915494309189535f);
            float r = fmaf(-kf, 6.28318548202514648f, ang); r = fmaf(-kf, -1.7484556000744883e-7f, r);
            rope[e] = (f32x2){cosf(r), sinf(r)};
        }
    }
    {
        bf16_t* d1 = (bf16_t*)(a.ws + WS_DFT1);
        for (size_t e = gt; e < 512 * 512; e += GT) {
            const int m = (int)(e >> 9), k = (int)(e & 511), part = m >> 8, cp = m & 255;
            const int rr = (k * cp) & 511; const float rev = (float)rr * (1.f / 512.f);
            float v = part ? __builtin_amdgcn_sinf(rev) : __builtin_amdgcn_cosf(rev);
            if (m == 256) v = (k & 1) ? -1.f : 1.f;
            d1[e] = (bf16_t)f2bf(v * 0.044194173824159216f);
        }
        bf16_t* d2 = (bf16_t*)(a.ws + WS_DFT2);
        for (size_t e = gt; e < (size_t)2048 * 4096; e += GT) {
            const int lp = (int)(e >> 12), k = (int)(e & 4095), part = k >> 11, l = k & 2047;
            const int rr = (l * lp) & 2047; const float rev = (float)rr * (1.f / 2048.f);
            const float v = (part ? -__builtin_amdgcn_sinf(rev) : __builtin_amdgcn_cosf(rev)) * 0.022097086912079608f;
            d2[e] = (bf16_t)f2bf(v);
        }
    }
}

__device__ __forceinline__ void transpose_item(const float* W, int K, int N, bf16_t* WT, int mode, LAS unsigned* scr, int item, int lane) {
    const int nblk = (N + 63) / 64, kb = item / nblk, nb = item - kb * nblk, k0 = 64 * kb, n0 = 64 * nb;
    const int q = lane >> 4, c4 = (lane & 15) * 4;
    const bool ldok = n0 + c4 < N;
    f32x4 v[16];
#pragma unroll
    for (int i = 0; i < 16; ++i) { const int k = (i >> 1) * 8 + q * 2 + (i & 1); int ks = k0 + k;
        if (mode == 2) { const int pos = ks & 511; ks = (ks & ~511) + (pos <= 256 ? pos : 768 - pos); }
        v[i] = ldok ? *(const f32x4*)(W + (size_t)ks * N + n0 + c4) : (f32x4){0.f, 0.f, 0.f, 0.f}; }
#pragma unroll
    for (int j = 0; j < 8; ++j) { const int kd = j * 4 + q;
        scr[(c4 + 0) * 33 + kd] = cvt_pk_bf16(v[2 * j].x, v[2 * j + 1].x); scr[(c4 + 1) * 33 + kd] = cvt_pk_bf16(v[2 * j].y, v[2 * j + 1].y);
        scr[(c4 + 2) * 33 + kd] = cvt_pk_bf16(v[2 * j].z, v[2 * j + 1].z); scr[(c4 + 3) * 33 + kd] = cvt_pk_bf16(v[2 * j].w, v[2 * j + 1].w); }
    LDS_WAIT(); asm volatile("" ::: "memory");
    const int c = lane & 7;
#pragma unroll
    for (int j = 0; j < 8; ++j) { const int n = (lane >> 3) + 8 * j; const LAS unsigned* sp = scr + n * 33 + 4 * c;
        u32x4 o; o.x = sp[0]; o.y = sp[1]; o.z = sp[2]; o.w = sp[3];
        int drow = n0 + n;
        if (mode == 1) { const int part = drow >= FF ? 1 : 0, hid = drow - part * FF; drow = 256 * (hid >> 7) + 128 * part + (hid & 127); }
        if (n0 + n < N) *(u32x4*)(WT + (size_t)drow * K + k0 + 8 * c) = o; }
    LDS_WAIT(); asm volatile("" ::: "memory");
}
__device__ __forceinline__ void convert_layer(const KArgs& a, LAS unsigned char* lds, int gw, int NGW, const float* f_in, const float* f_out, const float* wi, int Nin, const float* wo, int wo_mode = 0, size_t sh1 = 0, size_t sh2 = 0) {
    const int tid = threadIdx.x, lane = tid & 63, wave = __builtin_amdgcn_readfirstlane(tid >> 6);
    LAS unsigned* scr = (LAS unsigned*)(lds + wave * 16384);
    const int I1 = f_in ? (DM / 64) * (2 * FF / 64) : 0, I2 = f_out ? (FF / 64) * (DM / 64) : 0, I3 = wi ? (DM / 64) * ((Nin + 63) / 64) : 0, I4 = wo ? (DM / 64) * (DM / 64) : 0;
    const int NI = I1 + I2 + I3 + I4;
    for (int it = gw; it < NI; it += NGW) {
        int r = it;
        if (r < I1) { transpose_item(f_in, DM, 2 * FF, (bf16_t*)(a.ws + W_FFN1 + sh1), 1, scr, r, lane); continue; } r -= I1;
        if (r < I2) { transpose_item(f_out, FF, DM, (bf16_t*)(a.ws + W_FFN2 + sh2), 0, scr, r, lane); continue; } r -= I2;
        if (r < I3) { transpose_item(wi, DM, Nin, (bf16_t*)(a.ws + W_IN), 0, scr, r, lane); continue; } r -= I3;
        transpose_item(wo, DM, DM, (bf16_t*)(a.ws + W_OUT), wo_mode, scr, r, lane);
    }
}

template <bool SRC16>
__device__ __forceinline__ void norm_phase(const void* lat, const void* ctx, const float* gain, const float* modvL, int shoff, int scoff, bf16_t* HN, int lat_only, int G, int bid,
                                           void* copy_lat = nullptr, void* copy_ctx = nullptr) {
    const int tid = threadIdx.x, lane = tid & 63, wave = __builtin_amdgcn_readfirstlane(tid >> 6);
    const int nunits = lat_only ? NLAT / 16 : NT / 16;
    for (int u = bid; u < nunits; u += G) {
        int r0;
        if (lat_only) { const int lr = u * 16, b = lr / SEQ; r0 = b * TPB + CTXL + (lr - b * SEQ); } else r0 = u * 16;
        const int ra = r0 + wave * 2;
        const int b = ra / TPB, t = ra - b * TPB;
        const size_t eoff = t < CTXL ? ((size_t)b * CTXL + t) * DM : ((size_t)b * SEQ + (t - CTXL)) * DM;
        const char* xa = (const char*)(t < CTXL ? ctx : lat) + eoff * (SRC16 ? 2 : 4);
        const float* mv = modvL + (size_t)(t < CTXL ? 16 : b) * 12288;
        f32x4 v[2][8]; float ss[2] = {0.f, 0.f};
        if constexpr (SRC16) {
            u32x4 raw[2][4];
#pragma unroll
            for (int rr = 0; rr < 2; ++rr)
#pragma unroll
                for (int j = 0; j < 4; ++j) raw[rr][j] = *(const u32x4*)(xa + ((size_t)rr * DM + 8 * lane + 512 * j) * 2);
#pragma unroll
            for (int rr = 0; rr < 2; ++rr)
#pragma unroll
                for (int j = 0; j < 4; ++j) { const u32x4 w = raw[rr][j];
                    v[rr][2 * j] = (f32x4){f16lo(w.x), f16hi(w.x), f16lo(w.y), f16hi(w.y)}; v[rr][2 * j + 1] = (f32x4){f16lo(w.z), f16hi(w.z), f16lo(w.w), f16hi(w.w)}; }
        } else {
#pragma unroll
            for (int rr = 0; rr < 2; ++rr)
#pragma unroll
                for (int j = 0; j < 8; ++j) v[rr][j] = *(const f32x4*)(xa + ((size_t)rr * DM + 4 * lane + 256 * j) * 4);
            if (copy_lat) { char* xc = (char*)(t < CTXL ? copy_ctx : copy_lat) + eoff * 2;
#pragma unroll
                for (int rr = 0; rr < 2; ++rr)
#pragma unroll
                    for (int j = 0; j < 8; ++j) { u32x2 w; w.x = pk_f16(v[rr][j].x, v[rr][j].y); w.y = pk_f16(v[rr][j].z, v[rr][j].w); *(u32x2*)(xc + ((size_t)rr * DM + 4 * lane + 256 * j) * 2) = w; } }
        }
#pragma unroll
        for (int rr = 0; rr < 2; ++rr)
#pragma unroll
            for (int j = 0; j < 8; ++j) ss[rr] += (v[rr][j].x * v[rr][j].x + v[rr][j].y * v[rr][j].y) + (v[rr][j].z * v[rr][j].z + v[rr][j].w * v[rr][j].w);
        const float rstd0 = 1.0f / sqrtf(wave_sum(ss[0]) * (1.f / DM) + NORM_EPS), rstd1 = 1.0f / sqrtf(wave_sum(ss[1]) * (1.f / DM) + NORM_EPS);
        bf16_t* orow = HN + (size_t)ra * DM;
#pragma unroll
        for (int j = 0; j < 8; ++j) {
            const int c = SRC16 ? (8 * lane + 512 * (j >> 1) + 4 * (j & 1)) : (4 * lane + 256 * j);
            const f32x4 g = *(const f32x4*)(gain + c), sc = *(const f32x4*)(mv + scoff + c), sh = *(const f32x4*)(mv + shoff + c);
            const f32x4 gs = g * (1.f + sc);
            const f32x4 o0 = v[0][j] * rstd0 * gs + sh, o1 = v[1][j] * rstd1 * gs + sh;
            u32x2 w0, w1; w0.x = cvt_pk_bf16(o0.x, o0.y); w0.y = cvt_pk_bf16(o0.z, o0.w); w1.x = cvt_pk_bf16(o1.x, o1.y); w1.y = cvt_pk_bf16(o1.z, o1.w);
            *(u32x2*)(orow + c) = w0; *(u32x2*)(orow + DM + c) = w1;
        }
    }
}

__device__ __forceinline__ void qknorm_rope_phase(bf16_t* P, int ld, int nh, const float* qn, const float* kn, const f32x2* rope, int G, int bid) {
    const int tid = threadIdx.x, lane = tid & 63, wave = __builtin_amdgcn_readfirstlane(tid >> 6);
    const int nq = (nh - 16) >> 2, sub = lane >> 4, li = lane & 15, quarter = li >> 2;
    const long total = (long)NT * nq, stride = (long)G * 8;
    constexpr int NI = 4;
    for (long id0 = (long)bid * 8 + wave; id0 < total; id0 += stride * NI) {
        u32x4 w[NI]; bf16_t* pp[NI]; int tt[NI], hh[NI]; bool ok[NI];
#pragma unroll
        for (int i = 0; i < NI; ++i) {
            const long id = id0 + stride * i; ok[i] = id < total; const long idc = ok[i] ? id : id0;
            const int r = (int)(idc / nq), quad = (int)(idc - (long)r * nq); hh[i] = 16 + quad * 4 + sub; tt[i] = r % TPB;
            pp[i] = P + (size_t)r * ld + hh[i] * 128 + 8 * li; w[i] = *(const u32x4*)pp[i];
        }
#pragma unroll
        for (int i = 0; i < NI; ++i) {
            float x[8] = {bflo(w[i].x), bfhi(w[i].x), bflo(w[i].y), bfhi(w[i].y), bflo(w[i].z), bfhi(w[i].z), bflo(w[i].w), bfhi(w[i].w)};
            float ss = 0.f;
#pragma unroll
            for (int e = 0; e < 8; ++e) ss += x[e] * x[e];
            ss += __shfl_xor(ss, 1); ss += __shfl_xor(ss, 2); ss += __shfl_xor(ss, 4); ss += __shfl_xor(ss, 8);
            const float rstd = 1.0f / sqrtf(ss * (1.f / 128.f) + NORM_EPS);
            const float* gp = (hh[i] < 16 ? qn : kn) + 8 * li;
            const f32x4 g0 = *(const f32x4*)gp, g1 = *(const f32x4*)(gp + 4);
            x[0] *= rstd * g0.x; x[1] *= rstd * g0.y; x[2] *= rstd * g0.z; x[3] *= rstd * g0.w;
            x[4] *= rstd * g1.x; x[5] *= rstd * g1.y; x[6] *= rstd * g1.z; x[7] *= rstd * g1.w;
            if (tt[i] >= CTXL) {
                const f32x2* rp = rope + (size_t)(tt[i] - CTXL) * 64 + (quarter >> 1) * 32 + (li & 3) * 8;
                const float sgn = (quarter & 1) ? 1.f : -1.f;
#pragma unroll
                for (int e = 0; e < 8; ++e) { const f32x2 cs = rp[e]; const float pv = __shfl_xor(x[e], 4); x[e] = x[e] * cs.x + sgn * pv * cs.y; }
            }
            u32x4 o; o.x = cvt_pk_bf16(x[0], x[1]); o.y = cvt_pk_bf16(x[2], x[3]); o.z = cvt_pk_bf16(x[4], x[5]); o.w = cvt_pk_bf16(x[6], x[7]);
            if (ok[i]) *(u32x4*)pp[i] = o;
        }
    }
}

namespace att {
constexpr int D = 128, NW = 8, QBLK = 32, KVBLK = 64;
constexpr float SCALE = 0.088388347648318440f;
constexpr float THR = 8.f;
constexpr size_t SHM_V = KVBLK * D * 2, SHM_K = KVBLK * D * 2, SHM_ATTN = 2 * SHM_V + 2 * SHM_K + NW * 64 * 4;
#define KSWZ(row, colB) ((row) * 256 + ((colB) ^ (((row) & 7) << 4)))
#define SBAR() __builtin_amdgcn_sched_barrier(0)
__device__ __forceinline__ int crow(int r, int hi) { return (r & 3) + 8 * (r >> 2) + 4 * hi; }
template <bool SUB> __device__ __forceinline__ void partialSM(f32x16& p0, f32x16& p1, float rsub) {
  if constexpr (SUB) { for (int r = 0; r < 16; ++r) p0[r] -= rsub; for (int r = 0; r < 16; ++r) p1[r] -= rsub; }
  for (int r = 0; r < 16; ++r) p0[r] = __builtin_amdgcn_exp2f(p0[r]);
}
__device__ __forceinline__ void finishSM(f32x16& p0, f32x16& p1, float& l_reg, bf16x8& pa0, bf16x8& pa1, bf16x8& pa2, bf16x8& pa3) {
  for (int r = 0; r < 16; ++r) p1[r] = __builtin_amdgcn_exp2f(p1[r]);
  float ps = 0; for (int r = 0; r < 16; ++r) ps += p0[r]; for (int r = 0; r < 16; ++r) ps += p1[r];
  { auto rr = __builtin_amdgcn_permlane32_swap(__float_as_uint(ps), __float_as_uint(ps), false, false);
    ps = __uint_as_float(rr[0]) + __uint_as_float(rr[1]); }
  l_reg += ps;
#define PK4(P, BASE, OUT) do { unsigned a0 = cvt_pk_bf16(P[BASE + 0], P[BASE + 1]), a1 = cvt_pk_bf16(P[BASE + 2], P[BASE + 3]);   \
    unsigned b0 = cvt_pk_bf16(P[BASE + 4], P[BASE + 5]), b1 = cvt_pk_bf16(P[BASE + 6], P[BASE + 7]);                              \
    auto r0 = __builtin_amdgcn_permlane32_swap(a0, b0, false, false); auto r1 = __builtin_amdgcn_permlane32_swap(a1, b1, false, false); \
    u32x4 w = {r0[0], r1[0], r0[1], r1[1]}; OUT = *reinterpret_cast<bf16x8*>(&w); } while (0)
  PK4(p0, 0, pa0); PK4(p0, 8, pa1); PK4(p1, 0, pa2); PK4(p1, 8, pa3);
#undef PK4
}
__device__ __forceinline__ void qkt(f32x16& p0, f32x16& p1, const bf16_t* Ks, const bf16x8* qr, int r32, int hi) {
  p0 = f32x16{}; p1 = f32x16{};
  for (int d0 = 0; d0 < 8; ++d0) { int cb = (d0 * 16 + hi * 8) * 2;
    bf16x8 b0 = *reinterpret_cast<const bf16x8*>((const char*)Ks + KSWZ(r32, cb));
    bf16x8 b1 = *reinterpret_cast<const bf16x8*>((const char*)Ks + KSWZ(32 + r32, cb));
    p0 = __builtin_amdgcn_mfma_f32_32x32x16_bf16(b0, qr[d0], p0, 0, 0, 0);
    p1 = __builtin_amdgcn_mfma_f32_32x32x16_bf16(b1, qr[d0], p1, 0, 0, 0); }
}
__device__ __forceinline__ int v_st(int k, int c) { const int kk = (k & ~0xC) | ((k & 4) << 1) | ((k & 8) >> 1); return ((kk >> 3) * 4 + (c >> 5)) * 512 + ((kk & 7) * 32 + (c & 31)) * 2; }
__device__ __forceinline__ int v_rd_base(int lane) { return ((lane & 3) << 3) | (((lane >> 2) & 3) << 6) | (((lane >> 4) & 1) << 5) | (((lane >> 5) & 1) << 8); }
constexpr int v_rd_off(int d0, int ks, int half) { return d0 * 512 + ks * 4096 + half * 2048; }
template <int OFF> __device__ __forceinline__ s16x4 tr_read(int vb) {
  s16x4 r; asm volatile("ds_read_b64_tr_b16 %0, %1 offset:%2" : "=&v"(r) : "v"(vb), "i"(OFF) : "memory"); return r;
}
template <int D0> __device__ __forceinline__ void pv_one(f32x16& od, int vb, bf16x8 pa0, bf16x8 pa1, bf16x8 pa2, bf16x8 pa3) {
  const s16x4 l0 = tr_read<v_rd_off(D0, 0, 0)>(vb), h0 = tr_read<v_rd_off(D0, 0, 1)>(vb), l1 = tr_read<v_rd_off(D0, 1, 0)>(vb), h1 = tr_read<v_rd_off(D0, 1, 1)>(vb);
  const s16x4 l2 = tr_read<v_rd_off(D0, 2, 0)>(vb), h2 = tr_read<v_rd_off(D0, 2, 1)>(vb), l3 = tr_read<v_rd_off(D0, 3, 0)>(vb), h3 = tr_read<v_rd_off(D0, 3, 1)>(vb);
  asm volatile("s_waitcnt lgkmcnt(0)" ::: "memory"); SBAR();
#define PK(L, H) (bf16x8){L[0], L[1], L[2], L[3], H[0], H[1], H[2], H[3]}
  od = __builtin_amdgcn_mfma_f32_32x32x16_bf16(pa0, PK(l0, h0), od, 0, 0, 0);
  od = __builtin_amdgcn_mfma_f32_32x32x16_bf16(pa1, PK(l1, h1), od, 0, 0, 0);
  od = __builtin_amdgcn_mfma_f32_32x32x16_bf16(pa2, PK(l2, h2), od, 0, 0, 0);
  od = __builtin_amdgcn_mfma_f32_32x32x16_bf16(pa3, PK(l3, h3), od, 0, 0, 0);
#undef PK
}
__device__ __forceinline__ void pv_d0(f32x16* o, int vb, bf16x8 pa0, bf16x8 pa1, bf16x8 pa2, bf16x8 pa3) {
  pv_one<0>(o[0], vb, pa0, pa1, pa2, pa3); pv_one<1>(o[1], vb, pa0, pa1, pa2, pa3); pv_one<2>(o[2], vb, pa0, pa1, pa2, pa3); pv_one<3>(o[3], vb, pa0, pa1, pa2, pa3);
}
__device__ __forceinline__ void q_norm_rope(bf16x8 (&qr)[8], const float* __restrict__ qn, const f32x2* __restrict__ rope, int pos, int hi_) {
  int hi = hi_; asm volatile("" : "+v"(hi));
  float x[8][8]; float ss = 0.f;
#pragma unroll
  for (int d0 = 0; d0 < 8; ++d0) { const u32x4 w = __builtin_bit_cast(u32x4, qr[d0]);
    x[d0][0] = bflo(w.x); x[d0][1] = bfhi(w.x); x[d0][2] = bflo(w.y); x[d0][3] = bfhi(w.y); x[d0][4] = bflo(w.z); x[d0][5] = bfhi(w.z); x[d0][6] = bflo(w.w); x[d0][7] = bfhi(w.w);
#pragma unroll
    for (int j = 0; j < 8; ++j) ss += x[d0][j] * x[d0][j]; }
  ss += __shfl_xor(ss, 32);
  const float rstd = (SCALE * 1.4426950408889634f) / sqrtf(ss * (1.f / 128.f) + NORM_EPS);
#pragma unroll
  for (int d0 = 0; d0 < 8; ++d0) { const float* gp = qn + d0 * 16 + hi * 8; const f32x4 g0 = *(const f32x4*)gp, g1 = *(const f32x4*)(gp + 4);
    x[d0][0] *= rstd * g0.x; x[d0][1] *= rstd * g0.y; x[d0][2] *= rstd * g0.z; x[d0][3] *= rstd * g0.w;
    x[d0][4] *= rstd * g1.x; x[d0][5] *= rstd * g1.y; x[d0][6] *= rstd * g1.z; x[d0][7] *= rstd * g1.w; }
  if (pos >= 0) {
#pragma unroll
    for (int hf = 0; hf < 2; ++hf)
#pragma unroll
      for (int e = 0; e < 2; ++e) { const int da = hf * 4 + e, db = da + 2; const f32x2* rp = rope + (size_t)pos * 64 + hf * 32 + e * 16 + hi * 8;
#pragma unroll
        for (int j = 0; j < 8; ++j) { const f32x2 cs = rp[j]; const float a = x[da][j], b = x[db][j]; x[da][j] = a * cs.x - b * cs.y; x[db][j] = b * cs.x + a * cs.y; } }
  }
#pragma unroll
  for (int d0 = 0; d0 < 8; ++d0) { u32x4 w; w.x = cvt_pk_bf16(x[d0][0], x[d0][1]); w.y = cvt_pk_bf16(x[d0][2], x[d0][3]); w.z = cvt_pk_bf16(x[d0][4], x[d0][5]); w.w = cvt_pk_bf16(x[d0][6], x[d0][7]);
    qr[d0] = __builtin_bit_cast(bf16x8, w); }
}
constexpr int OT_PITCH = 272, OT_BYTES = 32 * OT_PITCH;
template <int LDO>
__device__ __forceinline__ void store_o_tile(const f32x16 (&o)[4], const float (&rli)[16], char* tb, bf16_t* Ow, int lane) {
  const int r32 = lane & 31, hi = lane >> 5, odd = lane & 1;
#pragma unroll
  for (int d0 = 0; d0 < 4; ++d0)
#pragma unroll
    for (int q = 0; q < 8; ++q) {
      const unsigned ba = f2bf(o[d0][2 * q] * rli[2 * q]), bb = f2bf(o[d0][2 * q + 1] * rli[2 * q + 1]);
      const unsigned recv = (unsigned)__shfl_xor((int)(odd ? ba : bb), 1);
      const unsigned word = odd ? (recv | (bb << 16)) : (ba | (recv << 16));
      const int row = crow(2 * q + odd, hi);
      *(unsigned*)(tb + row * OT_PITCH + ((d0 * 32 + r32) >> 1) * 4) = word;
    }
  if (Ow == nullptr) return;
#pragma unroll
  for (int it = 0; it < 8; ++it) { const int idx = it * 64 + lane, row = idx >> 4, ch = idx & 15;
    *(u32x4*)(Ow + (long)row * LDO + ch * 8) = *(const u32x4*)(tb + row * OT_PITCH + ch * 16); }
}
template <int LDQ, int LDK, int LDO, bool SUB>
__device__ __forceinline__ void attn_dense_body(const bf16_t* __restrict__ Qb, const bf16_t* __restrict__ Kh, const bf16_t* __restrict__ Vh,
                                                bf16_t* __restrict__ Ob, int seq, float mfix, const float* __restrict__ qn, const f32x2* __restrict__ rope, int pos0, char* lds) {
  const int tid = opaque_tid(), wid = tid >> 6, lane = tid & 63, r32 = lane & 31, hi = lane >> 5;
  bf16_t* V_lds = (bf16_t*)lds; bf16_t* K_lds = (bf16_t*)(lds + 2 * SHM_V);
  float* ws = (float*)(lds + 2 * SHM_V + 2 * SHM_K) + wid * 64; float* li_l = ws;
  const float mnC = mfix * (SCALE * 1.4426950408889634f) - 80.f; float l_reg = 0; f32x16 o[4] = {}; bf16x8 qr[8];
  const bf16_t* Qw = Qb + (long)(wid * QBLK + r32) * LDQ + hi * 8;
#pragma unroll
  for (int d0 = 0; d0 < 8; ++d0) qr[d0] = *reinterpret_cast<const bf16x8*>(Qw + d0 * 16);
  q_norm_rope(qr, qn, rope, pos0 < 0 ? -1 : pos0 + wid * QBLK + r32, hi);
  SBAR();
  const int sr = tid >> 4, sc = (tid & 15) * 8, vst0 = v_st(sr, sc), vst1 = v_st(32 + sr, sc);
  const int vb0 = (int)(uintptr_t)V_lds + v_rd_base(lane);
  struct { bf16x8 vs0, vs1, ks0, ks1; } sr_[1];
  const unsigned goff0 = (unsigned)(sr * LDK + sc) * 2u, goff1 = (unsigned)((32 + sr) * LDK + sc) * 2u;
  const __amdgpu_buffer_rsrc_t rsK = __builtin_amdgcn_make_buffer_rsrc((void*)Kh, (short)0, seq * (LDK * 2), 0x00020000);
  const __amdgpu_buffer_rsrc_t rsV = __builtin_amdgcn_make_buffer_rsrc((void*)Vh, (short)0, seq * (LDK * 2), 0x00020000);
#define SLOAD(i, k0) do { const unsigned so_ = (unsigned)(k0) * (unsigned)(LDK * 2); \
    sr_[i].vs0 = __builtin_bit_cast(bf16x8, __builtin_amdgcn_raw_buffer_load_b128(rsV, goff0, so_, 0)); sr_[i].vs1 = __builtin_bit_cast(bf16x8, __builtin_amdgcn_raw_buffer_load_b128(rsV, goff1, so_, 0)); \
    sr_[i].ks0 = __builtin_bit_cast(bf16x8, __builtin_amdgcn_raw_buffer_load_b128(rsK, goff0, so_, 0)); sr_[i].ks1 = __builtin_bit_cast(bf16x8, __builtin_amdgcn_raw_buffer_load_b128(rsK, goff1, so_, 0)); } while (0)
#define SWRITE(b, i) do { *(bf16x8*)((char*)V_lds + (b) * SHM_V + vst0) = sr_[i].vs0;          \
    *(bf16x8*)((char*)V_lds + (b) * SHM_V + vst1) = sr_[i].vs1; int kc = sc * 2;               \
    *(bf16x8*)((char*)K_lds + (b) * SHM_K + KSWZ(sr, kc)) = sr_[i].ks0;                       \
    *(bf16x8*)((char*)K_lds + (b) * SHM_K + KSWZ(32 + sr, kc)) = sr_[i].ks1; } while (0)
#define SWAIT() asm volatile("s_waitcnt vmcnt(0)" ::: "memory")
  f32x16 pA0, pA1, pB0, pB1; bf16x8 pa0, pa1, pa2, pa3; const int NTL = seq / KVBLK;
  constexpr int SE = 0, SO = 0;
  SLOAD(SE, 0); asm volatile("s_waitcnt vmcnt(0)" ::: "memory"); SWRITE(0, SE); __syncthreads();
  qkt(pA0, pA1, K_lds, qr, r32, hi); partialSM<SUB>(pA0, pA1, mnC);
  SLOAD(SO, KVBLK);
  SWAIT(); SWRITE(1, SO); __syncthreads();
  for (int j = 1; j + 1 < NTL; j += 2) {
    SBAR(); qkt(pB0, pB1, (bf16_t*)((char*)K_lds + SHM_K), qr, r32, hi);
    finishSM(pA0, pA1, l_reg, pa0, pa1, pa2, pa3); SBAR();
    SLOAD(SO, (j + 1) * KVBLK); SBAR();
    pv_d0(o, vb0, pa0, pa1, pa2, pa3); partialSM<SUB>(pB0, pB1, mnC);
    __syncthreads(); SWAIT(); SWRITE(0, SE);
    __syncthreads();
    SBAR(); qkt(pA0, pA1, K_lds, qr, r32, hi);
    finishSM(pB0, pB1, l_reg, pa0, pa1, pa2, pa3); SBAR();
    SLOAD(SE, (j + 2) * KVBLK); SBAR();
    pv_d0(o, vb0 + (int)SHM_V, pa0, pa1, pa2, pa3); partialSM<SUB>(pA0, pA1, mnC);
    __syncthreads(); SWAIT(); SWRITE(1, SO);
    __syncthreads();
  }
  SBAR(); qkt(pB0, pB1, (bf16_t*)((char*)K_lds + SHM_K), qr, r32, hi);
  finishSM(pA0, pA1, l_reg, pa0, pa1, pa2, pa3); SBAR();
  pv_d0(o, vb0, pa0, pa1, pa2, pa3); partialSM<SUB>(pB0, pB1, mnC);
  __syncthreads();
  finishSM(pB0, pB1, l_reg, pa0, pa1, pa2, pa3); SBAR();
  pv_d0(o, vb0 + (int)SHM_V, pa0, pa1, pa2, pa3);
  if (hi == 0) li_l[r32] = l_reg; asm volatile("s_waitcnt lgkmcnt(0)" ::: "memory");
  float rli[16];
#pragma unroll
  for (int r = 0; r < 16; ++r) rli[r] = __builtin_amdgcn_rcpf(li_l[crow(r, hi)]);
  store_o_tile<LDO>(o, rli, lds + SHM_ATTN + wid * OT_BYTES, Ob + (long)(wid * QBLK) * LDO, lane);
  __syncthreads();
#undef SLOAD
#undef SWRITE
#undef SWAIT
}

constexpr int DF_K = 0, DF_V = 32768, DF_PX = 98304, DF_LI = 131072, DF_LDS = 131072 + 1024;
template <int LDK, int LDO, bool SUB>
__device__ __forceinline__ void attn_diff_body(const bf16_t* __restrict__ Qb, const bf16_t* __restrict__ Kh, const bf16_t* __restrict__ Vh,
                                               bf16_t* Ob, int seq, float mfix, const float* __restrict__ qn, const f32x2* __restrict__ rope, int pos0, char* lds,
                                               bool comb, bf16_t* Ofin, float lam, float oscale, const float* __restrict__ gain) {
  const int tid = opaque_tid(), wid = tid >> 6, lane = tid & 63, r32 = lane & 31, hi = lane >> 5, rg = wid & 3, half = wid >> 2;
  char* K_lds = lds + DF_K; char* V_lds = lds + DF_V; char* PXm = lds + DF_PX + wid * 4096; char* PXo = lds + DF_PX + (wid ^ 4) * 4096;
  float* li = (float*)(lds + DF_LI);
  const float mnC = mfix * (SCALE * 1.4426950408889634f) - 80.f; float l_reg = 0; f32x16 o[4] = {}; bf16x8 qr[8];
  const bf16_t* Qw = Qb + (long)(rg * QBLK + r32) * LDK + hi * 8;
#pragma unroll
  for (int d0 = 0; d0 < 8; ++d0) qr[d0] = *reinterpret_cast<const bf16x8*>(Qw + d0 * 16);
  q_norm_rope(qr, qn, rope, pos0 + rg * QBLK + r32, hi);
  const int sr = tid >> 4, sc = (tid & 15) * 8, vst0 = v_st(sr, sc), vst1 = v_st(32 + sr, sc), kc = sc * 2;
  const unsigned goff0 = (unsigned)(sr * LDK + sc) * 2u, goff1 = (unsigned)((32 + sr) * LDK + sc) * 2u;
  const __amdgpu_buffer_rsrc_t rsK = __builtin_amdgcn_make_buffer_rsrc((void*)Kh, (short)0, seq * (LDK * 2), 0x00020000);
  const __amdgpu_buffer_rsrc_t rsV = __builtin_amdgcn_make_buffer_rsrc((void*)Vh, (short)0, seq * (LDK * 2), 0x00020000);
  bf16x8 kr[2][2], vr[2][4];
#define DF_LDK(t0) do { _Pragma("unroll") for (int tt = 0; tt < 2; ++tt) { const unsigned so_ = (unsigned)(((t0) + tt) * KVBLK) * (unsigned)(LDK * 2); \
    kr[tt][0] = __builtin_bit_cast(bf16x8, __builtin_amdgcn_raw_buffer_load_b128(rsK, goff0, so_, 0)); kr[tt][1] = __builtin_bit_cast(bf16x8, __builtin_amdgcn_raw_buffer_load_b128(rsK, goff1, so_, 0)); } } while (0)
#define DF_LDV(t0) do { _Pragma("unroll") for (int tt = 0; tt < 2; ++tt) { const unsigned so_ = (unsigned)(((t0) + tt) * KVBLK) * (unsigned)(LDK * 2); \
    vr[tt][0] = __builtin_bit_cast(bf16x8, __builtin_amdgcn_raw_buffer_load_b128(rsV, goff0, so_, 0)); vr[tt][1] = __builtin_bit_cast(bf16x8, __builtin_amdgcn_raw_buffer_load_b128(rsV, goff1, so_, 0)); \
    vr[tt][2] = __builtin_bit_cast(bf16x8, __builtin_amdgcn_raw_buffer_load_b128(rsV, goff0 + 256u, so_, 0)); vr[tt][3] = __builtin_bit_cast(bf16x8, __builtin_amdgcn_raw_buffer_load_b128(rsV, goff1 + 256u, so_, 0)); } } while (0)
#define DF_WRK() do { _Pragma("unroll") for (int tt = 0; tt < 2; ++tt) { *(bf16x8*)(K_lds + tt * 16384 + KSWZ(sr, kc)) = kr[tt][0]; *(bf16x8*)(K_lds + tt * 16384 + KSWZ(32 + sr, kc)) = kr[tt][1]; } } while (0)
#define DF_WRV() do { _Pragma("unroll") for (int tt = 0; tt < 2; ++tt) { *(bf16x8*)(V_lds + tt * 32768 + vst0) = vr[tt][0]; *(bf16x8*)(V_lds + tt * 32768 + vst1) = vr[tt][1]; \
    *(bf16x8*)(V_lds + tt * 32768 + 16384 + vst0) = vr[tt][2]; *(bf16x8*)(V_lds + tt * 32768 + 16384 + vst1) = vr[tt][3]; } } while (0)
  const int NP = seq / (2 * KVBLK);
  const int vb = (int)(uintptr_t)V_lds + half * 16384 + v_rd_base(lane);
  DF_LDK(0); DF_LDV(0); DF_WRK(); DF_WRV(); __syncthreads();
  for (int p = 0; p < NP; ++p) {
    const bool more = p + 1 < NP;
    if (more) DF_LDK(2 * p + 2);
    SBAR();
    f32x16 p0, p1; bf16x8 pa0, pa1, pa2, pa3;
    qkt(p0, p1, (const bf16_t*)(K_lds + half * 16384), qr, r32, hi);
    partialSM<SUB>(p0, p1, mnC);
    finishSM(p0, p1, l_reg, pa0, pa1, pa2, pa3);
    *(bf16x8*)(PXm + lane * 16) = pa0; *(bf16x8*)(PXm + 1024 + lane * 16) = pa1; *(bf16x8*)(PXm + 2048 + lane * 16) = pa2; *(bf16x8*)(PXm + 3072 + lane * 16) = pa3;
    __syncthreads();
    if (more) { DF_WRK(); DF_LDV(2 * p + 2); }
    const bf16x8 po0 = *(const bf16x8*)(PXo + lane * 16), po1 = *(const bf16x8*)(PXo + 1024 + lane * 16), po2 = *(const bf16x8*)(PXo + 2048 + lane * 16), po3 = *(const bf16x8*)(PXo + 3072 + lane * 16);
    asm volatile("s_waitcnt lgkmcnt(0)" ::: "memory"); SBAR();
    if (half == 0) { pv_d0(o, vb, pa0, pa1, pa2, pa3); pv_d0(o, vb + 32768, po0, po1, po2, po3); }
    else           { pv_d0(o, vb, po0, po1, po2, po3); pv_d0(o, vb + 32768, pa0, pa1, pa2, pa3); }
    __syncthreads();
    if (more) DF_WRV();
  }
  if (hi == 0) li[wid * 32 + r32] = l_reg;
  __syncthreads();
  float rli[16];
#pragma unroll
  for (int r = 0; r < 16; ++r) rli[r] = __builtin_amdgcn_rcpf(li[wid * 32 + crow(r, hi)] + li[(wid ^ 4) * 32 + crow(r, hi)]);
  char* tb = V_lds + wid * OT_BYTES;
  bf16_t* Ow = Ob + (long)(rg * QBLK) * LDO + half * 128;
  if (!comb) store_o_tile<LDO>(o, rli, tb, Ow, lane);
  else {
    store_o_tile<LDO>(o, rli, tb, nullptr, lane);
    float* ss2 = (float*)(lds + DF_LI + 1024);
    const int ch = lane & 15, rq = lane >> 4;
    const bf16_t* O0w = Ow - 256;
    u32x4 o0[8]; float ssv[8];
#pragma unroll
    for (int it = 0; it < 8; ++it) o0[it] = *(const u32x4*)(O0w + (long)(it * 4 + rq) * LDO + ch * 8);
#pragma unroll
    for (int it = 0; it < 8; ++it) { const int row = it * 4 + rq; const u32x4 o1 = *(const u32x4*)(tb + row * OT_PITCH + ch * 16);
      const float x[8] = {bflo(o0[it].x) - lam * bflo(o1.x), bfhi(o0[it].x) - lam * bfhi(o1.x), bflo(o0[it].y) - lam * bflo(o1.y), bfhi(o0[it].y) - lam * bfhi(o1.y),
                          bflo(o0[it].z) - lam * bflo(o1.z), bfhi(o0[it].z) - lam * bfhi(o1.z), bflo(o0[it].w) - lam * bflo(o1.w), bfhi(o0[it].w) - lam * bfhi(o1.w)};
      float ss = 0.f;
#pragma unroll
      for (int e = 0; e < 8; ++e) ss += x[e] * x[e];
      ss += __shfl_xor(ss, 1); ss += __shfl_xor(ss, 2); ss += __shfl_xor(ss, 4); ss += __shfl_xor(ss, 8);
      ssv[it] = ss; if (ch == 0) ss2[wid * 32 + row] = ss; }
    __syncthreads();
    const f32x4 g0 = *(const f32x4*)(gain + half * 128 + ch * 8), g1 = *(const f32x4*)(gain + half * 128 + ch * 8 + 4);
    bf16_t* Of = Ofin + (long)(rg * QBLK) * DM + half * 128 + ch * 8;
#pragma unroll
    for (int it = 0; it < 8; ++it) { const int row = it * 4 + rq; const u32x4 o1 = *(const u32x4*)(tb + row * OT_PITCH + ch * 16);
      const float x[8] = {bflo(o0[it].x) - lam * bflo(o1.x), bfhi(o0[it].x) - lam * bfhi(o1.x), bflo(o0[it].y) - lam * bflo(o1.y), bfhi(o0[it].y) - lam * bfhi(o1.y),
                          bflo(o0[it].z) - lam * bflo(o1.z), bfhi(o0[it].z) - lam * bfhi(o1.z), bflo(o0[it].w) - lam * bflo(o1.w), bfhi(o0[it].w) - lam * bfhi(o1.w)};
      const float rs = oscale / sqrtf((ssv[it] + ss2[(wid ^ 4) * 32 + row]) * (1.f / 256.f) + NORM_EPS);
      u32x4 w; w.x = cvt_pk_bf16(x[0] * rs * g0.x, x[1] * rs * g0.y); w.y = cvt_pk_bf16(x[2] * rs * g0.z, x[3] * rs * g0.w);
      w.z = cvt_pk_bf16(x[4] * rs * g1.x, x[5] * rs * g1.y); w.w = cvt_pk_bf16(x[6] * rs * g1.z, x[7] * rs * g1.w);
      *(u32x4*)(Of + (long)row * DM) = w; }
  }
  __syncthreads();
#undef DF_LDK
#undef DF_LDV
#undef DF_WRK
#undef DF_WRV
}
}

__device__ __forceinline__ float qk_bound(const float* qn, const float* kn) {
    const int lane = threadIdx.x & 63;
    float a = fmaxf(fabsf(qn[lane]), fabsf(qn[lane + 64])), b = fmaxf(fabsf(kn[lane]), fabsf(kn[lane + 64]));
#pragma unroll
    for (int o = 1; o < 64; o <<= 1) { a = fmaxf(a, __shfl_xor(a, o)); b = fmaxf(b, __shfl_xor(b, o)); }
    return 128.f * 1.02f * a * b;
}
__device__ __forceinline__ void gqa_attn_phase(const bf16_t* P, bf16_t* O, const float* qn, const float* kn, const f32x2* rope, char* lds, int G, int bid) {
    constexpr int NBIG = 2048, NSMALL = 256;
    const float mfix = qk_bound(qn, kn);
    const bool sub = __builtin_amdgcn_readfirstlane((int)(mfix * (att::SCALE * 1.4426950408889634f) > 80.f)) != 0;
    for (int L = bid; L < NBIG + NSMALL; L += G) {
        int b, hq, q0, seq;
        if (L < NBIG) { const int xcd = L & 7, j = (L >> 3) & 31, rnd = L >> 8, bk = rnd * 8 + xcd; b = bk >> 2; const int kvh = bk & 3; hq = kvh * 4 + (j >> 3); q0 = CTXL + (j & 7) * 256; seq = TPB; }
        else { const int l2 = L - NBIG; b = l2 >> 4; hq = l2 & 15; q0 = 0; seq = CTXL; }
        const int kvh = hq >> 2;
        const bf16_t* base = P + (size_t)b * TPB * 3072;
        if (sub) att::attn_dense_body<3072, 3072, 2048, true>(base + (size_t)q0 * 3072 + hq * 128, base + 2048 + kvh * 128, base + 2560 + kvh * 128,
                                               O + ((size_t)b * TPB + q0) * DM + hq * 128, seq, mfix, qn, rope, q0 - CTXL, lds);
        else att::attn_dense_body<3072, 3072, 2048, false>(base + (size_t)q0 * 3072 + hq * 128, base + 2048 + kvh * 128, base + 2560 + kvh * 128,
                                               O + ((size_t)b * TPB + q0) * DM + hq * 128, seq, mfix, qn, rope, q0 - CTXL, lds);
    }
}
__device__ __forceinline__ void diff_attn_phase(const bf16_t* P, bf16_t* OD, bf16_t* O, const float* qn, const float* kn, const f32x2* rope,
                                                const float* lq1, const float* lk1, const float* lq2, const float* lk2, const float* gain, char* lds, int G, int bid) {
    const float mfix = qk_bound(qn, kn);
    const bool sub = __builtin_amdgcn_readfirstlane((int)(mfix * (att::SCALE * 1.4426950408889634f) > 80.f)) != 0;
    const int lane = threadIdx.x & 63;
    const float lam_init = 0.8f - 0.6f * 0.54881163609402643f;
    const float d1 = wave_sum(lq1[lane] * lk1[lane] + lq1[lane + 64] * lk1[lane + 64]);
    const float d2 = wave_sum(lq2[lane] * lk2[lane] + lq2[lane + 64] * lk2[lane + 64]);
    const float lam = expf(d1) - expf(d2) + lam_init, oscale = 1.f - lam_init;
    for (int L = bid; L < 2048; L += G) {
        const int xcd = L & 7, j = (L >> 3) & 31, rnd = L >> 8, bh = (rnd * 8 + xcd) * 2 + (j >> 4), b = bh >> 3, h = bh & 7, qb = j & 15;
        const bf16_t* base = P + (size_t)b * TPB * 6144;
        bf16_t* Of = O + ((size_t)b * TPB + CTXL + qb * 128) * DM + h * 256;
#pragma unroll 1
        for (int m = 0; m < 2; ++m) {
            if (sub) att::attn_diff_body<6144, 4096, true>(base + (size_t)(CTXL + qb * 128) * 6144 + (2 * h + m) * 128, base + 2048 + (2 * h + m) * 128, base + 4096 + h * 256,
                                        OD + ((size_t)b * SEQ + qb * 128) * 4096 + (2 * h + m) * 256, TPB, mfix, qn, rope, qb * 128, lds, m == 1, Of, lam, oscale, gain);
            else att::attn_diff_body<6144, 4096, false>(base + (size_t)(CTXL + qb * 128) * 6144 + (2 * h + m) * 128, base + 2048 + (2 * h + m) * 128, base + 4096 + h * 256,
                                        OD + ((size_t)b * SEQ + qb * 128) * 4096 + (2 * h + m) * 256, TPB, mfix, qn, rope, qb * 128, lds, m == 1, Of, lam, oscale, gain);
        }
    }
}
__device__ __forceinline__ void diff_combine_phase(const bf16_t* OD, bf16_t* O, const float* lq1, const float* lk1, const float* lq2, const float* lk2, const float* gain, int G, int bid) {
    const int tid = threadIdx.x, lane = tid & 63, wave = __builtin_amdgcn_readfirstlane(tid >> 6);
    const float lam_init = 0.8f - 0.6f * 0.54881163609402643f;
    const float d1 = wave_sum(lq1[lane] * lk1[lane] + lq1[lane + 64] * lk1[lane + 64]);
    const float d2 = wave_sum(lq2[lane] * lk2[lane] + lq2[lane + 64] * lk2[lane + 64]);
    const float lam = expf(d1) - expf(d2) + lam_init;
    const float oscale = 1.f - lam_init;
    const int sub = lane >> 5, li = lane & 31;
    const f32x4 g0 = *(const f32x4*)(gain + 8 * li), g1 = *(const f32x4*)(gain + 8 * li + 4);
    const long total = (long)NLAT * 4, stride = (long)G * 8;
    constexpr int NI = 4;
    for (long id0 = (long)bid * 8 + wave; id0 < total; id0 += stride * NI) {
        u32x4 a[NI], c[NI]; bf16_t* op[NI]; bool ok[NI];
#pragma unroll
        for (int i = 0; i < NI; ++i) { const long id = id0 + stride * i; ok[i] = id < total; const long idc = ok[i] ? id : id0;
            const int lr = (int)(idc >> 2), h = (int)(idc & 3) * 2 + sub;
            const bf16_t* p = OD + (size_t)lr * 4096 + (2 * h) * 256 + 8 * li; a[i] = *(const u32x4*)p; c[i] = *(const u32x4*)(p + 256);
            const int b = lr / SEQ, t = lr - b * SEQ; op[i] = O + ((size_t)b * TPB + CTXL + t) * DM + h * 256 + 8 * li; }
#pragma unroll
        for (int i = 0; i < NI; ++i) {
            float x[8] = {bflo(a[i].x) - lam * bflo(c[i].x), bfhi(a[i].x) - lam * bfhi(c[i].x), bflo(a[i].y) - lam * bflo(c[i].y), bfhi(a[i].y) - lam * bfhi(c[i].y),
                          bflo(a[i].z) - lam * bflo(c[i].z), bfhi(a[i].z) - lam * bfhi(c[i].z), bflo(a[i].w) - lam * bflo(c[i].w), bfhi(a[i].w) - lam * bfhi(c[i].w)};
            float ss = 0.f;
#pragma unroll
            for (int e = 0; e < 8; ++e) ss += x[e] * x[e];
            ss += __shfl_xor(ss, 1); ss += __shfl_xor(ss, 2); ss += __shfl_xor(ss, 4); ss += __shfl_xor(ss, 8); ss += __shfl_xor(ss, 16);
            const float rs = oscale / sqrtf(ss * (1.f / 256.f) + NORM_EPS);
            u32x4 o; o.x = cvt_pk_bf16(x[0] * rs * g0.x, x[1] * rs * g0.y); o.y = cvt_pk_bf16(x[2] * rs * g0.z, x[3] * rs * g0.w);
            o.z = cvt_pk_bf16(x[4] * rs * g1.x, x[5] * rs * g1.y); o.w = cvt_pk_bf16(x[6] * rs * g1.z, x[7] * rs * g1.w);
            if (ok[i]) *(u32x4*)op[i] = o;
        }
    }
}

__device__ __forceinline__ float logsigmoidf(float x) { return fminf(x, 0.f) - __logf(1.f + __expf(-fabsf(x))); }
constexpr int G1_ZS = 0, G1_HT = 8192, G1_MS = 12288, G1_QS = 21504, G1_KS = 55296, G1_VS = 21504;
template <int DIR>
__device__ __forceinline__ void gla_prep_dir(const bf16_t* P, const float* wg, const float* bg, bf16_t* QT, bf16_t* KTT, float* CM, float* CL, LAS unsigned char* lds,
                                             int b, int h, int c, int R0, const unsigned (&raw)[32], f32x4 (&accOut)[2]) {
    const int tid = opaque_tid(), lane = tid & 63, wave = __builtin_amdgcn_readfirstlane(tid >> 6), d = tid & 255, half = tid >> 8;
    LAS float* ZS = (LAS float*)(lds + G1_ZS); LAS float* HT = (LAS float*)(lds + G1_HT);
    LAS bf16_t* QS = (LAS bf16_t*)(lds + G1_QS); LAS bf16_t* KS = (LAS bf16_t*)(lds + G1_KS);
    f32x2 wp[8];
#pragma unroll
    for (int kk = 0; kk < 8; ++kk) wp[kk] = (f32x2){wg[(2 * kk) * 1024 + 256 * h + d], wg[(2 * kk + 1) * 1024 + 256 * h + d]};
    const float bias = bg[256 * h + d];
    float cum[32];
#pragma unroll
    for (int ii = 0; ii < 32; ++ii) {
        const LAS float* zr = ZS + (half * 32 + ii) * 32 + DIR * 16;
        const f32x4 z0 = *(const LAS f32x4*)zr, z1 = *(const LAS f32x4*)(zr + 4), z2 = *(const LAS f32x4*)(zr + 8), z3 = *(const LAS f32x4*)(zr + 12);
        f32x2 a2 = (f32x2){z0.x, z0.y} * wp[0];
        a2 += (f32x2){z0.z, z0.w} * wp[1]; a2 += (f32x2){z1.x, z1.y} * wp[2]; a2 += (f32x2){z1.z, z1.w} * wp[3];
        a2 += (f32x2){z2.x, z2.y} * wp[4]; a2 += (f32x2){z2.z, z2.w} * wp[5]; a2 += (f32x2){z3.x, z3.y} * wp[6]; a2 += (f32x2){z3.z, z3.w} * wp[7];
        const float x = (a2.x + a2.y) + bias;
        const float t = __builtin_amdgcn_exp2f(fabsf(x) * -1.4426950408889634f);
        cum[ii] = fmaf(__builtin_amdgcn_logf(1.0f + t), -0.6931471805599453f * 0.0625f, fminf(x, 0.f) * 0.0625f);
    }
    float total;
    if (DIR == 0) {
#pragma unroll
        for (int ii = 1; ii < 32; ++ii) cum[ii] += cum[ii - 1];
        total = cum[31];
    } else {
#pragma unroll
        for (int ii = 30; ii >= 0; --ii) cum[ii] += cum[ii + 1];
        total = cum[0];
    }
    HT[(DIR * 2 + half) * 256 + d] = total;
    __syncthreads();
    const float t0 = HT[(DIR * 2 + 0) * 256 + d], t1 = HT[(DIR * 2 + 1) * 256 + d];
    const float cmid = DIR == 0 ? t0 : t1, clast = t0 + t1;
    const float add = DIR == 0 ? (half == 1 ? t0 : 0.f) : (half == 0 ? t1 : 0.f);
    unsigned kpack[16];
    const float ecl = __expf(clast - cmid);
#pragma unroll
    for (int i0 = 0; i0 < 32; i0 += 8) {
        float kcv[8];
#pragma unroll
        for (int e = 0; e < 8; ++e) {
            const int ii = i0 + e;
            const float cu = cum[ii] + add;
            const float e1 = __expf(cu - cmid);
            const f32x2 ee = {e1, __builtin_amdgcn_rcpf(e1)};
            const f32x2 qk = (f32x2){__builtin_bit_cast(float, raw[ii] << 16), __builtin_bit_cast(float, raw[ii] & 0xffff0000u)} * ee;
            const unsigned qkb = cvt_pk_bf16(qk.x * 0.0625f, qk.y);
            QS[(half * 32 + ii) * 264 + d] = (bf16_t)(qkb & 0xffffu); KS[(half * 32 + ii) * 264 + d] = (bf16_t)(qkb >> 16);
            kcv[e] = qk.y * ecl;
        }
#pragma unroll
        for (int e = 0; e < 8; e += 2) kpack[(i0 + e) >> 1] = cvt_pk_bf16(kcv[e], kcv[e + 1]);
    }
    const size_t chunk_frag0 = ((((size_t)DIR * NB + b) * 36 + c) * 4 + h) * 32;
    {
        bf16_t* kt = KTT + (chunk_frag0 + (size_t)(d >> 4) * 2 + half) * 512 + (d & 15) * 8;
#pragma unroll
        for (int q = 0; q < 4; ++q) *(u32x4*)(kt + q * 128) = (u32x4){kpack[4 * q], kpack[4 * q + 1], kpack[4 * q + 2], kpack[4 * q + 3]};
    }
    if (half == 0) { const size_t vi = (((size_t)DIR * NB + b) * 36 + c) * 1024 + 256 * h + d; CM[vi] = cmid; CL[vi] = clast; }
    __syncthreads();
    const int ti = wave >> 1, tj0 = (wave & 1) * 2, fr = lane & 15, fq = lane >> 4;
    {
#pragma unroll
        for (int x = 0; x < 4; ++x) { const int f = wave * 4 + x, fti = f >> 3, fks = f & 7;
            *(bf16x8*)(QT + (chunk_frag0 + f) * 512 + lane * 8) = *(const LAS bf16x8*)(QS + (16 * fti + fr) * 264 + 32 * fks + 8 * fq); }
    }
#pragma unroll
    for (int x = 0; x < 2; ++x) {
        f32x4 acc = {0.f, 0.f, 0.f, 0.f};
#pragma unroll
        for (int ks = 0; ks < 8; ++ks) {
            const bf16x8 av = *(const LAS bf16x8*)(QS + (16 * ti + fr) * 264 + 32 * ks + 8 * fq);
            const bf16x8 bv = *(const LAS bf16x8*)(KS + (16 * (tj0 + x) + fr) * 264 + 32 * ks + 8 * fq);
            acc = __builtin_amdgcn_mfma_f32_16x16x32_bf16(av, bv, acc, 0, 0, 0);
        }
        accOut[x] = acc;
    }
    __syncthreads();
}
__device__ __forceinline__ void gla_prep_phase(const bf16_t* P, const float* Z, const float* wgf, const float* bgf, const float* wgb, const float* bgb,
                                               bf16_t* QT, bf16_t* KTT, bf16_t* VT, float* CM, float* CL, _Float16* O32, LAS unsigned char* lds, int G, int bid) {
    const int tid = opaque_tid(), lane = tid & 63, wave = __builtin_amdgcn_readfirstlane(tid >> 6), fr = lane & 15, fq = lane >> 4;
    LAS float* ZS = (LAS float*)(lds + G1_ZS);
    LAS bf16_t* MS = (LAS bf16_t*)(lds + G1_MS);
    LAS bf16_t* VSw = (LAS bf16_t*)(lds + G1_VS) + wave * (64 * 72);
    for (int u = bid; u < NB * 4 * 36; u += G) {
        const int b = u / 144, rem = u - b * 144, h = rem / 36, c = rem - h * 36, R0 = b * TPB + 64 * c;
        { const int row = tid >> 3, c4 = (tid & 7) * 4; *(LAS f32x4*)(ZS + row * 32 + c4) = *(const f32x4*)(Z + (size_t)(R0 + row) * 32 + c4); }
        __syncthreads();
        unsigned raw[32];
        { const bf16_t* qp = P + (size_t)(R0 + (tid >> 8) * 32) * 6144 + 256 * h + (tid & 255);
#pragma unroll
          for (int ii = 0; ii < 32; ++ii) raw[ii] = (unsigned)qp[(size_t)ii * 6144] | ((unsigned)qp[(size_t)ii * 6144 + 1024] << 16); }
        f32x4 accF[2], accB[2];
        gla_prep_dir<0>(P, wgf, bgf, QT, KTT, CM, CL, lds, b, h, c, R0, raw, accF);
        gla_prep_dir<1>(P, wgb, bgb, QT, KTT, CM, CL, lds, b, h, c, R0, raw, accB);
        const int ti = wave >> 1, tj0 = (wave & 1) * 2;
#pragma unroll
        for (int x = 0; x < 2; ++x)
#pragma unroll
            for (int r = 0; r < 4; ++r) { const int i = 16 * ti + 4 * fq + r, j = 16 * (tj0 + x) + fr;
                const float m = (j <= i ? accF[x][r] : 0.f) + (j >= i ? accB[x][r] : 0.f);
                MS[i * 72 + j] = (bf16_t)f2bf(m); }
#pragma unroll
        for (int it = 0; it < 8; ++it) { const int q = it * 64 + lane, j = q >> 3, ec = (q & 7) * 8;
            const u32x4 w = *(const u32x4*)(P + (size_t)(R0 + j) * 6144 + 2048 + 512 * h + 64 * wave + ec);
            const int js = (((j >> 3) ^ (q & 7)) << 3) | (j & 7);
            VSw[(ec + 0) * 72 + js] = (bf16_t)(w.x & 0xffff); VSw[(ec + 1) * 72 + js] = (bf16_t)(w.x >> 16);
            VSw[(ec + 2) * 72 + js] = (bf16_t)(w.y & 0xffff); VSw[(ec + 3) * 72 + js] = (bf16_t)(w.y >> 16);
            VSw[(ec + 4) * 72 + js] = (bf16_t)(w.z & 0xffff); VSw[(ec + 5) * 72 + js] = (bf16_t)(w.z >> 16);
            VSw[(ec + 6) * 72 + js] = (bf16_t)(w.w & 0xffff); VSw[(ec + 7) * 72 + js] = (bf16_t)(w.w >> 16); }
        __syncthreads();
        {
            bf16_t* vt = VT + ((((size_t)b * 36 + c) * 4 + h) * 512 + 64 * wave) * 64;
#pragma unroll
            for (int it = 0; it < 8; ++it) { const int q = it * 64 + lane, e = q >> 3, jc = (q & 7) * 8;
                *(u32x4*)(vt + (size_t)e * 64 + jc) = *(const LAS u32x4*)(VSw + e * 72 + (jc ^ (((e >> 3) & 7) << 3))); }
        }
        f32x4 oacc[4][4];
#pragma unroll
        for (int a = 0; a < 4; ++a)
#pragma unroll
            for (int bb = 0; bb < 4; ++bb) oacc[a][bb] = (f32x4){0.f, 0.f, 0.f, 0.f};
#pragma unroll
        for (int ks = 0; ks < 2; ++ks) {
            bf16x8 av[4], bv[4];
#pragma unroll
            for (int t = 0; t < 4; ++t) { av[t] = *(const LAS bf16x8*)(MS + (16 * t + fr) * 72 + 32 * ks + 8 * fq); bv[t] = *(const LAS bf16x8*)(VSw + (16 * t + fr) * 72 + (((4 * ks + fq) ^ ((2 * t + (fr >> 3)) & 7)) << 3)); }
#pragma unroll
            for (int a = 0; a < 4; ++a)
#pragma unroll
                for (int bb = 0; bb < 4; ++bb) oacc[a][bb] = __builtin_amdgcn_mfma_f32_16x16x32_bf16(bv[bb], av[a], oacc[a][bb], 0, 0, 0);
        }
#pragma unroll
        for (int a = 0; a < 4; ++a) { _Float16* op = O32 + (size_t)(R0 + 16 * a + fr) * 2048 + 512 * h + 64 * wave + 4 * fq;
#pragma unroll
            for (int bb = 0; bb < 4; ++bb) { u32x2 w; w.x = pk_f16(oacc[a][bb].x, oacc[a][bb].y); w.y = pk_f16(oacc[a][bb].z, oacc[a][bb].w); *(u32x2*)(op + 16 * bb) = w; } }
        __syncthreads();
    }
}
constexpr int SC_ST = 0, SC_VT = 67584, SC_VTB = 18432;
__device__ __forceinline__ void gla_scan_phase(const bf16_t* QT, const bf16_t* KTT, const bf16_t* VT, const float* CM, const float* CL, _Float16* O32, LAS unsigned char* lds, int G, int bid, float sgn = 1.f) {
    const int tid = opaque_tid(), lane = tid & 63, wave = __builtin_amdgcn_readfirstlane(tid >> 6), fr = lane & 15, fq = lane >> 4;
    const int ti = wave >> 1, tj0 = (wave & 1) * 4;
    LAS bf16_t* ST = (LAS bf16_t*)(lds + SC_ST);
    const int vte = tid >> 2, vtp = tid & 3;
    for (int u0 = bid; u0 < 256; u0 += G) {
        const int u = (G == 256) ? ((u0 & 7) * 32 + (u0 >> 3)) : u0;
        const int b = u >> 4, h = (u >> 2) & 3, sl = u & 3;
#define SC_CHUNK(q, dir, c) const int dir = (q) >= 36 ? 1 : 0; const int s_##c = (q) - 36 * dir; const int c = dir == 0 ? s_##c : (s_##c < 4 ? 3 - s_##c : 39 - s_##c)
#define SC_LOAD_CMCL(q) do { SC_CHUNK(q, d_, c_); const size_t vb = (((size_t)d_ * NB + b) * 36 + c_) * 1024 + 256 * h + 32 * wave + 4 * fq; \
        _Pragma("unroll") for (int t = 0; t < 2; ++t) { cm[t] = *(const f32x4*)(CM + vb + 16 * t); cl[t] = *(const f32x4*)(CL + vb + 16 * t); } } while (0)
#define SC_LOAD_Q(q) do { SC_CHUNK(q, d_, c_); const bf16_t* qfr = QT + ((((((size_t)d_ * NB + b) * 36 + c_) * 4 + h) * 32) + ti * 8) * 512 + lane * 8; \
        _Pragma("unroll") for (int ks = 0; ks < 8; ++ks) qf[ks] = *(const bf16x8*)(qfr + ks * 512); } while (0)
#define SC_LOAD_K(q) do { SC_CHUNK(q, d_, c_); const bf16_t* kb = KTT + ((((((size_t)d_ * NB + b) * 36 + c_) * 4 + h) * 32) + wave * 4) * 512 + lane * 8; \
        _Pragma("unroll") for (int ks = 0; ks < 2; ++ks) _Pragma("unroll") for (int t = 0; t < 2; ++t) kf[t][ks] = *(const bf16x8*)(kb + (t * 2 + ks) * 512); } while (0)
#define SC_LOAD_V(q) do { SC_CHUNK(q, d_, c_); (void)d_; const bf16_t* vp = VT + ((((size_t)b * 36 + c_) * 4 + h) * 512 + 128 * sl + vte) * 64 + 16 * vtp; \
        vs0 = *(const bf16x8*)vp; vs1 = *(const bf16x8*)(vp + 8); } while (0)
#define SC_WRITE_V(buf) do { LAS bf16_t* vd = (LAS bf16_t*)(lds + SC_VT + (buf) * SC_VTB) + vte * 72 + 16 * vtp; *(LAS bf16x8*)vd = vs0; *(LAS bf16x8*)(vd + 8) = vs1; } while (0)
#define SC_LOAD_O(q) do { SC_CHUNK(q, d_, c_); (void)d_; const _Float16* ob_ = O32 + (size_t)(b * TPB + 64 * c_ + 16 * ti + fr) * 2048 + 512 * h + 128 * sl + 16 * tj0 + 4 * fq; \
        _Pragma("unroll") for (int x = 0; x < 4; ++x) ov[x] = *(const u32x2*)(ob_ + 16 * x); } while (0)
        f32x4 S[2][8];
#pragma unroll
        for (int t = 0; t < 2; ++t)
#pragma unroll
            for (int uu = 0; uu < 8; ++uu) S[t][uu] = (f32x4){0.f, 0.f, 0.f, 0.f};
        f32x4 cm[2], cl[2]; bf16x8 qf[8], kf[2][2], vs0, vs1; u32x2 ov[4];
        SC_LOAD_V(0); SC_WRITE_V(0); SC_LOAD_V(1);
        SC_LOAD_CMCL(0); SC_LOAD_Q(0); SC_LOAD_K(0); SC_LOAD_O(0);
        __syncthreads();
        for (int q = 0; q < 72; ++q) {
            SC_CHUNK(q, dir, c);
            (void)dir;
            const int R0 = b * TPB + 64 * c;
            const int qn = q < 71 ? q + 1 : 71, qnn = q < 70 ? q + 2 : 71;
            if (q == 36) {
#pragma unroll
                for (int t = 0; t < 2; ++t)
#pragma unroll
                    for (int uu = 0; uu < 8; ++uu) S[t][uu] = (f32x4){0.f, 0.f, 0.f, 0.f};
            }
            _Float16* const ob = O32 + (size_t)(R0 + 16 * ti + fr) * 2048 + 512 * h + 128 * sl + 16 * tj0 + 4 * fq;
            f32x4 dec[2];
#pragma unroll
            for (int t = 0; t < 2; ++t) { const f32x4 e = {__expf(cm[t].x), __expf(cm[t].y), __expf(cm[t].z), __expf(cm[t].w)};
                dec[t] = (f32x4){__expf(cl[t].x), __expf(cl[t].y), __expf(cl[t].z), __expf(cl[t].w)};
#pragma unroll
                for (int uu = 0; uu < 8; ++uu) { const f32x4 v = S[t][uu] * e; u32x2 w; w.x = cvt_pk_bf16(v.x, v.y); w.y = cvt_pk_bf16(v.z, v.w);
                    *(LAS u32x2*)(ST + (16 * uu + fr) * 264 + 32 * wave + 16 * t + 4 * fq) = w; } }
            SC_LOAD_CMCL(qn);
            __syncthreads();
            SC_WRITE_V((q + 1) & 1); SC_LOAD_V(qnn);
            f32x4 oa[4];
#pragma unroll
            for (int x = 0; x < 4; ++x) oa[x] = (f32x4){0.f, 0.f, 0.f, 0.f};
#pragma unroll
            for (int ks = 0; ks < 8; ++ks) {
#pragma unroll
                for (int x = 0; x < 4; ++x) { const bf16x8 bv = *(const LAS bf16x8*)(ST + (16 * (tj0 + x) + fr) * 264 + 32 * ks + 8 * fq);
                    oa[x] = __builtin_amdgcn_mfma_f32_16x16x32_bf16(bv, qf[ks], oa[x], 0, 0, 0); } }
            __syncthreads();
            SC_LOAD_Q(qn);
#pragma unroll
            for (int x = 0; x < 4; ++x) { u32x2 w; w.x = pk_f16(f16lo(ov[x].x) + sgn * oa[x].x, f16hi(ov[x].x) + sgn * oa[x].y); w.y = pk_f16(f16lo(ov[x].y) + sgn * oa[x].z, f16hi(ov[x].y) + sgn * oa[x].w);
                *(u32x2*)(ob + 16 * x) = w; }
            SC_LOAD_O(qn);
            const LAS bf16_t* vt = (const LAS bf16_t*)(lds + SC_VT + (q & 1) * SC_VTB);
#pragma unroll
            for (int t = 0; t < 2; ++t)
#pragma unroll
                for (int uu = 0; uu < 8; ++uu) S[t][uu] = S[t][uu] * dec[t];
#pragma unroll
            for (int ks = 0; ks < 2; ++ks)
#pragma unroll
                for (int uu = 0; uu < 8; ++uu) { const bf16x8 bv = *(const LAS bf16x8*)(vt + (16 * uu + fr) * 72 + 32 * ks + 8 * fq);
#pragma unroll
                    for (int t = 0; t < 2; ++t) S[t][uu] = __builtin_amdgcn_mfma_f32_16x16x32_bf16(kf[t][ks], bv, S[t][uu], 0, 0, 0); }
            SC_LOAD_K(qn);
        }
        __syncthreads();
#undef SC_CHUNK
#undef SC_LOAD_CMCL
#undef SC_LOAD_Q
#undef SC_LOAD_K
#undef SC_LOAD_V
#undef SC_WRITE_V
#undef SC_LOAD_O
    }
}
__device__ __forceinline__ void gla_finish_phase(const _Float16* O32, const bf16_t* P, const float* gain, bf16_t* O, int G, int bid) {
    const int tid = threadIdx.x, lane = tid & 63, wave = __builtin_amdgcn_readfirstlane(tid >> 6);
    const f32x4 g0 = *(const f32x4*)(gain + 4 * lane), g1 = *(const f32x4*)(gain + 256 + 4 * lane);
    const long total = (long)NT * 4, stride = (long)G * 8;
    constexpr int NI = 4;
    for (long id0 = (long)bid * 8 + wave; id0 < total; id0 += stride * NI) {
        u32x2 qa[NI], qc[NI]; f32x4 a[NI], c[NI]; u32x2 ra[NI], rc[NI]; bf16_t* op[NI]; bool ok[NI];
#pragma unroll
        for (int i = 0; i < NI; ++i) { const long id = id0 + stride * i; ok[i] = id < total; const long idc = ok[i] ? id : id0;
            const int r = (int)(idc >> 2), h = (int)(idc & 3);
            const _Float16* ip = O32 + (size_t)r * 2048 + 512 * h + 4 * lane; qa[i] = *(const u32x2*)ip; qc[i] = *(const u32x2*)(ip + 256);
            const bf16_t* rp = P + (size_t)r * 6144 + 4096 + 512 * h + 4 * lane; ra[i] = *(const u32x2*)rp; rc[i] = *(const u32x2*)(rp + 256);
            op[i] = O + (size_t)r * DM + 512 * h + 4 * lane; }
#pragma unroll
        for (int i = 0; i < NI; ++i) {
            a[i] = (f32x4){f16lo(qa[i].x), f16hi(qa[i].x), f16lo(qa[i].y), f16hi(qa[i].y)}; c[i] = (f32x4){f16lo(qc[i].x), f16hi(qc[i].x), f16lo(qc[i].y), f16hi(qc[i].y)};
            const float ss = wave_sum((a[i].x * a[i].x + a[i].y * a[i].y) + (a[i].z * a[i].z + a[i].w * a[i].w) + (c[i].x * c[i].x + c[i].y * c[i].y) + (c[i].z * c[i].z + c[i].w * c[i].w));
            const float rs = 1.0f / sqrtf(ss * (1.f / 512.f) + NORM_EPS);
            u32x2 o0, o1;
            o0.x = cvt_pk_bf16(a[i].x * rs * g0.x * siluf(bflo(ra[i].x)), a[i].y * rs * g0.y * siluf(bfhi(ra[i].x)));
            o0.y = cvt_pk_bf16(a[i].z * rs * g0.z * siluf(bflo(ra[i].y)), a[i].w * rs * g0.w * siluf(bfhi(ra[i].y)));
            o1.x = cvt_pk_bf16(c[i].x * rs * g1.x * siluf(bflo(rc[i].x)), c[i].y * rs * g1.y * siluf(bfhi(rc[i].x)));
            o1.y = cvt_pk_bf16(c[i].z * rs * g1.z * siluf(bflo(rc[i].y)), c[i].w * rs * g1.w * siluf(bfhi(rc[i].y)));
            if (ok[i]) { *(u32x2*)op[i] = o0; *(u32x2*)(op[i] + 256) = o1; }
        }
    }
}

__device__ __forceinline__ void fnet_nyquist(const bf16_t* DFT2m, const bf16_t* UVT, bf16_t* O, int G, int bid) {
    const int tid = opaque_tid(), lane = tid & 63, wave = __builtin_amdgcn_readfirstlane(tid >> 6), fr = lane & 15, fq = lane >> 4;
    for (int task = bid * 8 + wave; task < NB * 128; task += G * 8) {
        const int b = task >> 7, l0 = (task & 127) * 16;
        const bf16_t* ap = DFT2m + (size_t)(l0 + fr) * 4096 + 8 * fq;
        const bf16_t* bp = UVT + ((size_t)b * 1024 + (size_t)(fr & 3) * 256) * 4096 + 2048 + 8 * fq;
        f32x4 acc = {0.f, 0.f, 0.f, 0.f};
#pragma unroll 8
        for (int ks = 0; ks < 64; ++ks) acc = __builtin_amdgcn_mfma_f32_16x16x32_bf16(*(const bf16x8*)(ap + 32 * ks), *(const bf16x8*)(bp + 32 * ks), acc, 0, 0, 0);
        if (fr < 4) {
#pragma unroll
            for (int r = 0; r < 4; ++r) O[((size_t)b * TPB + CTXL + l0 + 4 * fq + r) * DM + fr * 512 + 256] = (bf16_t)f2bf(acc[r]);
        }
    }
}

__device__ __forceinline__ void fnet_row1024(const bf16_t* UVT, bf16_t* O, int G, int bid) {
    const int tid = opaque_tid(), lane = tid & 63, wave = __builtin_amdgcn_readfirstlane(tid >> 6);
    const float cw = bf2f((unsigned short)f2bf(0.022097086912079608f));
    for (int task = bid * 8 + wave; task < NB * 1024; task += G * 8) {
        const int b = task >> 10, ch = task & 1023, g = ch >> 8, t = ch & 255;
        const bf16_t* up = UVT + ((size_t)b * 1024 + ch) * 4096 + 8 * lane;
        float sum = 0.f;
#pragma unroll
        for (int j = 0; j < 4; ++j) { const u32x4 w = *(const u32x4*)(up + 512 * j);
            sum += (bflo(w.x) - bfhi(w.x)) + (bflo(w.y) - bfhi(w.y)) + (bflo(w.z) - bfhi(w.z)) + (bflo(w.w) - bfhi(w.w)); }
        sum = wave_sum(sum) * cw;
        if (lane == 0) { bf16_t* orow = O + ((size_t)b * TPB + CTXL + 1024) * DM + g * 512; const bf16_t v = (bf16_t)f2bf(sum); orow[t] = v; if (t != 0) orow[256 + t] = v; }
    }
}

constexpr int NPH = 34;
template <int L> __device__ __forceinline__ int c_in(int which) {
    constexpr int base = L == 0 ? 4 : L == 1 ? 17 : L == 2 ? 27 : 42;
    constexpr int n2 = L == 0 ? 14 : L == 1 ? 24 : L == 2 ? 39 : 46;
    return which < 3 ? base + which : n2 + (which - 3);
}
__global__ void __launch_bounds__(512, 2) fwd_kernel(KArgs a) {
    extern __shared__ __attribute__((aligned(16))) unsigned char lds_raw[];
    LAS unsigned char* lds = (LAS unsigned char*)lds_raw;
    const int tid = threadIdx.x, G = gridDim.x, bid = blockIdx.x;
    if (tid < 16) ((LAS unsigned*)(lds + MISC_OFF))[tid] = 0u;
    __syncthreads();
    unsigned* barw = (unsigned*)(a.ws + WS_CTL) + 4096;
    XcdBarrier bar; bar.bar = barw; bar.x = 0; bar.st = (volatile LAS unsigned*)(lds + MISC_OFF);
    if (N_LAUNCH_MODE == 1) bar = xcd_barrier_post(barw, (volatile LAS unsigned*)(lds + MISC_OFF));
    const int lo = a.ph_lo, hi = a.ph_hi;
#ifndef PHSEL
#define PHSEL -1
#endif
#define IN(k) ((PHSEL < 0 || PHSEL == (k)) && lo <= (k) && (k) < hi)
#ifndef STAMP_A
#define STAMP_A -100
#endif
#ifndef STAMP_B
#define STAMP_B -100
#endif
    unsigned long long tA0 = 0, tA1 = 0, tB0 = 0, tB1 = 0;
#define STAMP_AT(k) do { if ((k) + 1 == STAMP_A) tA0 = wall_clock64(); if ((k) == STAMP_A) tA1 = wall_clock64(); if ((k) + 1 == STAMP_B) tB0 = wall_clock64(); if ((k) == STAMP_B) tB1 = wall_clock64(); } while (0)
#define SEAM(k) do { if (IN(k) && IN((k) + 1)) xcd_barrier(bar); STAMP_AT(k); } while (0)
#ifndef PROBE_REP
#define PROBE_REP -1
#endif
#ifndef PROBE_N
#define PROBE_N 2
#endif
#define REPS(k) (PROBE_REP == (k) ? PROBE_N : 1)

#define p_ws (a.ws)
#define p_modv ((float*)(a.ws + WS_MODV))
#define p_rope ((const f32x2*)(a.ws + WS_ROPE))
#define p_DFT1 ((bf16_t*)(a.ws + WS_DFT1))
#define p_DFT2 ((bf16_t*)(a.ws + WS_DFT2))
#define p_Wf1 ((bf16_t*)(a.ws + W_FFN1))
#define p_Wf2 ((bf16_t*)(a.ws + W_FFN2))
#define p_Win ((bf16_t*)(a.ws + W_IN))
#define p_Wout ((bf16_t*)(a.ws + W_OUT))
#define p_xh ((void*)(a.ws + WS_XH))
#define p_xhc ((void*)(a.ws + WS_XHC))
#define p_HN ((bf16_t*)(a.ws + WS_HN))
#define p_OB ((bf16_t*)(a.ws + WS_O))
#define p_BIG ((bf16_t*)(a.ws + WS_BIG))
#define p_out (a.out)

#define PH_PREP(k, L, FIN, FOUT, WI, NIN, WO, LATONLY, ...) if (IN(k)) { \
        convert_layer(a, lds, bid * 8 + (int)(threadIdx.x >> 6), G * 8, FIN, FOUT, WI, NIN, WO, ##__VA_ARGS__); \
        norm_phase<(L != 0)>(L == 0 ? (const void*)a.in[0] : (const void*)p_xh, L == 0 ? (const void*)a.in[2] : (const void*)p_xhc, a.in[c_in<L>(2)], p_modv + (size_t)L * 17 * 12288, 0, 2048, p_HN, LATONLY, G, bid, L == 0 ? p_xh : nullptr, L == 0 ? p_xhc : nullptr); } SEAM(k)
#ifndef SKEW_TICKS
#define SKEW_TICKS 0
#endif
#define PH_SKEW() do { if (SKEW_TICKS > 0) { const unsigned long long t0_ = __builtin_amdgcn_s_memrealtime(); const unsigned long long w_ = (unsigned long long)(bid & 3) * SKEW_TICKS; \
        while (__builtin_amdgcn_s_memrealtime() - t0_ < w_) __builtin_amdgcn_s_sleep(32); } } while (0)
#define PH_PROJ(k, NN, LDC, ZT, ZP, KLO, KHI, KN, PROJTAIL) if (IN(k)) { PH_SKEW(); \
        ProbStd g{p_HN, p_Win, DM, DM, DM, 0}; pg8::UOrder S; S.init(144, NN, 1, G, bid, 4); EpiProj E{p_BIG, LDC, ZT, ZP, KLO, KHI, KN, p_rope}; \
        pg8::gemm_phase<ProbStd, EpiProj>(lds, g, S, E); PROJTAIL } SEAM(k)
#define PROJTAIL_L(L, FIRST) if (G == 256 && bid >= (FIRST)) convert_layer(a, lds, (bid - (FIRST)) * 8 + (int)(threadIdx.x >> 6), (256 - (FIRST)) * 8, nullptr, a.in[c_in<L>(5)], nullptr, 0, nullptr);
#define PH_DELAY(ticks) do { if ((ticks) > 0 && G == 256 && bid >= 128) { const unsigned long long t0_ = __builtin_amdgcn_s_memrealtime(); \
        while (__builtin_amdgcn_s_memrealtime() - t0_ < (unsigned long long)(ticks)) __builtin_amdgcn_s_sleep(32); } } while (0)
#define PH_OUT(k, L, AMAP, OUTTAIL) if (IN(k)) { PH_DELAY(0); \
        ProbStd g{p_OB, p_Wout, DM, DM, DM, AMAP}; pg8::UOrder S; S.init(AMAP ? 128 : 144, 8, 1, G, bid, 4); \
        EpiResT<true, true> E{p_xh, p_xhc, p_xh, p_xhc, p_modv + (size_t)L * 17 * 12288, 4096, AMAP}; \
        pg8::gemm_phase<ProbStd, EpiResT<true, true>>(lds, g, S, E); OUTTAIL } SEAM(k)
#define FFNTAIL(FIRST, FIN, FOUT, SH1, SH2) if (G == 256 && bid >= (FIRST)) convert_layer(a, lds, (bid - (FIRST)) * 8 + (int)(threadIdx.x >> 6), (256 - (FIRST)) * 8, FIN, FOUT, nullptr, 0, nullptr, 0, SH1, SH2); \
        else if (G != 256) convert_layer(a, lds, bid * 8 + (int)(threadIdx.x >> 6), G * 8, FIN, FOUT, nullptr, 0, nullptr, 0, SH1, SH2);
#define PH_NORM2(k, L, AMAP) if (IN(k)) { \
        norm_phase<true>(p_xh, p_xhc, a.in[c_in<L>(3)], p_modv + (size_t)L * 17 * 12288, 6144, 8192, p_HN, AMAP, G, bid); } SEAM(k)
#define PH_FFN1(k, L, AMAP) if (IN(k)) { PH_SKEW(); \
        ProbStd g{p_HN, L == 3 ? (bf16_t*)(p_ws + WS_W3F1) : p_Wf1, DM, DM, DM, AMAP}; pg8::UOrder S; S.init(AMAP ? 128 : 144, 44, 1, G, bid, 4); EpiSwiGLU E{p_BIG, AMAP}; \
        pg8::gemm_phase<ProbStd, EpiSwiGLU>(lds, g, S, E); } SEAM(k)
#define PH_FFN2(k, L, AMAP, TAILCONV) if (IN(k)) { \
        ProbStd g{p_BIG, L == 3 ? (bf16_t*)(p_ws + WS_W3F2) : p_Wf2, FF, FF, FF, AMAP}; pg8::UOrder S; S.init(AMAP ? 128 : 144, 8, 1, G, bid, 4, 1); \
        EpiResT<true, (L != 3)> E{p_xh, p_xhc, L == 3 ? (void*)p_out : p_xh, p_xhc, p_modv + (size_t)L * 17 * 12288, 10240, AMAP}; \
        pg8::gemm_phase<ProbStd, EpiResT<true, (L != 3)>>(lds, g, S, E); TAILCONV } SEAM(k)
#define TAILCONV_L(L1, WI, NIN, WO) if (G == 256 && bid >= 128) convert_layer(a, lds, (bid - 128) * 8 + (int)(threadIdx.x >> 6), 128 * 8, a.in[c_in<L1>(4)], nullptr, WI, NIN, WO); \
        else if (G != 256) { xcd_barrier(bar); convert_layer(a, lds, bid * 8 + (int)(threadIdx.x >> 6), G * 8, a.in[c_in<L1>(4)], nullptr, WI, NIN, WO); }

    if (IN(0)) { ph_prologue(a, lds, G, bid); } SEAM(0);
#if PROBE_REP == 0
    if (IN(0)) { ph_prologue(a, lds, G, bid); } SEAM(0);
#endif
#if PROBE_REP >= 200 && PROBE_REP < 210
    if (IN(0)) { const int tid_ = opaque_tid(), lane_ = tid_ & 63, wv_ = tid_ >> 6;
        char* base_ = (char*)(p_ws + WS_O32) + (size_t)bid * (PROBE_REP == 202 ? (size_t)256 * 11264 : (size_t)131072);
        u32x4 val_ = {(unsigned)tid_, 1u, 2u, 3u}; u32x4 accl_ = {0u, 0u, 0u, 0u};
#pragma unroll 1
        for (int it = 0; it < 1024; it += 8) {
#pragma unroll
            for (int k2 = 0; k2 < 8; ++k2) { const int slot = ((it + k2) & 15) * 8 + wv_;
                char* p_;
                if (PROBE_REP == 200 || PROBE_REP == 203) p_ = base_ + (size_t)slot * 1024 + lane_ * 16;
                else if (PROBE_REP == 201) p_ = base_ + (size_t)((slot >> 3) * 16 + (lane_ & 15)) * 512 + (slot & 7) * 64 + (lane_ >> 4) * 16;
                else if (PROBE_REP == 204) p_ = base_ + (size_t)((slot >> 2) * 8 + (lane_ >> 3)) * 512 + (slot & 3) * 128 + (lane_ & 7) * 16;
                else if (PROBE_REP == 205) p_ = base_ + (size_t)((slot >> 3) * 16 + (lane_ >> 2)) * 512 + (slot & 7) * 64 + (lane_ & 3) * 16;
                else p_ = base_ + (size_t)((slot >> 3) * 16 + (lane_ & 15)) * 11264 + (slot & 7) * 64 + (lane_ >> 4) * 16;
                if (PROBE_REP == 203) { const u32x4 r_ = *(const volatile u32x4*)p_; accl_ += r_; }
                else { val_.y += 1u; *(u32x4*)p_ = val_; } }
        }
        if (PROBE_REP == 203 && accl_.x == 0x12345678u && accl_.y == 77u) *(u32x4*)base_ = accl_;
    } SEAM(0);
#endif

    PH_PREP(1, 0, nullptr, nullptr, a.in[7], 6176, a.in[13], 0);
#if PROBE_REP == 1
    PH_PREP(1, 0, nullptr, nullptr, a.in[7], 6176, a.in[13], 0);
#endif
    PH_PROJ(2, 25, 6144, 24, (float*)(p_ws + WS_Z), 0, 0, nullptr, FFNTAIL(16, a.in[c_in<0>(4)], a.in[c_in<0>(5)], 0, 0));
#if PROBE_REP == 2
    PH_PROJ(2, 25, 6144, 24, (float*)(p_ws + WS_Z), 0, 0, nullptr, FFNTAIL(16, a.in[c_in<0>(4)], a.in[c_in<0>(5)], 0, 0));
#endif
    {
        bf16_t* QT = (bf16_t*)(p_ws + WS_O); bf16_t* KTT = (bf16_t*)(p_ws + WS_KTT); bf16_t* VT = (bf16_t*)(p_ws + WS_HN);
        float* CM = (float*)(p_ws + WS_CMCL); float* CL = CM + (size_t)2 * NB * 36 * 1024; _Float16* O32 = (_Float16*)p_out;
        if (IN(3)) { gla_prep_phase(p_BIG, (const float*)(p_ws + WS_Z), a.in[8], a.in[9], a.in[10], a.in[11], QT, KTT, VT, CM, CL, O32, lds, G, bid); } SEAM(3);
#if PROBE_REP == 3
        if (IN(3)) { gla_prep_phase(p_BIG, (const float*)(p_ws + WS_Z), a.in[8], a.in[9], a.in[10], a.in[11], QT, KTT, VT, CM, CL, O32, lds, G, bid); } SEAM(3);
#endif
#if PROBE_REP == 4
        if (IN(4)) { gla_scan_phase(QT, KTT, VT, CM, CL, O32, lds, G, bid); xcd_barrier(bar); gla_scan_phase(QT, KTT, VT, CM, CL, O32, lds, G, bid, -1.f); xcd_barrier(bar); }
#endif
        if (IN(4)) { gla_scan_phase(QT, KTT, VT, CM, CL, O32, lds, G, bid); } SEAM(4);
        if (IN(5)) { gla_finish_phase(O32, p_BIG, a.in[12], p_OB, G, bid); } SEAM(5);
#if PROBE_REP == 5
        if (IN(5)) { gla_finish_phase(O32, p_BIG, a.in[12], p_OB, G, bid); } SEAM(5);
#endif
    }
    PH_OUT(6, 0, 0, FFNTAIL(128, nullptr, a.in[c_in<3>(5)], 0, WS_W3F2 - W_FFN2));
#if PROBE_REP == 6
    PH_OUT(6, 0, 0, FFNTAIL(128, nullptr, a.in[c_in<3>(5)], 0, WS_W3F2 - W_FFN2));
#endif
    PH_NORM2(7, 0, 0);
#if PROBE_REP == 7
    PH_NORM2(7, 0, 0);
#endif
    PH_FFN1(8, 0, 0);
#if PROBE_REP == 8
    PH_FFN1(8, 0, 0);
#endif
    PH_FFN2(9, 0, 0, TAILCONV_L(1, a.in[20], 3072, a.in[23]));

    PH_PREP(10, 1, nullptr, (G == 256 ? (const float*)nullptr : a.in[c_in<1>(5)]), nullptr, 0, nullptr, 0);
#if PROBE_REP == 10
    PH_PREP(10, 1, nullptr, (G == 256 ? (const float*)nullptr : a.in[c_in<1>(5)]), nullptr, 0, nullptr, 0);
#endif
    PH_PROJ(11, 12, 3072, -1, nullptr, 8, 10, a.in[22], PROJTAIL_L(1, 192));
#if PROBE_REP == 11
    PH_PROJ(11, 12, 3072, -1, nullptr, 8, 10, a.in[22], PROJTAIL_L(1, 192));
#endif
    if (IN(13)) { gqa_attn_phase(p_BIG, p_OB, a.in[21], a.in[22], p_rope, (char*)lds_raw, G, bid); } SEAM(13);
#if PROBE_REP == 13
    if (IN(13)) { gqa_attn_phase(p_BIG, p_OB, a.in[21], a.in[22], p_rope, (char*)lds_raw, G, bid); } SEAM(13);
#endif
    PH_OUT(14, 1, 0, FFNTAIL(128, a.in[c_in<3>(4)], nullptr, WS_W3F1 - W_FFN1, 0));
    PH_NORM2(15, 1, 0);
#if PROBE_REP == 15
    PH_NORM2(15, 1, 0);
#endif
    PH_FFN1(16, 1, 0);
#if PROBE_REP == 16
    PH_FFN1(16, 1, 0);
#endif
    PH_FFN2(17, 1, 0, TAILCONV_L(2, a.in[30], 6144, a.in[38]));

    PH_PREP(18, 2, nullptr, (G == 256 ? (const float*)nullptr : a.in[c_in<2>(5)]), nullptr, 0, nullptr, 0);
#if PROBE_REP == 18
    PH_PREP(18, 2, nullptr, (G == 256 ? (const float*)nullptr : a.in[c_in<2>(5)]), nullptr, 0, nullptr, 0);
#endif
    PH_PROJ(19, 24, 6144, -1, nullptr, 8, 16, a.in[32], PROJTAIL_L(2, 128));
#if PROBE_REP == 19
    PH_PROJ(19, 24, 6144, -1, nullptr, 8, 16, a.in[32], PROJTAIL_L(2, 128));
#endif
    if (IN(21)) { diff_attn_phase(p_BIG, (bf16_t*)(p_ws + WS_GX), p_OB, a.in[31], a.in[32], p_rope, a.in[33], a.in[34], a.in[35], a.in[36], a.in[37], (char*)lds_raw, G, bid); } SEAM(21);
#if PROBE_REP == 21
    if (IN(21)) { diff_attn_phase(p_BIG, (bf16_t*)(p_ws + WS_GX), p_OB, a.in[31], a.in[32], p_rope, a.in[33], a.in[34], a.in[35], a.in[36], a.in[37], (char*)lds_raw, G, bid); } SEAM(21);
#endif
    PH_OUT(23, 2, 1, );
    PH_NORM2(24, 2, 1);
#if PROBE_REP == 24
    PH_NORM2(24, 2, 1);
#endif
    PH_FFN1(25, 2, 1);
#if PROBE_REP == 25
    PH_FFN1(25, 2, 1);
#endif
    PH_FFN2(26, 2, 1, );

    PH_PREP(27, 3, nullptr, nullptr, nullptr, 0, a.in[45], 1, 2);
#if PROBE_REP == 27
    PH_PREP(27, 3, nullptr, nullptr, nullptr, 0, a.in[45], 1, 2);
#endif
    if (IN(28)) { ProbF1 g{p_DFT1, p_HN, 512, DM, 512}; pg8::UOrder S; S.init(2, 8, 64, G, bid); EpiF1 E{p_BIG}; pg8::gemm_phase<ProbF1, EpiF1>(lds, g, S, E); } SEAM(28);
#if PROBE_REP == 28
    if (IN(28)) { ProbF1 g{p_DFT1, p_HN, 512, DM, 512}; pg8::UOrder S; S.init(2, 8, 64, G, bid); EpiF1 E{p_BIG}; pg8::gemm_phase<ProbF1, EpiF1>(lds, g, S, E); } SEAM(28);
#endif
    if (IN(29)) { ProbF2 g{p_DFT2, p_BIG, 4096, 4096, 2048}; pg8::UOrder S; S.init(4, 4, 16, G, bid); EpiF2P E{p_BIG + (size_t)64 * 1024 * 1024};
        pg8::gemm_phase<ProbF2, EpiF2P>(lds, g, S, E); fnet_nyquist(p_DFT2, p_BIG, p_OB, G, bid); fnet_row1024(p_BIG, p_OB, G, bid); } SEAM(29);
    if (IN(29)) { ProbF2 g{p_DFT2 + 2048, p_BIG + 2048, 4096, 4096, 2048}; pg8::UOrder S; S.init(4, 4, 16, G, bid); EpiF2Q E{p_BIG + (size_t)64 * 1024 * 1024, p_OB};
        pg8::gemm_phase<ProbF2, EpiF2Q>(lds, g, S, E); } SEAM(29);
    PH_OUT(30, 3, 1, );
    PH_NORM2(31, 3, 1);
#if PROBE_REP == 31
    PH_NORM2(31, 3, 1);
#endif
    PH_FFN1(32, 3, 1);
#if PROBE_REP == 32
    PH_FFN1(32, 3, 1);
#endif
    PH_FFN2(33, 3, 1, );
#if STAMP_A >= 0
    xcd_barrier(bar); STAMP_AT(33);
    if (bid == 0 && tid == 0) p_out[0] = (float)(tA1 - tA0) * 0.01f;
    if (bid == 1) { const float bv = STAMP_B >= 0 ? (float)(tB1 - tB0) * 0.001f : 50.f; for (int i = 1 + tid; i <= 1000000; i += 512) p_out[i] = bv; }
#endif
#undef IN
#undef SEAM
#undef p_ws
#undef p_modv
#undef p_rope
#undef p_DFT1
#undef p_DFT2
#undef p_Wf1
#undef p_Wf2
#undef p_Win
#undef p_Wout
#undef p_xh
#undef p_xhc
#undef p_HN
#undef p_OB
#undef p_BIG
#undef p_out
}

extern "C" void kernel_launch(void* const* d_in, const int* in_sizes, int n_in, void* d_out, int out_size, void* d_ws, size_t ws_size, hipStream_t stream) {
    static int grid = 0;
    if (grid == 0) {
        if (n_in != 49 || out_size != NLAT * DM || ws_size < WS_END) { fprintf(stderr, "kernel_launch: unexpected shapes: n_in %d out %d ws %zu (need >= %zu)\n", n_in, out_size, ws_size, (size_t)WS_END); grid = -1; return; }
        int dev = 0, cus = 0, per_cu = 0;
        if (hipGetDevice(&dev) != hipSuccess || hipDeviceGetAttribute(&cus, hipDeviceAttributeMultiprocessorCount, dev) != hipSuccess) { grid = -1; return; }
        if (hipFuncSetAttribute((const void*)fwd_kernel, hipFuncAttributeMaxDynamicSharedMemorySize, LDS_BYTES) != hipSuccess) { fprintf(stderr, "kernel_launch: hipFuncSetAttribute failed\n"); grid = -1; return; }
        if (hipOccupancyMaxActiveBlocksPerMultiprocessor(&per_cu, (const void*)fwd_kernel, 512, LDS_BYTES) != hipSuccess || per_cu < 1) { fprintf(stderr, "kernel_launch: occupancy query says %d\n", per_cu); }
        (void)hipGetLastError();
        grid = cus;
    }
    if (grid < 0) return;
    (void)hipMemsetAsync((char*)d_ws + WS_CTL, 0, CTL_ZERO_BYTES, stream);
    KArgs a{};
    for (int i = 0; i < 49; ++i) a.in[i] = (const float*)d_in[i];
    a.out = (float*)d_out; a.ws = (unsigned char*)d_ws;
#if N_LAUNCH_MODE == 1
    a.ph_lo = 0; a.ph_hi = NPH;
    hipLaunchKernelGGL(fwd_kernel, dim3(grid), dim3(512), LDS_BYTES, stream, a);
#else
    for (int k = 0; k < NPH; ++k) { a.ph_lo = k; a.ph_hi = k + 1; hipLaunchKernelGGL(fwd_kernel, dim3(grid), dim3(512), LDS_BYTES, stream, a); }
#endif
    const hipError_t le = hipPeekAtLastError();
    if (le != hipSuccess) fprintf(stderr, "kernel_launch: launch failed: %s\n", hipGetErrorName(le));
}
```

```cpp
#include <hip/hip_runtime.h>
#include <cstdio>
#include <cstdint>

#define LAS __attribute__((address_space(3)))
typedef unsigned short bf16_t;
typedef short bf16x8 __attribute__((ext_vector_type(8)));
typedef short s16x4 __attribute__((ext_vector_type(4)));
typedef float f32x4 __attribute__((ext_vector_type(4)));
typedef float f32x2 __attribute__((ext_vector_type(2)));
typedef float f32x16 __attribute__((ext_vector_type(16)));
typedef unsigned u32x4 __attribute__((ext_vector_type(4)));
typedef unsigned u32x2 __attribute__((ext_vector_type(2)));
typedef _Float16 f16x2 __attribute__((ext_vector_type(2)));

#ifndef N_LAUNCH_MODE
#define N_LAUNCH_MODE 1
#endif

constexpr int NB = 16, SEQ = 2048, DM = 2048, CTXL = 256, TPB = 2304  , NT = NB * TPB, FF = 5632;
constexpr int NLAT = NB * SEQ;
constexpr float NORM_EPS = 1e-6f;

constexpr size_t MiB = 1u << 20;
constexpr size_t WS_CTL = 0, CTL_ZERO_BYTES = 65536;
constexpr size_t WS_MODV = 1 * MiB;
constexpr size_t WS_ROPE = 5 * MiB;
constexpr size_t WS_DFT1 = 6 * MiB;
constexpr size_t WS_DFT2 = 7 * MiB;
constexpr size_t WS_W = 24 * MiB;
constexpr size_t W_FFN1 = WS_W, W_FFN2 = WS_W + 44 * MiB, W_IN = WS_W + 66 * MiB, W_OUT = WS_W + 91 * MiB;
constexpr size_t WS_XCTX = 128 * MiB;
constexpr size_t WS_HN = 160 * MiB;
constexpr size_t WS_O = 304 * MiB;
constexpr size_t WS_BIG = 448 * MiB;
constexpr size_t WS_GX = 880 * MiB;
constexpr size_t WS_KTT = WS_GX, WS_CMCL = WS_GX + 144 * MiB, WS_Z = WS_GX + 154 * MiB;
constexpr size_t WS_O32 = 1039 * MiB;
constexpr size_t WS_W3F1 = 1280 * MiB, WS_W3F2 = 128 * MiB;
constexpr size_t WS_XH = 1136 * MiB;
constexpr size_t WS_XHC = 1264 * MiB;
constexpr size_t WS_END = 1327 * MiB;

constexpr int RING_BYTES = 131072;
constexpr int LDS_BYTES = 147456;
constexpr int MISC_OFF = LDS_BYTES - 64;

__device__ __forceinline__ unsigned f2bf(float f) { unsigned u = __builtin_bit_cast(unsigned, f); return (u + 0x7fffu + ((u >> 16) & 1u)) >> 16; }
__device__ __forceinline__ unsigned pk2(float lo, float hi) { return f2bf(lo) | (f2bf(hi) << 16); }
__device__ __forceinline__ float bf2f(unsigned short b) { return __builtin_bit_cast(float, ((unsigned)b) << 16); }
__device__ __forceinline__ float bflo(unsigned w) { return __builtin_bit_cast(float, w << 16); }
__device__ __forceinline__ float bfhi(unsigned w) { return __builtin_bit_cast(float, w & 0xffff0000u); }
__device__ __forceinline__ unsigned cvt_pk_bf16(float lo, float hi) { unsigned r; asm volatile("v_cvt_pk_bf16_f32 %0, %1, %2" : "=v"(r) : "v"(lo), "v"(hi)); return r; }
__device__ __forceinline__ float wave_sum(float v) {
#pragma unroll
    for (int o = 1; o < 64; o <<= 1) v += __shfl_xor(v, o);
    return v;
}
__device__ __forceinline__ float siluf(float v) { return v * __builtin_amdgcn_rcpf(1.f + __expf(-v)); }
__device__ __forceinline__ int opaque_tid() { int t = threadIdx.x; asm volatile("" : "+v"(t)); return t; }
#define LDS_WAIT() asm volatile("s_waitcnt lgkmcnt(0)" ::: "memory")
#define VM_WAIT() asm volatile("s_waitcnt vmcnt(0)" ::: "memory")

#define XB_TMO      128
#define XB_XCNT(j)  (256  + 64 * (j))
#define XB_XSUB(j)  (1280 + 64 * (j))
#define XB_XGEN(j)  (2304 + 64 * (j))
#define XB_TOP      3328
#define XB_TOPGEN   3392
#define XCD_BAR_WORDS 3456
#define XB_SPIN_CAP (1u << 24)
__device__ __forceinline__ unsigned xb_ld(unsigned* p)              { return __hip_atomic_load(p, __ATOMIC_RELAXED, __HIP_MEMORY_SCOPE_AGENT); }
__device__ __forceinline__ unsigned xb_add(unsigned* p, unsigned v) { return __hip_atomic_fetch_add(p, v, __ATOMIC_RELAXED, __HIP_MEMORY_SCOPE_AGENT); }
__device__ __forceinline__ unsigned xb_xcc_id() { return (unsigned)__builtin_amdgcn_s_getreg((3 << 11) | 20) & 0xFu; }
#define XB_SPIN(cond, bar) do { unsigned _sp = 0; while (cond) { __builtin_amdgcn_s_sleep(1); \
    if ((++_sp & 255u) == 0u) { if (xb_ld(&(bar)[XB_TMO])) break; if (_sp > XB_SPIN_CAP) { atomicAdd(&(bar)[XB_TMO], 1u); break; } } } } while (0)
struct XcdBarrier { unsigned* bar; unsigned x; volatile LAS unsigned* st; };
__device__ __forceinline__ XcdBarrier xcd_barrier_post(unsigned* bar, volatile LAS unsigned* st) {
    XcdBarrier b; b.bar = bar; b.x = xb_xcc_id(); b.st = st;
    if (threadIdx.x == 0) (void)xb_add(&bar[XB_XCNT(b.x)], 1u);
    return b;
}
__device__ __forceinline__ void xcd_barrier_complete(unsigned* bar, unsigned x, unsigned& nloc, unsigned& nx) {
    const unsigned G = gridDim.x * gridDim.y * gridDim.z;
    unsigned sum, cnt, mine, sp = 0u;
    for (;;) {
        sum = 0u; cnt = 0u; mine = 0u;
#pragma unroll
        for (unsigned j = 0; j < 16; ++j) { const unsigned c = xb_ld(&bar[XB_XCNT(j)]); sum += c; cnt += (c > 0u) ? 1u : 0u; mine = (j == x) ? c : mine; }
        if (sum == G) break;
        __builtin_amdgcn_s_sleep(1);
        if ((++sp & 255u) == 0u) { if (xb_ld(&bar[XB_TMO])) break; if (sp > XB_SPIN_CAP) { atomicAdd(&bar[XB_TMO], 1u); break; } }
    }
    nloc = mine > 0u ? mine : 1u; nx = cnt > 0u ? cnt : 1u;
}
__device__ __forceinline__ void xcd_barrier(const XcdBarrier& b) {
    asm volatile("s_waitcnt vmcnt(0)" ::: "memory");
    __syncthreads();
    if (threadIdx.x == 0) {
        unsigned* bar = b.bar;
        __builtin_amdgcn_s_waitcnt(0);
        unsigned nloc = b.st[0], nx = b.st[1];
        if (nloc == 0u) { xcd_barrier_complete(bar, b.x, nloc, nx); b.st[0] = nloc; b.st[1] = nx; }
        const unsigned old = xb_add(&bar[XB_XSUB(b.x)], 1u);
        const unsigned gen = old / nloc;
        if (old + 1u == (gen + 1u) * nloc) {
            __builtin_amdgcn_fence(__ATOMIC_RELEASE, "agent");
            asm volatile("s_waitcnt vmcnt(0)" ::: "memory");
            const unsigned og = xb_add(&bar[XB_TOP], 1u);
            const unsigned tg = og / nx;
            if (og + 1u == (tg + 1u) * nx) xb_add(&bar[XB_TOPGEN], 1u);
            else XB_SPIN(xb_ld(&bar[XB_TOPGEN]) == tg, bar);
            __builtin_amdgcn_fence(__ATOMIC_ACQUIRE, "agent");
            xb_add(&bar[XB_XGEN(b.x)], 1u);
            asm volatile("s_waitcnt vmcnt(0)" ::: "memory");
        } else {
            XB_SPIN(xb_ld(&bar[XB_XGEN(b.x)]) == gen, bar);
            __builtin_amdgcn_fence(__ATOMIC_ACQUIRE, "agent");
            asm volatile("s_waitcnt vmcnt(0)" ::: "memory");
        }
    }
    __syncthreads();
}

namespace pg8 {
constexpr int BM = 256, BK = 64, HALF = 128, HTB = HALF * BK * 2, STAGE_BYTES = 8 * HTB, NXCD = 8, WGM = 8;
__host__ __device__ __forceinline__ int lds_byte(int r, int c) { const int st = (r >> 4) * 2 + (c >> 5), rr = r & 15, cc = c & 31, ob = rr * 64 + cc * 2; return st * 1024 + (ob ^ (((ob >> 9) & 1) << 5)); }
__host__ __device__ __forceinline__ void stage_rc(int b, int& R, int& C) { const int st = b / 1024, sb = b % 1024, swz = sb ^ (((sb >> 9) & 1) << 5); R = (st >> 1) * 16 + swz / 64; C = (st & 1) * 32 + (swz % 64) / 2; }
__host__ __device__ __forceinline__ int perm32(int rho) { const int n = rho >> 4, i = rho & 15; return 8 * (i >> 2) + 4 * n + (i & 3); }

struct Unit { int pm, pn, z; };
struct UOrder {
    int nM, nN, nZ, nwg, G, c, wgm, rev;
    __device__ __forceinline__ void init(int nM_, int nN_, int nZ_, int G_, int c_, int wgm_ = WGM, int rev_ = 0) { nM = nM_; nN = nN_; nZ = nZ_; nwg = nM_ * nN_ * nZ_; G = G_; c = c_; wgm = wgm_; rev = rev_; }
    __device__ __forceinline__ bool next(int i, Unit& u) const {
        const long L = (long)i * G + c; if (L >= nwg) return false;
        int wgid = (int)L; { const int q = nwg / NXCD, r = nwg % NXCD, xcd = wgid % NXCD, off = wgid / NXCD; wgid = (xcd < r ? xcd * (q + 1) : r * (q + 1) + (xcd - r) * q) + off; }
        if (rev) wgid = nwg - 1 - wgid;
        const int per = nM * nN; u.z = wgid / per; const int w2 = wgid - u.z * per;
        const int nig = wgm * nN, gid = w2 / nig, fm = gid * wgm, gsz = (nM - fm) < wgm ? (nM - fm) : wgm;
        u.pm = fm + ((w2 % nig) % gsz); u.pn = (w2 % nig) / gsz; return true;
    }
};

template <class Prob, class Epi>
__device__ __forceinline__ void gemm_phase(LAS unsigned char* lds, const Prob g, const UOrder& S, const Epi& E) {
    const int tid = opaque_tid(), wid = __builtin_amdgcn_readfirstlane(tid >> 6), lane = tid & 63, wr = wid >> 2, wc = wid & 3, fr = lane & 15, fq = lane >> 4;
    const int K = g.K, nt = K / BK;
    unsigned voffA[2], voffB[2];
#pragma unroll
    for (int i = 0; i < 2; ++i) { int R, C; stage_rc(tid * 16 + i * 8192, R, C); const int Rb = Epi::PERM ? ((R & ~31) + perm32(R & 31)) : R;
        voffA[i] = (unsigned)(R * g.lda + C) * 2u; voffB[i] = (unsigned)(Rb * g.ldb + C) * 2u; }
    const size_t kstep = (size_t)(BK * 2);
    const size_t hstepA = (size_t)HALF * g.lda * 2, hstepB = (size_t)HALF * g.ldb * 2;
    const unsigned ldsw = (unsigned)wid * 1024u;
    const int aoff = lds_byte(wr * 64 + fr, fq * 8), boff = lds_byte(wc * 32 + fr, fq * 8);
#define PG8_SA(b, h) (((b) * 2 + (h)) * HTB)
#define PG8_SB(b, h) ((4 + (b) * 2 + (h)) * HTB)
#define PG8_STAGE(bufoff, gbase, voff) do { _Pragma("unroll") for (int _i = 0; _i < 2; ++_i) \
        __builtin_amdgcn_global_load_lds((const unsigned*)((const char*)(gbase) + (voff)[_i]), (LAS unsigned*)(lds + (bufoff) + ldsw + _i * 8192), 16, 0, 0); } while (0)
#define PG8_LDA(dst, b, h) do { _Pragma("unroll") for (int m = 0; m < 4; ++m) _Pragma("unroll") for (int k = 0; k < 2; ++k) dst[m][k] = *(const LAS bf16x8*)(lds + PG8_SA(b, h) + aoff + m * 2048 + k * 1024); } while (0)
#define PG8_LDB(dst, b, h) do { _Pragma("unroll") for (int n = 0; n < 2; ++n) _Pragma("unroll") for (int k = 0; k < 2; ++k) dst[n][k] = *(const LAS bf16x8*)(lds + PG8_SB(b, h) + boff + n * 2048 + k * 1024); } while (0)
#define PG8_MMA(ai, bj, At, Bt) do { __builtin_amdgcn_s_setprio(1); _Pragma("unroll") for (int m = 0; m < 4; ++m) _Pragma("unroll") for (int n = 0; n < 2; ++n) _Pragma("unroll") for (int k = 0; k < 2; ++k) \
        acc[ai][bj][m][n] = __builtin_amdgcn_mfma_f32_16x16x32_bf16(Bt[n][k], At[m][k], acc[ai][bj][m][n], 0, 0, 0); __builtin_amdgcn_s_setprio(0); } while (0)
#define PG8_WAIT_V(n) asm volatile("s_waitcnt vmcnt(" #n ")" ::: "memory")
#define PG8_WAIT_L(n) asm volatile("s_waitcnt lgkmcnt(" #n ")" ::: "memory")
#define PG8_BAR __builtin_amdgcn_s_barrier()
#define PG8_SCHED __builtin_amdgcn_sched_barrier(0)
    Unit cur, nxt; int ui = 0;
    if (!S.next(0, cur)) return;
    f32x4 acc[2][2][4][2];
#pragma unroll
    for (int a = 0; a < 2; ++a)
#pragma unroll
        for (int b = 0; b < 2; ++b)
#pragma unroll
            for (int m = 0; m < 4; ++m)
#pragma unroll
                for (int n = 0; n < 2; ++n) acc[a][b][m][n] = (f32x4){0.f, 0.f, 0.f, 0.f};
    bf16x8 At[4][2], B0[2][2], B1[2][2];
    const char* cA = g.a_tile(cur); const char* cB = g.b_tile(cur);
    PG8_STAGE(PG8_SB(0, 0), cB, voffB); PG8_STAGE(PG8_SB(0, 1), cB + hstepB, voffB); PG8_STAGE(PG8_SA(0, 0), cA, voffA); PG8_STAGE(PG8_SA(0, 1), cA + hstepA, voffA);
    if (wr == 1) PG8_BAR;
    PG8_WAIT_V(2); PG8_BAR;
    PG8_STAGE(PG8_SB(1, 0), cB + kstep, voffB); PG8_STAGE(PG8_SA(1, 0), cA + kstep, voffA); PG8_STAGE(PG8_SB(1, 1), cB + hstepB + kstep, voffB);
    PG8_WAIT_V(6); PG8_BAR;
    for (;;) {
        const bool has_next = S.next(ui + 1, nxt);
        const char* nA = has_next ? g.a_tile(nxt) : cA; const char* nB = has_next ? g.b_tile(nxt) : cB;
        for (int t = 0; t < nt; t += 2) {
            const bool last = (t == nt - 2);
            const char* a1 = cA + (size_t)(t + 1) * kstep;
            const char* a2 = last ? nA : cA + (size_t)(t + 2) * kstep; const char* b2 = last ? nB : cB + (size_t)(t + 2) * kstep;
            const char* a3 = a2 + kstep; const char* b3 = b2 + kstep;
            PG8_LDB(B0, 0, 0); PG8_LDB(B1, 0, 1); PG8_SCHED; PG8_LDA(At, 0, 0); PG8_STAGE(PG8_SA(1, 1), a1 + hstepA, voffA);
            PG8_WAIT_V(8); PG8_WAIT_L(0); PG8_BAR; PG8_MMA(0, 0, At, B0); PG8_MMA(0, 1, At, B1); PG8_BAR; PG8_SCHED;
            PG8_LDA(At, 0, 1); PG8_STAGE(PG8_SB(0, 0), b2, voffB); PG8_STAGE(PG8_SB(0, 1), b2 + hstepB, voffB); PG8_STAGE(PG8_SA(0, 0), a2, voffA);
            PG8_WAIT_V(8); PG8_WAIT_L(0); PG8_BAR; PG8_MMA(1, 0, At, B0); PG8_MMA(1, 1, At, B1); PG8_BAR; PG8_SCHED;
            PG8_LDB(B0, 1, 0); PG8_LDB(B1, 1, 1); PG8_SCHED; PG8_LDA(At, 1, 0); PG8_STAGE(PG8_SA(0, 1), a2 + hstepA, voffA);
            PG8_WAIT_V(8); PG8_WAIT_L(0); PG8_BAR; PG8_MMA(0, 0, At, B0); PG8_MMA(0, 1, At, B1); PG8_BAR; PG8_SCHED;
            PG8_LDA(At, 1, 1); PG8_STAGE(PG8_SB(1, 0), b3, voffB); PG8_STAGE(PG8_SB(1, 1), b3 + hstepB, voffB); PG8_STAGE(PG8_SA(1, 0), a3, voffA);
            PG8_WAIT_V(8); PG8_WAIT_L(0); PG8_BAR; PG8_MMA(1, 0, At, B0); PG8_MMA(1, 1, At, B1); PG8_BAR; PG8_SCHED;
        }
        if (wr == 0) PG8_BAR;
        E(acc, cur, wr, wc, fr, fq);
        if (!has_next) break;
#pragma unroll
        for (int a = 0; a < 2; ++a)
#pragma unroll
            for (int b = 0; b < 2; ++b)
#pragma unroll
                for (int m = 0; m < 4; ++m)
#pragma unroll
                    for (int n = 0; n < 2; ++n) acc[a][b][m][n] = (f32x4){0.f, 0.f, 0.f, 0.f};
        cur = nxt; cA = nA; cB = nB; ++ui;
        if (wr == 1) PG8_BAR;
    }
    PG8_WAIT_V(0);
    PG8_BAR;
#undef PG8_SA
#undef PG8_SB
#undef PG8_STAGE
#undef PG8_LDA
#undef PG8_LDB
#undef PG8_MMA
#undef PG8_WAIT_V
#undef PG8_WAIT_L
#undef PG8_BAR
#undef PG8_SCHED
}
}
using pg8::Unit;

__device__ __forceinline__ int row_tile(int pm, int amap) { return amap ? 9 * (pm >> 3) + 1 + (pm & 7) : pm; }

struct ProbStd {
    const bf16_t* A; const bf16_t* Bt; int lda, ldb, K, amap;
    __device__ __forceinline__ const char* a_tile(const Unit& u) const { return (const char*)(A + (size_t)row_tile(u.pm, amap) * 256 * lda); }
    __device__ __forceinline__ const char* b_tile(const Unit& u) const { return (const char*)(Bt + (size_t)u.pn * 256 * ldb); }
};
struct ProbF1 {
    const bf16_t* A; const bf16_t* HN; int lda, ldb, K;
    __device__ __forceinline__ const char* a_tile(const Unit& u) const { return (const char*)(A + (size_t)u.pm * 256 * 512); }
    __device__ __forceinline__ const char* b_tile(const Unit& u) const { return (const char*)(HN + ((size_t)(u.z >> 2) * TPB + CTXL + (size_t)u.pn * 256) * DM + (u.z & 3) * 512); }
};
struct ProbF2 {
    const bf16_t* A; const bf16_t* UVT; int lda, ldb, K; static constexpr int akstep = 128;
    __device__ __forceinline__ const char* a_tile(const Unit& u) const { return (const char*)(A + (size_t)u.pm * 256 * 4096); }
    __device__ __forceinline__ const char* b_tile(const Unit& u) const { return (const char*)(UVT + ((size_t)u.z * 1024 + (size_t)u.pn * 256) * 4096); }
};

__device__ __forceinline__ void store_tile_bf16(const f32x4 (&acc)[2][2][4][2], bf16_t* base, size_t ldc, int wr, int wc, int fr, int fq) {
#pragma unroll
    for (int ai = 0; ai < 2; ++ai)
#pragma unroll
        for (int m = 0; m < 4; ++m) { bf16_t* rowp = base + (size_t)(ai * 128 + wr * 64 + m * 16 + fr) * ldc + wc * 32 + 8 * fq;
#pragma unroll
            for (int bj = 0; bj < 2; ++bj) { const f32x4 v0 = acc[ai][bj][m][0], v1 = acc[ai][bj][m][1];
                u32x4 w; w.x = cvt_pk_bf16(v0[0], v0[1]); w.y = cvt_pk_bf16(v0[2], v0[3]); w.z = cvt_pk_bf16(v1[0], v1[1]); w.w = cvt_pk_bf16(v1[2], v1[3]);
                *(u32x4*)(rowp + bj * 128) = w; } }
}
struct EpiProj {
    static constexpr bool PERM = true;
    bf16_t* O; int ldc; int zt; float* Z; int k_lo, k_hi; const float* kn; const f32x2* rope;
    __device__ __forceinline__ void operator()(const f32x4 (&acc)[2][2][4][2], const Unit& u, int wr, int wc, int fr, int fq) const {
        if (u.pn == zt) {
            if (wc == 0) {
#pragma unroll
                for (int ai = 0; ai < 2; ++ai)
#pragma unroll
                    for (int m = 0; m < 4; ++m) { float* zp = Z + (size_t)(u.pm * 256 + ai * 128 + wr * 64 + m * 16 + fr) * 32 + 8 * fq;
                        *(f32x4*)zp = acc[ai][0][m][0]; *(f32x4*)(zp + 4) = acc[ai][0][m][1]; }
            }
            return;
        }
        bf16_t* tb = O + (size_t)u.pm * 256 * ldc + (size_t)u.pn * 256;
        store_tile_bf16(acc, tb, (size_t)ldc, wr, wc, fr, fq);
        if (u.pn >= k_lo && u.pn < k_hi) {
            asm volatile("s_waitcnt vmcnt(0)" ::: "memory"); __builtin_amdgcn_s_barrier(); asm volatile("" ::: "memory");
            int ln_ = fq * 16 + fr; asm volatile("" : "+v"(ln_));
            const int wid = wr * 4 + wc, li = ln_ & 15, sub = ln_ >> 4, quarter = li >> 2;
            const float* gp = kn + 8 * li; const f32x4 g0 = *(const f32x4*)gp, g1 = *(const f32x4*)(gp + 4);
#pragma unroll 1
            for (int s0 = 0; s0 < 16; s0 += 4) {
                u32x4 w[4]; bf16_t* pp[4]; int tt[4];
#pragma unroll
                for (int i = 0; i < 4; ++i) { const int item = wid * 64 + (s0 + i) * 4 + sub, row = item >> 1, hd = item & 1;
                    pp[i] = tb + (size_t)row * ldc + hd * 128 + 8 * li; w[i] = *(const u32x4*)pp[i]; tt[i] = (u.pm * 256 + row) % TPB; }
#pragma unroll
                for (int i = 0; i < 4; ++i) {
                    float x[8] = {bflo(w[i].x), bfhi(w[i].x), bflo(w[i].y), bfhi(w[i].y), bflo(w[i].z), bfhi(w[i].z), bflo(w[i].w), bfhi(w[i].w)};
                    float ss = 0.f;
#pragma unroll
                    for (int e = 0; e < 8; ++e) ss += x[e] * x[e];
                    ss += __shfl_xor(ss, 1); ss += __shfl_xor(ss, 2); ss += __shfl_xor(ss, 4); ss += __shfl_xor(ss, 8);
                    const float rstd = 1.0f / sqrtf(ss * (1.f / 128.f) + NORM_EPS);
                    x[0] *= rstd * g0.x; x[1] *= rstd * g0.y; x[2] *= rstd * g0.z; x[3] *= rstd * g0.w;
                    x[4] *= rstd * g1.x; x[5] *= rstd * g1.y; x[6] *= rstd * g1.z; x[7] *= rstd * g1.w;
                    if (tt[i] >= CTXL) {
                        const f32x2* rp = rope + (size_t)(tt[i] - CTXL) * 64 + (quarter >> 1) * 32 + (li & 3) * 8;
                        const float sgn = (quarter & 1) ? 1.f : -1.f;
#pragma unroll
                        for (int e = 0; e < 8; ++e) { const f32x2 cs = rp[e]; const float pv = __shfl_xor(x[e], 4); x[e] = x[e] * cs.x + sgn * pv * cs.y; }
                    }
                    u32x4 o; o.x = cvt_pk_bf16(x[0], x[1]); o.y = cvt_pk_bf16(x[2], x[3]); o.z = cvt_pk_bf16(x[4], x[5]); o.w = cvt_pk_bf16(x[6], x[7]);
                    *(u32x4*)pp[i] = o;
                }
            }
        }
    }
};
struct EpiF1 {
    static constexpr bool PERM = true;
    bf16_t* UVT;
    __device__ __forceinline__ void operator()(const f32x4 (&acc)[2][2][4][2], const Unit& u, int wr, int wc, int fr, int fq) const {
        bf16_t* base = UVT + ((size_t)(u.z >> 2) * 1024 + (u.z & 3) * 256) * 4096 + (size_t)u.pm * 2048 + (size_t)u.pn * 256;
        store_tile_bf16(acc, base, 4096, wr, wc, fr, fq);
    }
};
struct EpiF2P {
    static constexpr bool PERM = true;
    bf16_t* P;
    __device__ __forceinline__ void operator()(const f32x4 (&acc)[2][2][4][2], const Unit& u, int wr, int wc, int fr, int fq) const {
        store_tile_bf16(acc, P + ((size_t)u.z * 1024 + (size_t)u.pm * 256) * 1024 + (size_t)u.pn * 256, 1024, wr, wc, fr, fq);
    }
};
struct EpiF2Q {
    static constexpr bool PERM = true;
    const bf16_t* P; bf16_t* O;
    __device__ __forceinline__ void store_mirror(bf16_t* om, const u32x4& y, bool t0) const {
        if (!t0) *(u32x4*)om = y;
        else { om[1] = (bf16_t)(y.x >> 16); *(unsigned*)(om + 2) = y.y; *(unsigned*)(om + 4) = y.z; *(unsigned*)(om + 6) = y.w; }
    }
    __device__ __forceinline__ void operator()(const f32x4 (&acc)[2][2][4][2], const Unit& u, int wr, int wc, int fr, int fq) const {
        const bf16_t* pb = P + ((size_t)u.z * 1024 + (size_t)u.pm * 256) * 1024 + (size_t)u.pn * 256 + wc * 32 + 8 * fq;
        bf16_t* ob = O + ((size_t)u.z * TPB + CTXL) * DM + (size_t)u.pn * 512 + wc * 32 + 8 * fq;
#pragma unroll
        for (int ai = 0; ai < 2; ++ai)
#pragma unroll
            for (int m = 0; m < 4; ++m) { const int row = ai * 128 + wr * 64 + m * 16 + fr, lp = u.pm * 256 + row;
                u32x4 pw[2];
#pragma unroll
                for (int bj = 0; bj < 2; ++bj) pw[bj] = *(const u32x4*)(pb + (size_t)row * 1024 + bj * 128);
#pragma unroll
                for (int bj = 0; bj < 2; ++bj) { const f32x4 q0 = acc[ai][bj][m][0], q1 = acc[ai][bj][m][1];
                    const float p[8] = {bflo(pw[bj].x), bfhi(pw[bj].x), bflo(pw[bj].y), bfhi(pw[bj].y), bflo(pw[bj].z), bfhi(pw[bj].z), bflo(pw[bj].w), bfhi(pw[bj].w)};
                    const bool t0 = (bj == 0) && (wc == 0) && (fq == 0);
                    u32x4 yd, ym;
                    yd.x = cvt_pk_bf16(t0 ? p[0] : p[0] + q0[0], p[1] + q0[1]); yd.y = cvt_pk_bf16(p[2] + q0[2], p[3] + q0[3]);
                    yd.z = cvt_pk_bf16(p[4] + q1[0], p[5] + q1[1]); yd.w = cvt_pk_bf16(p[6] + q1[2], p[7] + q1[3]);
                    ym.x = cvt_pk_bf16(t0 ? p[0] : p[0] - q0[0], p[1] - q0[1]); ym.y = cvt_pk_bf16(p[2] - q0[2], p[3] - q0[3]);
                    ym.z = cvt_pk_bf16(p[4] - q1[0], p[5] - q1[1]); ym.w = cvt_pk_bf16(p[6] - q1[2], p[7] - q1[3]);
                    bf16_t* od = ob + (size_t)lp * DM + bj * 128;
                    *(u32x4*)od = yd; store_mirror(od + 256, ym, t0);
                    if (lp != 0) { bf16_t* o2 = ob + (size_t)(2048 - lp) * DM + bj * 128; *(u32x4*)o2 = ym; store_mirror(o2 + 256, yd, t0); }
                } }
    }
};
__device__ __forceinline__ f32x4 swiglu4(const f32x4 g, const f32x4 u) {
    const f32x4 t = g * -1.4426950408889634f;
    const f32x4 e = {__builtin_amdgcn_exp2f(t.x), __builtin_amdgcn_exp2f(t.y), __builtin_amdgcn_exp2f(t.z), __builtin_amdgcn_exp2f(t.w)};
    const f32x4 d = e + 1.0f;
    const f32x4 r = {__builtin_amdgcn_rcpf(d.x), __builtin_amdgcn_rcpf(d.y), __builtin_amdgcn_rcpf(d.z), __builtin_amdgcn_rcpf(d.w)};
    return (g * u) * r;
}
struct EpiSwiGLU {
    static constexpr bool PERM = true;
    bf16_t* H; int amap;
    __device__ __forceinline__ void operator()(const f32x4 (&acc)[2][2][4][2], const Unit& u, int wr, int wc, int fr, int fq) const {
        bf16_t* base = H + (size_t)row_tile(u.pm, amap) * 256 * FF + (size_t)u.pn * 128 + wc * 32 + 8 * fq;
#pragma unroll
        for (int ai = 0; ai < 2; ++ai)
#pragma unroll
            for (int m = 0; m < 4; ++m) { bf16_t* rowp = base + (size_t)(ai * 128 + wr * 64 + m * 16 + fr) * FF;
                const f32x4 g0 = acc[ai][0][m][0], g1 = acc[ai][0][m][1], u0 = acc[ai][1][m][0], u1 = acc[ai][1][m][1];
                const f32x4 s0 = swiglu4(g0, u0), s1 = swiglu4(g1, u1);
                u32x4 w; w.x = cvt_pk_bf16(s0.x, s0.y); w.y = cvt_pk_bf16(s0.z, s0.w); w.z = cvt_pk_bf16(s1.x, s1.y); w.w = cvt_pk_bf16(s1.z, s1.w);
                *(u32x4*)rowp = w; }
    }
};
__device__ __forceinline__ unsigned pk_f16(float a, float b) { const f16x2 p = {(_Float16)a, (_Float16)b}; return __builtin_bit_cast(unsigned, p); }
__device__ __forceinline__ float f16lo(unsigned u) { return (float)__builtin_bit_cast(f16x2, u).x; }
__device__ __forceinline__ float f16hi(unsigned u) { return (float)__builtin_bit_cast(f16x2, u).y; }
template <bool SRC16, bool DST16>
struct EpiResT {
    static constexpr bool PERM = false;
    const void* src_lat; const void* src_ctx; void* dst_lat; void* dst_ctx; const float* modv; int goff; int amap;
    __device__ __forceinline__ void operator()(const f32x4 (&acc)[2][2][4][2], const Unit& u, int wr, int wc, int fr, int fq) const {
        const int rt = row_tile(u.pm, amap & 1), b = rt / 9, j = rt - b * 9;
        const size_t eoff = (j == 0) ? (size_t)b * CTXL * DM : ((size_t)b * SEQ + (size_t)(j - 1) * 256) * DM;
        const char* sb = (const char*)(j == 0 ? src_ctx : src_lat) + eoff * (SRC16 ? 2 : 4);
        char* db = (char*)(j == 0 ? dst_ctx : dst_lat) + eoff * (DST16 ? 2 : 4);
        const float* gv = modv + (size_t)(j == 0 ? 16 : b) * 12288 + goff;
        const int lane = fq * 16 + fr;
        if constexpr (DST16) {
            const int scol = u.pn * 256 + wc * 32 + 4 * fq;
            f32x4 gt[2][2];
#pragma unroll
            for (int bj = 0; bj < 2; ++bj)
#pragma unroll
                for (int n = 0; n < 2; ++n) gt[bj][n] = *(const f32x4*)(gv + scol + bj * 128 + n * 16);
            const int prow = lane >> 2, pc = lane & 3; const bool nj = (pc & 2) != 0;
            const int addrA = ((((pc & 1) * 2) << 4) | prow) << 2, addrB = addrA + 64;
            const int dcol = u.pn * 256 + wc * 32 + 8 * pc;
            constexpr int MB = SRC16 ? 4 : 2;
#pragma unroll
            for (int ai = 0; ai < 2; ++ai)
#pragma unroll
              for (int m0 = 0; m0 < 4; m0 += MB) {
                u32x4 xb[MB][2]; f32x4 xfb[MB][2][2];
#pragma unroll
                for (int mm = 0; mm < MB; ++mm)
#pragma unroll
                    for (int bj = 0; bj < 2; ++bj) { const char* xp = sb + ((size_t)(ai * 128 + wr * 64 + (m0 + mm) * 16 + prow) * DM + dcol + bj * 128) * (SRC16 ? 2 : 4);
                        if constexpr (SRC16) xb[mm][bj] = *(const u32x4*)xp;
                        else { xfb[mm][bj][0] = *(const f32x4*)xp; xfb[mm][bj][1] = *(const f32x4*)(xp + 16); } }
#pragma unroll
                for (int mm = 0; mm < MB; ++mm) { const int m = m0 + mm; const size_t roff = (size_t)(ai * 128 + wr * 64 + m * 16 + prow) * DM + dcol;
                    u32x4 xh[2]; f32x4 xf[2][2];
#pragma unroll
                    for (int bj = 0; bj < 2; ++bj) {
                        if constexpr (SRC16) xh[bj] = xb[mm][bj];
                        else { xf[bj][0] = xfb[mm][bj][0]; xf[bj][1] = xfb[mm][bj][1]; } }
#pragma unroll
                    for (int bj = 0; bj < 2; ++bj) { unsigned P[2][2], o[4];
#pragma unroll
                        for (int n = 0; n < 2; ++n) { const f32x4 up = gt[bj][n] * acc[ai][bj][m][n]; P[n][0] = pk_f16(up.x, up.y); P[n][1] = pk_f16(up.z, up.w); }
#pragma unroll
                        for (int k = 0; k < 4; ++k) { const int ad = (k & 2) ? addrB : addrA;
                            const int v0 = __builtin_amdgcn_ds_bpermute(ad, (int)P[0][k & 1]), v1 = __builtin_amdgcn_ds_bpermute(ad, (int)P[1][k & 1]); o[k] = (unsigned)(nj ? v1 : v0); }
                        float x[8];
                        if constexpr (SRC16) { x[0] = f16lo(xh[bj].x); x[1] = f16hi(xh[bj].x); x[2] = f16lo(xh[bj].y); x[3] = f16hi(xh[bj].y); x[4] = f16lo(xh[bj].z); x[5] = f16hi(xh[bj].z); x[6] = f16lo(xh[bj].w); x[7] = f16hi(xh[bj].w); }
                        else { x[0] = xf[bj][0].x; x[1] = xf[bj][0].y; x[2] = xf[bj][0].z; x[3] = xf[bj][0].w; x[4] = xf[bj][1].x; x[5] = xf[bj][1].y; x[6] = xf[bj][1].z; x[7] = xf[bj][1].w; }
                        u32x4 w; w.x = pk_f16(x[0] + f16lo(o[0]), x[1] + f16hi(o[0])); w.y = pk_f16(x[2] + f16lo(o[1]), x[3] + f16hi(o[1]));
                        w.z = pk_f16(x[4] + f16lo(o[2]), x[5] + f16hi(o[2])); w.w = pk_f16(x[6] + f16lo(o[3]), x[7] + f16hi(o[3]));
                        *(u32x4*)(db + (roff + bj * 128) * 2) = w; }
                    asm volatile("" ::: "memory"); }
            }
        } else {
            const int prow = lane >> 3, pch = lane & 7, paddr = (((lane & 3) << 4) | (((lane >> 2) & 1) << 3) | prow) << 2;
            const bool lo = (fr & 8) == 0;
            const int col0 = u.pn * 256 + wc * 32 + 4 * pch;
            f32x4 gt[2];
#pragma unroll
            for (int bj = 0; bj < 2; ++bj) gt[bj] = *(const f32x4*)(gv + col0 + bj * 128);
#pragma unroll
            for (int ai = 0; ai < 2; ++ai)
#pragma unroll
                for (int m = 0; m < 4; ++m) { const size_t off = (size_t)(ai * 128 + wr * 64 + m * 16 + prow) * DM + col0;
                    f32x4 xs[2][2];
#pragma unroll
                    for (int bj = 0; bj < 2; ++bj)
#pragma unroll
                        for (int h = 0; h < 2; ++h) {
                            if constexpr (SRC16) { const u32x2 r = *(const u32x2*)(sb + (off + (size_t)h * 8 * DM + bj * 128) * 2); xs[bj][h] = (f32x4){f16lo(r.x), f16hi(r.x), f16lo(r.y), f16hi(r.y)}; }
                            else xs[bj][h] = *(const f32x4*)(sb + (off + (size_t)h * 8 * DM + bj * 128) * 4); }
#pragma unroll
                    for (int bj = 0; bj < 2; ++bj) { const f32x4 a0 = acc[ai][bj][m][0], a1 = acc[ai][bj][m][1]; f32x4 o0, o1;
#pragma unroll
                        for (int c = 0; c < 4; ++c) { const int send = __float_as_int(lo ? a1[c] : a0[c]);
                            const int recv = __builtin_amdgcn_mov_dpp(send, 0x128, 0xf, 0xf, false);
                            const int t0 = lo ? __float_as_int(a0[c]) : recv, t1 = lo ? recv : __float_as_int(a1[c]);
                            o0[c] = __int_as_float(__builtin_amdgcn_ds_bpermute(paddr, t0)); o1[c] = __int_as_float(__builtin_amdgcn_ds_bpermute(paddr, t1)); }
                        *(f32x4*)(db + (off + bj * 128) * 4) = xs[bj][0] + gt[bj] * o0; *(f32x4*)(db + (off + (size_t)8 * DM + bj * 128) * 4) = xs[bj][1] + gt[bj] * o1; }
                    asm volatile("" ::: "memory"); }
        }
    }
};

struct KArgs { const float* in[49]; float* out; unsigned char* ws; int ph_lo, ph_hi; };
__device__ __forceinline__ int idx_modw(int L) { return L == 0 ? 4 : L == 1 ? 17 : L == 2 ? 27 : 42; }
__device__ __forceinline__ int idx_norm2(int L) { return L == 0 ? 14 : L == 1 ? 24 : L == 2 ? 39 : 46; }

__device__ __forceinline__ void ph_prologue(const KArgs& a, LAS unsigned char* lds, int G, int bid) {
    const int tid = threadIdx.x, lane = tid & 63, wave = __builtin_amdgcn_readfirstlane(tid >> 6);
    LAS float* sl = (LAS float*)lds;
    LAS float* red = (LAS float*)(lds + 139264);
    float* modv = (float*)(a.ws + WS_MODV);
    {
        const float* c = a.in[1]; const float* cc = a.in[3];
        for (int i = tid; i < 17 * 2048; i += 512) { const float v = i < 16 * 2048 ? c[i] : cc[i - 16 * 2048]; sl[i] = v / (1.f + __expf(-v)); }
    }
    __syncthreads();
    for (int u = bid; u < 768; u += G) {
        const int L = u / 192, n0 = (u % 192) * 64;
        const float* W = a.in[idx_modw(L)]; const float* bias = a.in[idx_modw(L) + 1];
        float acc[17];
#pragma unroll
        for (int r = 0; r < 17; ++r) acc[r] = 0.f;
        const int k0 = wave * 256;
        const float* Wp = W + (size_t)k0 * 12288 + n0 + lane;
        float wv[16];
#pragma unroll
        for (int kk = 0; kk < 16; ++kk) wv[kk] = Wp[(size_t)kk * 12288];
        for (int k = 0; k < 256; k += 16) {
            float wn[16];
            const float* Wn = Wp + (size_t)(k + 16 < 256 ? k + 16 : k) * 12288;
#pragma unroll
            for (int kk = 0; kk < 16; ++kk) wn[kk] = Wn[(size_t)kk * 12288];
#pragma unroll
            for (int q = 0; q < 4; ++q)
#pragma unroll
                for (int r = 0; r < 17; ++r) { const f32x4 s4 = *(const LAS f32x4*)(sl + r * 2048 + k0 + k + 4 * q);
                    acc[r] += s4.x * wv[4 * q] + s4.y * wv[4 * q + 1] + s4.z * wv[4 * q + 2] + s4.w * wv[4 * q + 3]; }
#pragma unroll
            for (int kk = 0; kk < 16; ++kk) wv[kk] = wn[kk];
        }
        for (int w = 0; w < 8; ++w) {
            if (wave == w) {
#pragma unroll
                for (int r = 0; r < 17; ++r) red[r * 64 + lane] = (w == 0 ? 0.f : red[r * 64 + lane]) + acc[r];
            }
            __syncthreads();
        }
        for (int i = tid; i < 17 * 64; i += 512) { const int r = i >> 6, l = i & 63; modv[((size_t)L * 17 + r) * 12288 + n0 + l] = red[i] + bias[n0 + l]; }
        __syncthreads();
    }
    const size_t gt = (size_t)bid * 512 + tid, GT = (size_t)G * 512;
    {
        f32x2* rope = (f32x2*)(a.ws + WS_ROPE);
        for (size_t e = gt; e < 2048 * 64; e += GT) {
            const int p = (int)(e >> 6), i = (int)(e & 63), f = i & 31;
            const float inv = exp2f(-(float)(2 * f) * (13.287712379549449f / 64.f));
            const float ang = (float)(i < 32 ? (p >> 6) : (p & 63)) * inv;
            const float kf = rintf(ang * 0.15915494309189535f);
            float r = fmaf(-kf, 6.28318548202514648f, ang); r = fmaf(-kf, -1.7484556000744883e-7f, r);
            rope[e] = (f32x2){cosf(r), sinf(r)};
        }
    }
    {
        bf16_t* d1 = (bf16_t*)(a.ws + WS_DFT1);
        for (size_t e = gt; e < 512 * 512; e += GT) {
            const int m = (int)(e >> 9), k = (int)(e & 511), part = m >> 8, cp = m & 255;
            const int rr = (k * cp) & 511; const float rev = (float)rr * (1.f / 512.f);
            float v = part ? __builtin_amdgcn_sinf(rev) : __builtin_amdgcn_cosf(rev);
            if (m == 256) v = (k & 1) ? -1.f : 1.f;
            d1[e] = (bf16_t)f2bf(v * 0.044194173824159216f);
        }
        bf16_t* d2 = (bf16_t*)(a.ws + WS_DFT2);
        for (size_t e = gt; e < (size_t)2048 * 4096; e += GT) {
            const int lp = (int)(e >> 12), k = (int)(e & 4095), part = k >> 11, l = k & 2047;
            const int rr = (l * lp) & 2047; const float rev = (float)rr * (1.f / 2048.f);
            const float v = (part ? -__builtin_amdgcn_sinf(rev) : __builtin_amdgcn_cosf(rev)) * 0.022097086912079608f;
            d2[e] = (bf16_t)f2bf(v);
        }
    }
}

__device__ __forceinline__ void transpose_item(const float* W, int K, int N, bf16_t* WT, int mode, LAS unsigned* scr, int item, int lane) {
    const int nblk = (N + 63) / 64, kb = item / nblk, nb = item - kb * nblk, k0 = 64 * kb, n0 = 64 * nb;
    const int q = lane >> 4, c4 = (lane & 15) * 4;
    const bool ldok = n0 + c4 < N;
    f32x4 v[16];
#pragma unroll
    for (int i = 0; i < 16; ++i) { const int k = (i >> 1) * 8 + q * 2 + (i & 1); int ks = k0 + k;
        if (mode == 2) { const int pos = ks & 511; ks = (ks & ~511) + (pos <= 256 ? pos : 768 - pos); }
        v[i] = ldok ? *(const f32x4*)(W + (size_t)ks * N + n0 + c4) : (f32x4){0.f, 0.f, 0.f, 0.f}; }
#pragma unroll
    for (int j = 0; j < 8; ++j) { const int kd = j * 4 + q;
        scr[(c4 + 0) * 33 + kd] = cvt_pk_bf16(v[2 * j].x, v[2 * j + 1].x); scr[(c4 + 1) * 33 + kd] = cvt_pk_bf16(v[2 * j].y, v[2 * j + 1].y);
        scr[(c4 + 2) * 33 + kd] = cvt_pk_bf16(v[2 * j].z, v[2 * j + 1].z); scr[(c4 + 3) * 33 + kd] = cvt_pk_bf16(v[2 * j].w, v[2 * j + 1].w); }
    LDS_WAIT(); asm volatile("" ::: "memory");
    const int c = lane & 7;
#pragma unroll
    for (int j = 0; j < 8; ++j) { const int n = (lane >> 3) + 8 * j; const LAS unsigned* sp = scr + n * 33 + 4 * c;
        u32x4 o; o.x = sp[0]; o.y = sp[1]; o.z = sp[2]; o.w = sp[3];
        int drow = n0 + n;
        if (mode == 1) { const int part = drow >= FF ? 1 : 0, hid = drow - part * FF; drow = 256 * (hid >> 7) + 128 * part + (hid & 127); }
        if (n0 + n < N) *(u32x4*)(WT + (size_t)drow * K + k0 + 8 * c) = o; }
    LDS_WAIT(); asm volatile("" ::: "memory");
}
__device__ __forceinline__ void convert_layer(const KArgs& a, LAS unsigned char* lds, int gw, int NGW, const float* f_in, const float* f_out, const float* wi, int Nin, const float* wo, int wo_mode = 0, size_t sh1 = 0, size_t sh2 = 0) {
    const int tid = threadIdx.x, lane = tid & 63, wave = __builtin_amdgcn_readfirstlane(tid >> 6);
    LAS unsigned* scr = (LAS unsigned*)(lds + wave * 16384);
    const int I1 = f_in ? (DM / 64) * (2 * FF / 64) : 0, I2 = f_out ? (FF / 64) * (DM / 64) : 0, I3 = wi ? (DM / 64) * ((Nin + 63) / 64) : 0, I4 = wo ? (DM / 64) * (DM / 64) : 0;
    const int NI = I1 + I2 + I3 + I4;
    for (int it = gw; it < NI; it += NGW) {
        int r = it;
        if (r < I1) { transpose_item(f_in, DM, 2 * FF, (bf16_t*)(a.ws + W_FFN1 + sh1), 1, scr, r, lane); continue; } r -= I1;
        if (r < I2) { transpose_item(f_out, FF, DM, (bf16_t*)(a.ws + W_FFN2 + sh2), 0, scr, r, lane); continue; } r -= I2;
        if (r < I3) { transpose_item(wi, DM, Nin, (bf16_t*)(a.ws + W_IN), 0, scr, r, lane); continue; } r -= I3;
        transpose_item(wo, DM, DM, (bf16_t*)(a.ws + W_OUT), wo_mode, scr, r, lane);
    }
}

template <bool SRC16>
__device__ __forceinline__ void norm_phase(const void* lat, const void* ctx, const float* gain, const float* modvL, int shoff, int scoff, bf16_t* HN, int lat_only, int G, int bid,
                                           void* copy_lat = nullptr, void* copy_ctx = nullptr) {
    const int tid = threadIdx.x, lane = tid & 63, wave = __builtin_amdgcn_readfirstlane(tid >> 6);
    const int nunits = lat_only ? NLAT / 16 : NT / 16;
    for (int u = bid; u < nunits; u += G) {
        int r0;
        if (lat_only) { const int lr = u * 16, b = lr / SEQ; r0 = b * TPB + CTXL + (lr - b * SEQ); } else r0 = u * 16;
        const int ra = r0 + wave * 2;
        const int b = ra / TPB, t = ra - b * TPB;
        const size_t eoff = t < CTXL ? ((size_t)b * CTXL + t) * DM : ((size_t)b * SEQ + (t - CTXL)) * DM;
        const char* xa = (const char*)(t < CTXL ? ctx : lat) + eoff * (SRC16 ? 2 : 4);
        const float* mv = modvL + (size_t)(t < CTXL ? 16 : b) * 12288;
        f32x4 v[2][8]; float ss[2] = {0.f, 0.f};
        if constexpr (SRC16) {
            u32x4 raw[2][4];
#pragma unroll
            for (int rr = 0; rr < 2; ++rr)
#pragma unroll
                for (int j = 0; j < 4; ++j) raw[rr][j] = *(const u32x4*)(xa + ((size_t)rr * DM + 8 * lane + 512 * j) * 2);
#pragma unroll
            for (int rr = 0; rr < 2; ++rr)
#pragma unroll
                for (int j = 0; j < 4; ++j) { const u32x4 w = raw[rr][j];
                    v[rr][2 * j] = (f32x4){f16lo(w.x), f16hi(w.x), f16lo(w.y), f16hi(w.y)}; v[rr][2 * j + 1] = (f32x4){f16lo(w.z), f16hi(w.z), f16lo(w.w), f16hi(w.w)}; }
        } else {
#pragma unroll
            for (int rr = 0; rr < 2; ++rr)
#pragma unroll
                for (int j = 0; j < 8; ++j) v[rr][j] = *(const f32x4*)(xa + ((size_t)rr * DM + 4 * lane + 256 * j) * 4);
            if (copy_lat) { char* xc = (char*)(t < CTXL ? copy_ctx : copy_lat) + eoff * 2;
#pragma unroll
                for (int rr = 0; rr < 2; ++rr)
#pragma unroll
                    for (int j = 0; j < 8; ++j) { u32x2 w; w.x = pk_f16(v[rr][j].x, v[rr][j].y); w.y = pk_f16(v[rr][j].z, v[rr][j].w); *(u32x2*)(xc + ((size_t)rr * DM + 4 * lane + 256 * j) * 2) = w; } }
        }
#pragma unroll
        for (int rr = 0; rr < 2; ++rr)
#pragma unroll
            for (int j = 0; j < 8; ++j) ss[rr] += (v[rr][j].x * v[rr][j].x + v[rr][j].y * v[rr][j].y) + (v[rr][j].z * v[rr][j].z + v[rr][j].w * v[rr][j].w);
        const float rstd0 = 1.0f / sqrtf(wave_sum(ss[0]) * (1.f / DM) + NORM_EPS), rstd1 = 1.0f / sqrtf(wave_sum(ss[1]) * (1.f / DM) + NORM_EPS);
        bf16_t* orow = HN + (size_t)ra * DM;
#pragma unroll
        for (int j = 0; j < 8; ++j) {
            const int c = SRC16 ? (8 * lane + 512 * (j >> 1) + 4 * (j & 1)) : (4 * lane + 256 * j);
            const f32x4 g = *(const f32x4*)(gain + c), sc = *(const f32x4*)(mv + scoff + c), sh = *(const f32x4*)(mv + shoff + c);
            const f32x4 gs = g * (1.f + sc);
            const f32x4 o0 = v[0][j] * rstd0 * gs + sh, o1 = v[1][j] * rstd1 * gs + sh;
            u32x2 w0, w1; w0.x = cvt_pk_bf16(o0.x, o0.y); w0.y = cvt_pk_bf16(o0.z, o0.w); w1.x = cvt_pk_bf16(o1.x, o1.y); w1.y = cvt_pk_bf16(o1.z, o1.w);
            *(u32x2*)(orow + c) = w0; *(u32x2*)(orow + DM + c) = w1;
        }
    }
}

__device__ __forceinline__ void qknorm_rope_phase(bf16_t* P, int ld, int nh, const float* qn, const float* kn, const f32x2* rope, int G, int bid) {
    const int tid = threadIdx.x, lane = tid & 63, wave = __builtin_amdgcn_readfirstlane(tid >> 6);
    const int nq = (nh - 16) >> 2, sub = lane >> 4, li = lane & 15, quarter = li >> 2;
    const long total = (long)NT * nq, stride = (long)G * 8;
    constexpr int NI = 4;
    for (long id0 = (long)bid * 8 + wave; id0 < total; id0 += stride * NI) {
        u32x4 w[NI]; bf16_t* pp[NI]; int tt[NI], hh[NI]; bool ok[NI];
#pragma unroll
        for (int i = 0; i < NI; ++i) {
            const long id = id0 + stride * i; ok[i] = id < total; const long idc = ok[i] ? id : id0;
            const int r = (int)(idc / nq), quad = (int)(idc - (long)r * nq); hh[i] = 16 + quad * 4 + sub; tt[i] = r % TPB;
            pp[i] = P + (size_t)r * ld + hh[i] * 128 + 8 * li; w[i] = *(const u32x4*)pp[i];
        }
#pragma unroll
        for (int i = 0; i < NI; ++i) {
            float x[8] = {bflo(w[i].x), bfhi(w[i].x), bflo(w[i].y), bfhi(w[i].y), bflo(w[i].z), bfhi(w[i].z), bflo(w[i].w), bfhi(w[i].w)};
            float ss = 0.f;
#pragma unroll
            for (int e = 0; e < 8; ++e) ss += x[e] * x[e];
            ss += __shfl_xor(ss, 1); ss += __shfl_xor(ss, 2); ss += __shfl_xor(ss, 4); ss += __shfl_xor(ss, 8);
            const float rstd = 1.0f / sqrtf(ss * (1.f / 128.f) + NORM_EPS);
            const float* gp = (hh[i] < 16 ? qn : kn) + 8 * li;
            const f32x4 g0 = *(const f32x4*)gp, g1 = *(const f32x4*)(gp + 4);
            x[0] *= rstd * g0.x; x[1] *= rstd * g0.y; x[2] *= rstd * g0.z; x[3] *= rstd * g0.w;
            x[4] *= rstd * g1.x; x[5] *= rstd * g1.y; x[6] *= rstd * g1.z; x[7] *= rstd * g1.w;
            if (tt[i] >= CTXL) {
                const f32x2* rp = rope + (size_t)(tt[i] - CTXL) * 64 + (quarter >> 1) * 32 + (li & 3) * 8;
                const float sgn = (quarter & 1) ? 1.f : -1.f;
#pragma unroll
                for (int e = 0; e < 8; ++e) { const f32x2 cs = rp[e]; const float pv = __shfl_xor(x[e], 4); x[e] = x[e] * cs.x + sgn * pv * cs.y; }
            }
            u32x4 o; o.x = cvt_pk_bf16(x[0], x[1]); o.y = cvt_pk_bf16(x[2], x[3]); o.z = cvt_pk_bf16(x[4], x[5]); o.w = cvt_pk_bf16(x[6], x[7]);
            if (ok[i]) *(u32x4*)pp[i] = o;
        }
    }
}

namespace att {
constexpr int D = 128, NW = 8, QBLK = 32, KVBLK = 64;
constexpr float SCALE = 0.088388347648318440f;
constexpr float THR = 8.f;
constexpr size_t SHM_V = KVBLK * D * 2, SHM_K = KVBLK * D * 2, SHM_ATTN = 2 * SHM_V + 2 * SHM_K + NW * 64 * 4;
#define KSWZ(row, colB) ((row) * 256 + ((colB) ^ (((row) & 7) << 4)))
#define SBAR() __builtin_amdgcn_sched_barrier(0)
__device__ __forceinline__ int crow(int r, int hi) { return (r & 3) + 8 * (r >> 2) + 4 * hi; }
template <bool SUB> __device__ __forceinline__ void partialSM(f32x16& p0, f32x16& p1, float rsub) {
  if constexpr (SUB) { for (int r = 0; r < 16; ++r) p0[r] -= rsub; for (int r = 0; r < 16; ++r) p1[r] -= rsub; }
  for (int r = 0; r < 16; ++r) p0[r] = __builtin_amdgcn_exp2f(p0[r]);
}
__device__ __forceinline__ void finishSM(f32x16& p0, f32x16& p1, float& l_reg, bf16x8& pa0, bf16x8& pa1, bf16x8& pa2, bf16x8& pa3) {
  for (int r = 0; r < 16; ++r) p1[r] = __builtin_amdgcn_exp2f(p1[r]);
  float ps = 0; for (int r = 0; r < 16; ++r) ps += p0[r]; for (int r = 0; r < 16; ++r) ps += p1[r];
  { auto rr = __builtin_amdgcn_permlane32_swap(__float_as_uint(ps), __float_as_uint(ps), false, false);
    ps = __uint_as_float(rr[0]) + __uint_as_float(rr[1]); }
  l_reg += ps;
#define PK4(P, BASE, OUT) do { unsigned a0 = cvt_pk_bf16(P[BASE + 0], P[BASE + 1]), a1 = cvt_pk_bf16(P[BASE + 2], P[BASE + 3]);   \
    unsigned b0 = cvt_pk_bf16(P[BASE + 4], P[BASE + 5]), b1 = cvt_pk_bf16(P[BASE + 6], P[BASE + 7]);                              \
    auto r0 = __builtin_amdgcn_permlane32_swap(a0, b0, false, false); auto r1 = __builtin_amdgcn_permlane32_swap(a1, b1, false, false); \
    u32x4 w = {r0[0], r1[0], r0[1], r1[1]}; OUT = *reinterpret_cast<bf16x8*>(&w); } while (0)
  PK4(p0, 0, pa0); PK4(p0, 8, pa1); PK4(p1, 0, pa2); PK4(p1, 8, pa3);
#undef PK4
}
__device__ __forceinline__ void qkt(f32x16& p0, f32x16& p1, const bf16_t* Ks, const bf16x8* qr, int r32, int hi) {
  p0 = f32x16{}; p1 = f32x16{};
  for (int d0 = 0; d0 < 8; ++d0) { int cb = (d0 * 16 + hi * 8) * 2;
    bf16x8 b0 = *reinterpret_cast<const bf16x8*>((const char*)Ks + KSWZ(r32, cb));
    bf16x8 b1 = *reinterpret_cast<const bf16x8*>((const char*)Ks + KSWZ(32 + r32, cb));
    p0 = __builtin_amdgcn_mfma_f32_32x32x16_bf16(b0, qr[d0], p0, 0, 0, 0);
    p1 = __builtin_amdgcn_mfma_f32_32x32x16_bf16(b1, qr[d0], p1, 0, 0, 0); }
}
__device__ __forceinline__ int v_st(int k, int c) { const int kk = (k & ~0xC) | ((k & 4) << 1) | ((k & 8) >> 1); return ((kk >> 3) * 4 + (c >> 5)) * 512 + ((kk & 7) * 32 + (c & 31)) * 2; }
__device__ __forceinline__ int v_rd_base(int lane) { return ((lane & 3) << 3) | (((lane >> 2) & 3) << 6) | (((lane >> 4) & 1) << 5) | (((lane >> 5) & 1) << 8); }
constexpr int v_rd_off(int d0, int ks, int half) { return d0 * 512 + ks * 4096 + half * 2048; }
template <int OFF> __device__ __forceinline__ s16x4 tr_read(int vb) {
  s16x4 r; asm volatile("ds_read_b64_tr_b16 %0, %1 offset:%2" : "=&v"(r) : "v"(vb), "i"(OFF) : "memory"); return r;
}
template <int D0> __device__ __forceinline__ void pv_one(f32x16& od, int vb, bf16x8 pa0, bf16x8 pa1, bf16x8 pa2, bf16x8 pa3) {
  const s16x4 l0 = tr_read<v_rd_off(D0, 0, 0)>(vb), h0 = tr_read<v_rd_off(D0, 0, 1)>(vb), l1 = tr_read<v_rd_off(D0, 1, 0)>(vb), h1 = tr_read<v_rd_off(D0, 1, 1)>(vb);
  const s16x4 l2 = tr_read<v_rd_off(D0, 2, 0)>(vb), h2 = tr_read<v_rd_off(D0, 2, 1)>(vb), l3 = tr_read<v_rd_off(D0, 3, 0)>(vb), h3 = tr_read<v_rd_off(D0, 3, 1)>(vb);
  asm volatile("s_waitcnt lgkmcnt(0)" ::: "memory"); SBAR();
#define PK(L, H) (bf16x8){L[0], L[1], L[2], L[3], H[0], H[1], H[2], H[3]}
  od = __builtin_amdgcn_mfma_f32_32x32x16_bf16(pa0, PK(l0, h0), od, 0, 0, 0);
  od = __builtin_amdgcn_mfma_f32_32x32x16_bf16(pa1, PK(l1, h1), od, 0, 0, 0);
  od = __builtin_amdgcn_mfma_f32_32x32x16_bf16(pa2, PK(l2, h2), od, 0, 0, 0);
  od = __builtin_amdgcn_mfma_f32_32x32x16_bf16(pa3, PK(l3, h3), od, 0, 0, 0);
#undef PK
}
__device__ __forceinline__ void pv_d0(f32x16* o, int vb, bf16x8 pa0, bf16x8 pa1, bf16x8 pa2, bf16x8 pa3) {
  pv_one<0>(o[0], vb, pa0, pa1, pa2, pa3); pv_one<1>(o[1], vb, pa0, pa1, pa2, pa3); pv_one<2>(o[2], vb, pa0, pa1, pa2, pa3); pv_one<3>(o[3], vb, pa0, pa1, pa2, pa3);
}
__device__ __forceinline__ void q_norm_rope(bf16x8 (&qr)[8], const float* __restrict__ qn, const f32x2* __restrict__ rope, int pos, int hi_) {
  int hi = hi_; asm volatile("" : "+v"(hi));
  float x[8][8]; float ss = 0.f;
#pragma unroll
  for (int d0 = 0; d0 < 8; ++d0) { const u32x4 w = __builtin_bit_cast(u32x4, qr[d0]);
    x[d0][0] = bflo(w.x); x[d0][1] = bfhi(w.x); x[d0][2] = bflo(w.y); x[d0][3] = bfhi(w.y); x[d0][4] = bflo(w.z); x[d0][5] = bfhi(w.z); x[d0][6] = bflo(w.w); x[d0][7] = bfhi(w.w);
#pragma unroll
    for (int j = 0; j < 8; ++j) ss += x[d0][j] * x[d0][j]; }
  ss += __shfl_xor(ss, 32);
  const float rstd = (SCALE * 1.4426950408889634f) / sqrtf(ss * (1.f / 128.f) + NORM_EPS);
#pragma unroll
  for (int d0 = 0; d0 < 8; ++d0) { const float* gp = qn + d0 * 16 + hi * 8; const f32x4 g0 = *(const f32x4*)gp, g1 = *(const f32x4*)(gp + 4);
    x[d0][0] *= rstd * g0.x; x[d0][1] *= rstd * g0.y; x[d0][2] *= rstd * g0.z; x[d0][3] *= rstd * g0.w;
    x[d0][4] *= rstd * g1.x; x[d0][5] *= rstd * g1.y; x[d0][6] *= rstd * g1.z; x[d0][7] *= rstd * g1.w; }
  if (pos >= 0) {
#pragma unroll
    for (int hf = 0; hf < 2; ++hf)
#pragma unroll
      for (int e = 0; e < 2; ++e) { const int da = hf * 4 + e, db = da + 2; const f32x2* rp = rope + (size_t)pos * 64 + hf * 32 + e * 16 + hi * 8;
#pragma unroll
        for (int j = 0; j < 8; ++j) { const f32x2 cs = rp[j]; const float a = x[da][j], b = x[db][j]; x[da][j] = a * cs.x - b * cs.y; x[db][j] = b * cs.x + a * cs.y; } }
  }
#pragma unroll
  for (int d0 = 0; d0 < 8; ++d0) { u32x4 w; w.x = cvt_pk_bf16(x[d0][0], x[d0][1]); w.y = cvt_pk_bf16(x[d0][2], x[d0][3]); w.z = cvt_pk_bf16(x[d0][4], x[d0][5]); w.w = cvt_pk_bf16(x[d0][6], x[d0][7]);
    qr[d0] = __builtin_bit_cast(bf16x8, w); }
}
constexpr int OT_PITCH = 272, OT_BYTES = 32 * OT_PITCH;
template <int LDO>
__device__ __forceinline__ void store_o_tile(const f32x16 (&o)[4], const float (&rli)[16], char* tb, bf16_t* Ow, int lane) {
  const int r32 = lane & 31, hi = lane >> 5, odd = lane & 1;
#pragma unroll
  for (int d0 = 0; d0 < 4; ++d0)
#pragma unroll
    for (int q = 0; q < 8; ++q) {
      const unsigned ba = f2bf(o[d0][2 * q] * rli[2 * q]), bb = f2bf(o[d0][2 * q + 1] * rli[2 * q + 1]);
      const unsigned recv = (unsigned)__shfl_xor((int)(odd ? ba : bb), 1);
      const unsigned word = odd ? (recv | (bb << 16)) : (ba | (recv << 16));
      const int row = crow(2 * q + odd, hi);
      *(unsigned*)(tb + row * OT_PITCH + ((d0 * 32 + r32) >> 1) * 4) = word;
    }
  if (Ow == nullptr) return;
#pragma unroll
  for (int it = 0; it < 8; ++it) { const int idx = it * 64 + lane, row = idx >> 4, ch = idx & 15;
    *(u32x4*)(Ow + (long)row * LDO + ch * 8) = *(const u32x4*)(tb + row * OT_PITCH + ch * 16); }
}
template <int LDQ, int LDK, int LDO, bool SUB>
__device__ __forceinline__ void attn_dense_body(const bf16_t* __restrict__ Qb, const bf16_t* __restrict__ Kh, const bf16_t* __restrict__ Vh,
                                                bf16_t* __restrict__ Ob, int seq, float mfix, const float* __restrict__ qn, const f32x2* __restrict__ rope, int pos0, char* lds) {
  const int tid = opaque_tid(), wid = tid >> 6, lane = tid & 63, r32 = lane & 31, hi = lane >> 5;
  bf16_t* V_lds = (bf16_t*)lds; bf16_t* K_lds = (bf16_t*)(lds + 2 * SHM_V);
  float* ws = (float*)(lds + 2 * SHM_V + 2 * SHM_K) + wid * 64; float* li_l = ws;
  const float mnC = mfix * (SCALE * 1.4426950408889634f) - 80.f; float l_reg = 0; f32x16 o[4] = {}; bf16x8 qr[8];
  const bf16_t* Qw = Qb + (long)(wid * QBLK + r32) * LDQ + hi * 8;
#pragma unroll
  for (int d0 = 0; d0 < 8; ++d0) qr[d0] = *reinterpret_cast<const bf16x8*>(Qw + d0 * 16);
  q_norm_rope(qr, qn, rope, pos0 < 0 ? -1 : pos0 + wid * QBLK + r32, hi);
  SBAR();
  const int sr = tid >> 4, sc = (tid & 15) * 8, vst0 = v_st(sr, sc), vst1 = v_st(32 + sr, sc);
  const int vb0 = (int)(uintptr_t)V_lds + v_rd_base(lane);
  struct { bf16x8 vs0, vs1, ks0, ks1; } sr_[1];
  const unsigned goff0 = (unsigned)(sr * LDK + sc) * 2u, goff1 = (unsigned)((32 + sr) * LDK + sc) * 2u;
  const __amdgpu_buffer_rsrc_t rsK = __builtin_amdgcn_make_buffer_rsrc((void*)Kh, (short)0, seq * (LDK * 2), 0x00020000);
  const __amdgpu_buffer_rsrc_t rsV = __builtin_amdgcn_make_buffer_rsrc((void*)Vh, (short)0, seq * (LDK * 2), 0x00020000);
#define SLOAD(i, k0) do { const unsigned so_ = (unsigned)(k0) * (unsigned)(LDK * 2); \
    sr_[i].vs0 = __builtin_bit_cast(bf16x8, __builtin_amdgcn_raw_buffer_load_b128(rsV, goff0, so_, 0)); sr_[i].vs1 = __builtin_bit_cast(bf16x8, __builtin_amdgcn_raw_buffer_load_b128(rsV, goff1, so_, 0)); \
    sr_[i].ks0 = __builtin_bit_cast(bf16x8, __builtin_amdgcn_raw_buffer_load_b128(rsK, goff0, so_, 0)); sr_[i].ks1 = __builtin_bit_cast(bf16x8, __builtin_amdgcn_raw_buffer_load_b128(rsK, goff1, so_, 0)); } while (0)
#define SWRITE(b, i) do { *(bf16x8*)((char*)V_lds + (b) * SHM_V + vst0) = sr_[i].vs0;          \
    *(bf16x8*)((char*)V_lds + (b) * SHM_V + vst1) = sr_[i].vs1; int kc = sc * 2;               \
    *(bf16x8*)((char*)K_lds + (b) * SHM_K + KSWZ(sr, kc)) = sr_[i].ks0;                       \
    *(bf16x8*)((char*)K_lds + (b) * SHM_K + KSWZ(32 + sr, kc)) = sr_[i].ks1; } while (0)
#define SWAIT() asm volatile("s_waitcnt vmcnt(0)" ::: "memory")
  f32x16 pA0, pA1, pB0, pB1; bf16x8 pa0, pa1, pa2, pa3; const int NTL = seq / KVBLK;
  constexpr int SE = 0, SO = 0;
  SLOAD(SE, 0); asm volatile("s_waitcnt vmcnt(0)" ::: "memory"); SWRITE(0, SE); __syncthreads();
  qkt(pA0, pA1, K_lds, qr, r32, hi); partialSM<SUB>(pA0, pA1, mnC);
  SLOAD(SO, KVBLK);
  SWAIT(); SWRITE(1, SO); __syncthreads();
  for (int j = 1; j + 1 < NTL; j += 2) {
    SBAR(); qkt(pB0, pB1, (bf16_t*)((char*)K_lds + SHM_K), qr, r32, hi);
    finishSM(pA0, pA1, l_reg, pa0, pa1, pa2, pa3); SBAR();
    SLOAD(SO, (j + 1) * KVBLK); SBAR();
    pv_d0(o, vb0, pa0, pa1, pa2, pa3); partialSM<SUB>(pB0, pB1, mnC);
    __syncthreads(); SWAIT(); SWRITE(0, SE);
    __syncthreads();
    SBAR(); qkt(pA0, pA1, K_lds, qr, r32, hi);
    finishSM(pB0, pB1, l_reg, pa0, pa1, pa2, pa3); SBAR();
    SLOAD(SE, (j + 2) * KVBLK); SBAR();
    pv_d0(o, vb0 + (int)SHM_V, pa0, pa1, pa2, pa3); partialSM<SUB>(pA0, pA1, mnC);
    __syncthreads(); SWAIT(); SWRITE(1, SO);
    __syncthreads();
  }
  SBAR(); qkt(pB0, pB1, (bf16_t*)((char*)K_lds + SHM_K), qr, r32, hi);
  finishSM(pA0, pA1, l_reg, pa0, pa1, pa2, pa3); SBAR();
  pv_d0(o, vb0, pa0, pa1, pa2, pa3); partialSM<SUB>(pB0, pB1, mnC);
  __syncthreads();
  finishSM(pB0, pB1, l_reg, pa0, pa1, pa2, pa3); SBAR();
  pv_d0(o, vb0 + (int)SHM_V, pa0, pa1, pa2, pa3);
  if (hi == 0) li_l[r32] = l_reg; asm volatile("s_waitcnt lgkmcnt(0)" ::: "memory");
  float rli[16];
#pragma unroll
  for (int r = 0; r < 16; ++r) rli[r] = __builtin_amdgcn_rcpf(li_l[crow(r, hi)]);
  store_o_tile<LDO>(o, rli, lds + SHM_ATTN + wid * OT_BYTES, Ob + (long)(wid * QBLK) * LDO, lane);
  __syncthreads();
#undef SLOAD
#undef SWRITE
#undef SWAIT
}

constexpr int DF_K = 0, DF_V = 32768, DF_PX = 98304, DF_LI = 131072, DF_LDS = 131072 + 1024;
template <int LDK, int LDO, bool SUB>
__device__ __forceinline__ void attn_diff_body(const bf16_t* __restrict__ Qb, const bf16_t* __restrict__ Kh, const bf16_t* __restrict__ Vh,
                                               bf16_t* Ob, int seq, float mfix, const float* __restrict__ qn, const f32x2* __restrict__ rope, int pos0, char* lds,
                                               bool comb, bf16_t* Ofin, float lam, float oscale, const float* __restrict__ gain) {
  const int tid = opaque_tid(), wid = tid >> 6, lane = tid & 63, r32 = lane & 31, hi = lane >> 5, rg = wid & 3, half = wid >> 2;
  char* K_lds = lds + DF_K; char* V_lds = lds + DF_V; char* PXm = lds + DF_PX + wid * 4096; char* PXo = lds + DF_PX + (wid ^ 4) * 4096;
  float* li = (float*)(lds + DF_LI);
  const float mnC = mfix * (SCALE * 1.4426950408889634f) - 80.f; float l_reg = 0; f32x16 o[4] = {}; bf16x8 qr[8];
  const bf16_t* Qw = Qb + (long)(rg * QBLK + r32) * LDK + hi * 8;
#pragma unroll
  for (int d0 = 0; d0 < 8; ++d0) qr[d0] = *reinterpret_cast<const bf16x8*>(Qw + d0 * 16);
  q_norm_rope(qr, qn, rope, pos0 + rg * QBLK + r32, hi);
  const int sr = tid >> 4, sc = (tid & 15) * 8, vst0 = v_st(sr, sc), vst1 = v_st(32 + sr, sc), kc = sc * 2;
  const unsigned goff0 = (unsigned)(sr * LDK + sc) * 2u, goff1 = (unsigned)((32 + sr) * LDK + sc) * 2u;
  const __amdgpu_buffer_rsrc_t rsK = __builtin_amdgcn_make_buffer_rsrc((void*)Kh, (short)0, seq * (LDK * 2), 0x00020000);
  const __amdgpu_buffer_rsrc_t rsV = __builtin_amdgcn_make_buffer_rsrc((void*)Vh, (short)0, seq * (LDK * 2), 0x00020000);
  bf16x8 kr[2][2], vr[2][4];
#define DF_LDK(t0) do { _Pragma("unroll") for (int tt = 0; tt < 2; ++tt) { const unsigned so_ = (unsigned)(((t0) + tt) * KVBLK) * (unsigned)(LDK * 2); \
    kr[tt][0] = __builtin_bit_cast(bf16x8, __builtin_amdgcn_raw_buffer_load_b128(rsK, goff0, so_, 0)); kr[tt][1] = __builtin_bit_cast(bf16x8, __builtin_amdgcn_raw_buffer_load_b128(rsK, goff1, so_, 0)); } } while (0)
#define DF_LDV(t0) do { _Pragma("unroll") for (int tt = 0; tt < 2; ++tt) { const unsigned so_ = (unsigned)(((t0) + tt) * KVBLK) * (unsigned)(LDK * 2); \
    vr[tt][0] = __builtin_bit_cast(bf16x8, __builtin_amdgcn_raw_buffer_load_b128(rsV, goff0, so_, 0)); vr[tt][1] = __builtin_bit_cast(bf16x8, __builtin_amdgcn_raw_buffer_load_b128(rsV, goff1, so_, 0)); \
    vr[tt][2] = __builtin_bit_cast(bf16x8, __builtin_amdgcn_raw_buffer_load_b128(rsV, goff0 + 256u, so_, 0)); vr[tt][3] = __builtin_bit_cast(bf16x8, __builtin_amdgcn_raw_buffer_load_b128(rsV, goff1 + 256u, so_, 0)); } } while (0)
#define DF_WRK() do { _Pragma("unroll") for (int tt = 0; tt < 2; ++tt) { *(bf16x8*)(K_lds + tt * 16384 + KSWZ(sr, kc)) = kr[tt][0]; *(bf16x8*)(K_lds + tt * 16384 + KSWZ(32 + sr, kc)) = kr[tt][1]; } } while (0)
#define DF_WRV() do { _Pragma("unroll") for (int tt = 0; tt < 2; ++tt) { *(bf16x8*)(V_lds + tt * 32768 + vst0) = vr[tt][0]; *(bf16x8*)(V_lds + tt * 32768 + vst1) = vr[tt][1]; \
    *(bf16x8*)(V_lds + tt * 32768 + 16384 + vst0) = vr[tt][2]; *(bf16x8*)(V_lds + tt * 32768 + 16384 + vst1) = vr[tt][3]; } } while (0)
  const int NP = seq / (2 * KVBLK);
  const int vb = (int)(uintptr_t)V_lds + half * 16384 + v_rd_base(lane);
  DF_LDK(0); DF_LDV(0); DF_WRK(); DF_WRV(); __syncthreads();
  for (int p = 0; p < NP; ++p) {
    const bool more = p + 1 < NP;
    if (more) DF_LDK(2 * p + 2);
    SBAR();
    f32x16 p0, p1; bf16x8 pa0, pa1, pa2, pa3;
    qkt(p0, p1, (const bf16_t*)(K_lds + half * 16384), qr, r32, hi);
    partialSM<SUB>(p0, p1, mnC);
    finishSM(p0, p1, l_reg, pa0, pa1, pa2, pa3);
    *(bf16x8*)(PXm + lane * 16) = pa0; *(bf16x8*)(PXm + 1024 + lane * 16) = pa1; *(bf16x8*)(PXm + 2048 + lane * 16) = pa2; *(bf16x8*)(PXm + 3072 + lane * 16) = pa3;
    __syncthreads();
    if (more) { DF_WRK(); DF_LDV(2 * p + 2); }
    const bf16x8 po0 = *(const bf16x8*)(PXo + lane * 16), po1 = *(const bf16x8*)(PXo + 1024 + lane * 16), po2 = *(const bf16x8*)(PXo + 2048 + lane * 16), po3 = *(const bf16x8*)(PXo + 3072 + lane * 16);
    asm volatile("s_waitcnt lgkmcnt(0)" ::: "memory"); SBAR();
    if (half == 0) { pv_d0(o, vb, pa0, pa1, pa2, pa3); pv_d0(o, vb + 32768, po0, po1, po2, po3); }
    else           { pv_d0(o, vb, po0, po1, po2, po3); pv_d0(o, vb + 32768, pa0, pa1, pa2, pa3); }
    __syncthreads();
    if (more) DF_WRV();
  }
  if (hi == 0) li[wid * 32 + r32] = l_reg;
  __syncthreads();
  float rli[16];
#pragma unroll
  for (int r = 0; r < 16; ++r) rli[r] = __builtin_amdgcn_rcpf(li[wid * 32 + crow(r, hi)] + li[(wid ^ 4) * 32 + crow(r, hi)]);
  char* tb = V_lds + wid * OT_BYTES;
  bf16_t* Ow = Ob + (long)(rg * QBLK) * LDO + half * 128;
  if (!comb) store_o_tile<LDO>(o, rli, tb, Ow, lane);
  else {
    store_o_tile<LDO>(o, rli, tb, nullptr, lane);
    float* ss2 = (float*)(lds + DF_LI + 1024);
    const int ch = lane & 15, rq = lane >> 4;
    const bf16_t* O0w = Ow - 256;
    u32x4 o0[8]; float ssv[8];
#pragma unroll
    for (int it = 0; it < 8; ++it) o0[it] = *(const u32x4*)(O0w + (long)(it * 4 + rq) * LDO + ch * 8);
#pragma unroll
    for (int it = 0; it < 8; ++it) { const int row = it * 4 + rq; const u32x4 o1 = *(const u32x4*)(tb + row * OT_PITCH + ch * 16);
      const float x[8] = {bflo(o0[it].x) - lam * bflo(o1.x), bfhi(o0[it].x) - lam * bfhi(o1.x), bflo(o0[it].y) - lam * bflo(o1.y), bfhi(o0[it].y) - lam * bfhi(o1.y),
                          bflo(o0[it].z) - lam * bflo(o1.z), bfhi(o0[it].z) - lam * bfhi(o1.z), bflo(o0[it].w) - lam * bflo(o1.w), bfhi(o0[it].w) - lam * bfhi(o1.w)};
      float ss = 0.f;
#pragma unroll
      for (int e = 0; e < 8; ++e) ss += x[e] * x[e];
      ss += __shfl_xor(ss, 1); ss += __shfl_xor(ss, 2); ss += __shfl_xor(ss, 4); ss += __shfl_xor(ss, 8);
      ssv[it] = ss; if (ch == 0) ss2[wid * 32 + row] = ss; }
    __syncthreads();
    const f32x4 g0 = *(const f32x4*)(gain + half * 128 + ch * 8), g1 = *(const f32x4*)(gain + half * 128 + ch * 8 + 4);
    bf16_t* Of = Ofin + (long)(rg * QBLK) * DM + half * 128 + ch * 8;
#pragma unroll
    for (int it = 0; it < 8; ++it) { const int row = it * 4 + rq; const u32x4 o1 = *(const u32x4*)(tb + row * OT_PITCH + ch * 16);
      const float x[8] = {bflo(o0[it].x) - lam * bflo(o1.x), bfhi(o0[it].x) - lam * bfhi(o1.x), bflo(o0[it].y) - lam * bflo(o1.y), bfhi(o0[it].y) - lam * bfhi(o1.y),
                          bflo(o0[it].z) - lam * bflo(o1.z), bfhi(o0[it].z) - lam * bfhi(o1.z), bflo(o0[it].w) - lam * bflo(o1.w), bfhi(o0[it].w) - lam * bfhi(o1.w)};
      const float rs = oscale / sqrtf((ssv[it] + ss2[(wid ^ 4) * 32 + row]) * (1.f / 256.f) + NORM_EPS);
      u32x4 w; w.x = cvt_pk_bf16(x[0] * rs * g0.x, x[1] * rs * g0.y); w.y = cvt_pk_bf16(x[2] * rs * g0.z, x[3] * rs * g0.w);
      w.z = cvt_pk_bf16(x[4] * rs * g1.x, x[5] * rs * g1.y); w.w = cvt_pk_bf16(x[6] * rs * g1.z, x[7] * rs * g1.w);
      *(u32x4*)(Of + (long)row * DM) = w; }
  }
  __syncthreads();
#undef DF_LDK
#undef DF_LDV
#undef DF_WRK
#undef DF_WRV
}
}

__device__ __forceinline__ float qk_bound(const float* qn, const float* kn) {
    const int lane = threadIdx.x & 63;
    float a = fmaxf(fabsf(qn[lane]), fabsf(qn[lane + 64])), b = fmaxf(fabsf(kn[lane]), fabsf(kn[lane + 64]));
#pragma unroll
    for (int o = 1; o < 64; o <<= 1) { a = fmaxf(a, __shfl_xor(a, o)); b = fmaxf(b, __shfl_xor(b, o)); }
    return 128.f * 1.02f * a * b;
}
__device__ __forceinline__ void gqa_attn_phase(const bf16_t* P, bf16_t* O, const float* qn, const float* kn, const f32x2* rope, char* lds, int G, int bid) {
    constexpr int NBIG = 2048, NSMALL = 256;
    const float mfix = qk_bound(qn, kn);
    const bool sub = __builtin_amdgcn_readfirstlane((int)(mfix * (att::SCALE * 1.4426950408889634f) > 80.f)) != 0;
    for (int L = bid; L < NBIG + NSMALL; L += G) {
        int b, hq, q0, seq;
        if (L < NBIG) { const int xcd = L & 7, j = (L >> 3) & 31, rnd = L >> 8, bk = rnd * 8 + xcd; b = bk >> 2; const int kvh = bk & 3; hq = kvh * 4 + (j >> 3); q0 = CTXL + (j & 7) * 256; seq = TPB; }
        else { const int l2 = L - NBIG; b = l2 >> 4; hq = l2 & 15; q0 = 0; seq = CTXL; }
        const int kvh = hq >> 2;
        const bf16_t* base = P + (size_t)b * TPB * 3072;
        if (sub) att::attn_dense_body<3072, 3072, 2048, true>(base + (size_t)q0 * 3072 + hq * 128, base + 2048 + kvh * 128, base + 2560 + kvh * 128,
                                               O + ((size_t)b * TPB + q0) * DM + hq * 128, seq, mfix, qn, rope, q0 - CTXL, lds);
        else att::attn_dense_body<3072, 3072, 2048, false>(base + (size_t)q0 * 3072 + hq * 128, base + 2048 + kvh * 128, base + 2560 + kvh * 128,
                                               O + ((size_t)b * TPB + q0) * DM + hq * 128, seq, mfix, qn, rope, q0 - CTXL, lds);
    }
}
__device__ __forceinline__ void diff_attn_phase(const bf16_t* P, bf16_t* OD, bf16_t* O, const float* qn, const float* kn, const f32x2* rope,
                                                const float* lq1, const float* lk1, const float* lq2, const float* lk2, const float* gain, char* lds, int G, int bid) {
    const float mfix = qk_bound(qn, kn);
    const bool sub = __builtin_amdgcn_readfirstlane((int)(mfix * (att::SCALE * 1.4426950408889634f) > 80.f)) != 0;
    const int lane = threadIdx.x & 63;
    const float lam_init = 0.8f - 0.6f * 0.54881163609402643f;
    const float d1 = wave_sum(lq1[lane] * lk1[lane] + lq1[lane + 64] * lk1[lane + 64]);
    const float d2 = wave_sum(lq2[lane] * lk2[lane] + lq2[lane + 64] * lk2[lane + 64]);
    const float lam = expf(d1) - expf(d2) + lam_init, oscale = 1.f - lam_init;
    for (int L = bid; L < 2048; L += G) {
        const int xcd = L & 7, j = (L >> 3) & 31, rnd = L >> 8, bh = (rnd * 8 + xcd) * 2 + (j >> 4), b = bh >> 3, h = bh & 7, qb = j & 15;
        const bf16_t* base = P + (size_t)b * TPB * 6144;
        bf16_t* Of = O + ((size_t)b * TPB + CTXL + qb * 128) * DM + h * 256;
#pragma unroll 1
        for (int m = 0; m < 2; ++m) {
            if (sub) att::attn_diff_body<6144, 4096, true>(base + (size_t)(CTXL + qb * 128) * 6144 + (2 * h + m) * 128, base + 2048 + (2 * h + m) * 128, base + 4096 + h * 256,
                                        OD + ((size_t)b * SEQ + qb * 128) * 4096 + (2 * h + m) * 256, TPB, mfix, qn, rope, qb * 128, lds, m == 1, Of, lam, oscale, gain);
            else att::attn_diff_body<6144, 4096, false>(base + (size_t)(CTXL + qb * 128) * 6144 + (2 * h + m) * 128, base + 2048 + (2 * h + m) * 128, base + 4096 + h * 256,
                                        OD + ((size_t)b * SEQ + qb * 128) * 4096 + (2 * h + m) * 256, TPB, mfix, qn, rope, qb * 128, lds, m == 1, Of, lam, oscale, gain);
        }
    }
}
__device__ __forceinline__ void diff_combine_phase(const bf16_t* OD, bf16_t* O, const float* lq1, const float* lk1, const float* lq2, const float* lk2, const float* gain, int G, int bid) {
    const int tid = threadIdx.x, lane = tid & 63, wave = __builtin_amdgcn_readfirstlane(tid >> 6);
    const float lam_init = 0.8f - 0.6f * 0.54881163609402643f;
    const float d1 = wave_sum(lq1[lane] * lk1[lane] + lq1[lane + 64] * lk1[lane + 64]);
    const float d2 = wave_sum(lq2[lane] * lk2[lane] + lq2[lane + 64] * lk2[lane + 64]);
    const float lam = expf(d1) - expf(d2) + lam_init;
    const float oscale = 1.f - lam_init;
    const int sub = lane >> 5, li = lane & 31;
    const f32x4 g0 = *(const f32x4*)(gain + 8 * li), g1 = *(const f32x4*)(gain + 8 * li + 4);
    const long total = (long)NLAT * 4, stride = (long)G * 8;
    constexpr int NI = 4;
    for (long id0 = (long)bid * 8 + wave; id0 < total; id0 += stride * NI) {
        u32x4 a[NI], c[NI]; bf16_t* op[NI]; bool ok[NI];
#pragma unroll
        for (int i = 0; i < NI; ++i) { const long id = id0 + stride * i; ok[i] = id < total; const long idc = ok[i] ? id : id0;
            const int lr = (int)(idc >> 2), h = (int)(idc & 3) * 2 + sub;
            const bf16_t* p = OD + (size_t)lr * 4096 + (2 * h) * 256 + 8 * li; a[i] = *(const u32x4*)p; c[i] = *(const u32x4*)(p + 256);
            const int b = lr / SEQ, t = lr - b * SEQ; op[i] = O + ((size_t)b * TPB + CTXL + t) * DM + h * 256 + 8 * li; }
#pragma unroll
        for (int i = 0; i < NI; ++i) {
            float x[8] = {bflo(a[i].x) - lam * bflo(c[i].x), bfhi(a[i].x) - lam * bfhi(c[i].x), bflo(a[i].y) - lam * bflo(c[i].y), bfhi(a[i].y) - lam * bfhi(c[i].y),
                          bflo(a[i].z) - lam * bflo(c[i].z), bfhi(a[i].z) - lam * bfhi(c[i].z), bflo(a[i].w) - lam * bflo(c[i].w), bfhi(a[i].w) - lam * bfhi(c[i].w)};
            float ss = 0.f;
#pragma unroll
            for (int e = 0; e < 8; ++e) ss += x[e] * x[e];
            ss += __shfl_xor(ss, 1); ss += __shfl_xor(ss, 2); ss += __shfl_xor(ss, 4); ss += __shfl_xor(ss, 8); ss += __shfl_xor(ss, 16);
            const float rs = oscale / sqrtf(ss * (1.f / 256.f) + NORM_EPS);
            u32x4 o; o.x = cvt_pk_bf16(x[0] * rs * g0.x, x[1] * rs * g0.y); o.y = cvt_pk_bf16(x[2] * rs * g0.z, x[3] * rs * g0.w);
            o.z = cvt_pk_bf16(x[4] * rs * g1.x, x[5] * rs * g1.y); o.w = cvt_pk_bf16(x[6] * rs * g1.z, x[7] * rs * g1.w);
            if (ok[i]) *(u32x4*)op[i] = o;
        }
    }
}

__device__ __forceinline__ float logsigmoidf(float x) { return fminf(x, 0.f) - __logf(1.f + __expf(-fabsf(x))); }
constexpr int G1_ZS = 0, G1_HT = 8192, G1_MS = 12288, G1_QS = 21504, G1_KS = 55296, G1_VS = 21504;
template <int DIR>
__device__ __forceinline__ void gla_prep_dir(const bf16_t* P, const float* wg, const float* bg, bf16_t* QT, bf16_t* KTT, float* CM, float* CL, LAS unsigned char* lds,
                                             int b, int h, int c, int R0, const unsigned (&raw)[32], f32x4 (&accOut)[2]) {
    const int tid = opaque_tid(), lane = tid & 63, wave = __builtin_amdgcn_readfirstlane(tid >> 6), d = tid & 255, half = tid >> 8;
    LAS float* ZS = (LAS float*)(lds + G1_ZS); LAS float* HT = (LAS float*)(lds + G1_HT);
    LAS bf16_t* QS = (LAS bf16_t*)(lds + G1_QS); LAS bf16_t* KS = (LAS bf16_t*)(lds + G1_KS);
    f32x2 wp[8];
#pragma unroll
    for (int kk = 0; kk < 8; ++kk) wp[kk] = (f32x2){wg[(2 * kk) * 1024 + 256 * h + d], wg[(2 * kk + 1) * 1024 + 256 * h + d]};
    const float bias = bg[256 * h + d];
    float cum[32];
#pragma unroll
    for (int ii = 0; ii < 32; ++ii) {
        const LAS float* zr = ZS + (half * 32 + ii) * 32 + DIR * 16;
        const f32x4 z0 = *(const LAS f32x4*)zr, z1 = *(const LAS f32x4*)(zr + 4), z2 = *(const LAS f32x4*)(zr + 8), z3 = *(const LAS f32x4*)(zr + 12);
        f32x2 a2 = (f32x2){z0.x, z0.y} * wp[0], b2 = (f32x2){z0.z, z0.w} * wp[1], c2 = (f32x2){z1.x, z1.y} * wp[2], d2 = (f32x2){z1.z, z1.w} * wp[3];
        a2 += (f32x2){z2.x, z2.y} * wp[4]; b2 += (f32x2){z2.z, z2.w} * wp[5]; c2 += (f32x2){z3.x, z3.y} * wp[6]; d2 += (f32x2){z3.z, z3.w} * wp[7];
        const f32x2 s2 = (a2 + b2) + (c2 + d2);
        const float x = (s2.x + s2.y) + bias;
        const float t = __builtin_amdgcn_exp2f(fabsf(x) * -1.4426950408889634f);
        cum[ii] = fmaf(__builtin_amdgcn_logf(1.0f + t), -0.6931471805599453f * 0.0625f, fminf(x, 0.f) * 0.0625f);
    }
    float total;
    if (DIR == 0) {
#pragma unroll
        for (int ii = 1; ii < 32; ++ii) cum[ii] += cum[ii - 1];
        total = cum[31];
    } else {
#pragma unroll
        for (int ii = 30; ii >= 0; --ii) cum[ii] += cum[ii + 1];
        total = cum[0];
    }
    HT[(DIR * 2 + half) * 256 + d] = total;
    __syncthreads();
    const float t0 = HT[(DIR * 2 + 0) * 256 + d], t1 = HT[(DIR * 2 + 1) * 256 + d];
    const float cmid = DIR == 0 ? t0 : t1, clast = t0 + t1;
    const float add = DIR == 0 ? (half == 1 ? t0 : 0.f) : (half == 0 ? t1 : 0.f);
    unsigned kpack[16];
    const float ecl = __expf(clast - cmid);
#pragma unroll
    for (int i0 = 0; i0 < 32; i0 += 8) {
        float kcv[8];
#pragma unroll
        for (int e = 0; e < 8; ++e) {
            const int ii = i0 + e;
            const float cu = cum[ii] + add;
            const float e1 = __expf(cu - cmid);
            const f32x2 ee = {e1, __builtin_amdgcn_rcpf(e1)};
            const f32x2 qk = (f32x2){__builtin_bit_cast(float, raw[ii] << 16), __builtin_bit_cast(float, raw[ii] & 0xffff0000u)} * ee;
            const unsigned qkb = cvt_pk_bf16(qk.x * 0.0625f, qk.y);
            QS[(half * 32 + ii) * 264 + d] = (bf16_t)(qkb & 0xffffu); KS[(half * 32 + ii) * 264 + d] = (bf16_t)(qkb >> 16);
            kcv[e] = qk.y * ecl;
        }
#pragma unroll
        for (int e = 0; e < 8; e += 2) kpack[(i0 + e) >> 1] = cvt_pk_bf16(kcv[e], kcv[e + 1]);
    }
    const size_t chunk_frag0 = ((((size_t)DIR * NB + b) * 36 + c) * 4 + h) * 32;
    {
        bf16_t* kt = KTT + (chunk_frag0 + (size_t)(d >> 4) * 2 + half) * 512 + (d & 15) * 8;
#pragma unroll
        for (int q = 0; q < 4; ++q) *(u32x4*)(kt + q * 128) = (u32x4){kpack[4 * q], kpack[4 * q + 1], kpack[4 * q + 2], kpack[4 * q + 3]};
    }
    if (half == 0) { const size_t vi = (((size_t)DIR * NB + b) * 36 + c) * 1024 + 256 * h + d; CM[vi] = cmid; CL[vi] = clast; }
    __syncthreads();
    const int ti = wave >> 1, tj0 = (wave & 1) * 2, fr = lane & 15, fq = lane >> 4;
    {
#pragma unroll
        for (int x = 0; x < 4; ++x) { const int f = wave * 4 + x, fti = f >> 3, fks = f & 7;
            *(bf16x8*)(QT + (chunk_frag0 + f) * 512 + lane * 8) = *(const LAS bf16x8*)(QS + (16 * fti + fr) * 264 + 32 * fks + 8 * fq); }
    }
#pragma unroll
    for (int x = 0; x < 2; ++x) {
        f32x4 acc = {0.f, 0.f, 0.f, 0.f};
#pragma unroll
        for (int ks = 0; ks < 8; ++ks) {
            const bf16x8 av = *(const LAS bf16x8*)(QS + (16 * ti + fr) * 264 + 32 * ks + 8 * fq);
            const bf16x8 bv = *(const LAS bf16x8*)(KS + (16 * (tj0 + x) + fr) * 264 + 32 * ks + 8 * fq);
            acc = __builtin_amdgcn_mfma_f32_16x16x32_bf16(av, bv, acc, 0, 0, 0);
        }
        accOut[x] = acc;
    }
    __syncthreads();
}
__device__ __forceinline__ void gla_prep_phase(const bf16_t* P, const float* Z, const float* wgf, const float* bgf, const float* wgb, const float* bgb,
                                               bf16_t* QT, bf16_t* KTT, bf16_t* VT, float* CM, float* CL, _Float16* O32, LAS unsigned char* lds, int G, int bid) {
    const int tid = opaque_tid(), lane = tid & 63, wave = __builtin_amdgcn_readfirstlane(tid >> 6), fr = lane & 15, fq = lane >> 4;
    LAS float* ZS = (LAS float*)(lds + G1_ZS);
    LAS bf16_t* MS = (LAS bf16_t*)(lds + G1_MS);
    LAS bf16_t* VSw = (LAS bf16_t*)(lds + G1_VS) + wave * (64 * 72);
    for (int u = bid; u < NB * 4 * 36; u += G) {
        const int b = u / 144, rem = u - b * 144, h = rem / 36, c = rem - h * 36, R0 = b * TPB + 64 * c;
        { const int row = tid >> 3, c4 = (tid & 7) * 4; *(LAS f32x4*)(ZS + row * 32 + c4) = *(const f32x4*)(Z + (size_t)(R0 + row) * 32 + c4); }
        __syncthreads();
        unsigned raw[32];
        { const bf16_t* qp = P + (size_t)(R0 + (tid >> 8) * 32) * 6144 + 256 * h + (tid & 255);
#pragma unroll
          for (int ii = 0; ii < 32; ++ii) raw[ii] = (unsigned)qp[(size_t)ii * 6144] | ((unsigned)qp[(size_t)ii * 6144 + 1024] << 16); }
        f32x4 accF[2], accB[2];
        gla_prep_dir<0>(P, wgf, bgf, QT, KTT, CM, CL, lds, b, h, c, R0, raw, accF);
        gla_prep_dir<1>(P, wgb, bgb, QT, KTT, CM, CL, lds, b, h, c, R0, raw, accB);
        const int ti = wave >> 1, tj0 = (wave & 1) * 2;
#pragma unroll
        for (int x = 0; x < 2; ++x)
#pragma unroll
            for (int r = 0; r < 4; ++r) { const int i = 16 * ti + 4 * fq + r, j = 16 * (tj0 + x) + fr;
                const float m = (j <= i ? accF[x][r] : 0.f) + (j >= i ? accB[x][r] : 0.f);
                MS[i * 72 + j] = (bf16_t)f2bf(m); }
#pragma unroll
        for (int it = 0; it < 8; ++it) { const int q = it * 64 + lane, j = q >> 3, ec = (q & 7) * 8;
            const u32x4 w = *(const u32x4*)(P + (size_t)(R0 + j) * 6144 + 2048 + 512 * h + 64 * wave + ec);
            const int js = (((j >> 3) ^ (q & 7)) << 3) | (j & 7);
            VSw[(ec + 0) * 72 + js] = (bf16_t)(w.x & 0xffff); VSw[(ec + 1) * 72 + js] = (bf16_t)(w.x >> 16);
            VSw[(ec + 2) * 72 + js] = (bf16_t)(w.y & 0xffff); VSw[(ec + 3) * 72 + js] = (bf16_t)(w.y >> 16);
            VSw[(ec + 4) * 72 + js] = (bf16_t)(w.z & 0xffff); VSw[(ec + 5) * 72 + js] = (bf16_t)(w.z >> 16);
            VSw[(ec + 6) * 72 + js] = (bf16_t)(w.w & 0xffff); VSw[(ec + 7) * 72 + js] = (bf16_t)(w.w >> 16); }
        __syncthreads();
        {
            bf16_t* vt = VT + ((((size_t)b * 36 + c) * 4 + h) * 512 + 64 * wave) * 64;
#pragma unroll
            for (int it = 0; it < 8; ++it) { const int q = it * 64 + lane, e = q >> 3, jc = (q & 7) * 8;
                *(u32x4*)(vt + (size_t)e * 64 + jc) = *(const LAS u32x4*)(VSw + e * 72 + (jc ^ (((e >> 3) & 7) << 3))); }
        }
        f32x4 oacc[4][4];
#pragma unroll
        for (int a = 0; a < 4; ++a)
#pragma unroll
            for (int bb = 0; bb < 4; ++bb) oacc[a][bb] = (f32x4){0.f, 0.f, 0.f, 0.f};
#pragma unroll
        for (int ks = 0; ks < 2; ++ks) {
            bf16x8 av[4], bv[4];
#pragma unroll
            for (int t = 0; t < 4; ++t) { av[t] = *(const LAS bf16x8*)(MS + (16 * t + fr) * 72 + 32 * ks + 8 * fq); bv[t] = *(const LAS bf16x8*)(VSw + (16 * t + fr) * 72 + (((4 * ks + fq) ^ ((2 * t + (fr >> 3)) & 7)) << 3)); }
#pragma unroll
            for (int a = 0; a < 4; ++a)
#pragma unroll
                for (int bb = 0; bb < 4; ++bb) oacc[a][bb] = __builtin_amdgcn_mfma_f32_16x16x32_bf16(bv[bb], av[a], oacc[a][bb], 0, 0, 0);
        }
#pragma unroll
        for (int a = 0; a < 4; ++a) { _Float16* op = O32 + (size_t)(R0 + 16 * a + fr) * 2048 + 512 * h + 64 * wave + 4 * fq;
#pragma unroll
            for (int bb = 0; bb < 4; ++bb) { u32x2 w; w.x = pk_f16(oacc[a][bb].x, oacc[a][bb].y); w.y = pk_f16(oacc[a][bb].z, oacc[a][bb].w); *(u32x2*)(op + 16 * bb) = w; } }
        __syncthreads();
    }
}
constexpr int SC_ST = 0, SC_VT = 67584, SC_VTB = 18432;
__device__ __forceinline__ void gla_scan_phase(const bf16_t* QT, const bf16_t* KTT, const bf16_t* VT, const float* CM, const float* CL, _Float16* O32, LAS unsigned char* lds, int G, int bid, float sgn = 1.f) {
    const int tid = opaque_tid(), lane = tid & 63, wave = __builtin_amdgcn_readfirstlane(tid >> 6), fr = lane & 15, fq = lane >> 4;
    const int ti = wave >> 1, tj0 = (wave & 1) * 4;
    LAS bf16_t* ST = (LAS bf16_t*)(lds + SC_ST);
    const int vte = tid >> 2, vtp = tid & 3;
    for (int u0 = bid; u0 < 256; u0 += G) {
        const int u = (G == 256) ? ((u0 & 7) * 32 + (u0 >> 3)) : u0;
        const int b = u >> 4, h = (u >> 2) & 3, sl = u & 3;
#define SC_CHUNK(q, dir, c) const int dir = (q) >= 36 ? 1 : 0; const int s_##c = (q) - 36 * dir; const int c = dir == 0 ? s_##c : (s_##c < 4 ? 3 - s_##c : 39 - s_##c)
#define SC_LOAD_CMCL(q) do { SC_CHUNK(q, d_, c_); const size_t vb = (((size_t)d_ * NB + b) * 36 + c_) * 1024 + 256 * h + 32 * wave + 4 * fq; \
        _Pragma("unroll") for (int t = 0; t < 2; ++t) { cm[t] = *(const f32x4*)(CM + vb + 16 * t); cl[t] = *(const f32x4*)(CL + vb + 16 * t); } } while (0)
#define SC_LOAD_Q(q) do { SC_CHUNK(q, d_, c_); const bf16_t* qfr = QT + ((((((size_t)d_ * NB + b) * 36 + c_) * 4 + h) * 32) + ti * 8) * 512 + lane * 8; \
        _Pragma("unroll") for (int ks = 0; ks < 8; ++ks) qf[ks] = *(const bf16x8*)(qfr + ks * 512); } while (0)
#define SC_LOAD_K(q) do { SC_CHUNK(q, d_, c_); const bf16_t* kb = KTT + ((((((size_t)d_ * NB + b) * 36 + c_) * 4 + h) * 32) + wave * 4) * 512 + lane * 8; \
        _Pragma("unroll") for (int ks = 0; ks < 2; ++ks) _Pragma("unroll") for (int t = 0; t < 2; ++t) kf[t][ks] = *(const bf16x8*)(kb + (t * 2 + ks) * 512); } while (0)
#define SC_LOAD_V(q) do { SC_CHUNK(q, d_, c_); (void)d_; const bf16_t* vp = VT + ((((size_t)b * 36 + c_) * 4 + h) * 512 + 128 * sl + vte) * 64 + 16 * vtp; \
        vs0 = *(const bf16x8*)vp; vs1 = *(const bf16x8*)(vp + 8); } while (0)
#define SC_WRITE_V(buf) do { LAS bf16_t* vd = (LAS bf16_t*)(lds + SC_VT + (buf) * SC_VTB) + vte * 72 + 16 * vtp; *(LAS bf16x8*)vd = vs0; *(LAS bf16x8*)(vd + 8) = vs1; } while (0)
#define SC_LOAD_O(q) do { SC_CHUNK(q, d_, c_); (void)d_; const _Float16* ob_ = O32 + (size_t)(b * TPB + 64 * c_ + 16 * ti + fr) * 2048 + 512 * h + 128 * sl + 16 * tj0 + 4 * fq; \
        _Pragma("unroll") for (int x = 0; x < 4; ++x) ov[x] = *(const u32x2*)(ob_ + 16 * x); } while (0)
        f32x4 S[2][8];
#pragma unroll
        for (int t = 0; t < 2; ++t)
#pragma unroll
            for (int uu = 0; uu < 8; ++uu) S[t][uu] = (f32x4){0.f, 0.f, 0.f, 0.f};
        f32x4 cm[2], cl[2]; bf16x8 qf[8], kf[2][2], vs0, vs1; u32x2 ov[4];
        SC_LOAD_V(0); SC_WRITE_V(0); SC_LOAD_V(1);
        SC_LOAD_CMCL(0); SC_LOAD_Q(0); SC_LOAD_K(0); SC_LOAD_O(0);
        __syncthreads();
        for (int q = 0; q < 72; ++q) {
            SC_CHUNK(q, dir, c);
            (void)dir;
            const int R0 = b * TPB + 64 * c;
            const int qn = q < 71 ? q + 1 : 71, qnn = q < 70 ? q + 2 : 71;
            if (q == 36) {
#pragma unroll
                for (int t = 0; t < 2; ++t)
#pragma unroll
                    for (int uu = 0; uu < 8; ++uu) S[t][uu] = (f32x4){0.f, 0.f, 0.f, 0.f};
            }
            _Float16* const ob = O32 + (size_t)(R0 + 16 * ti + fr) * 2048 + 512 * h + 128 * sl + 16 * tj0 + 4 * fq;
            f32x4 dec[2];
#pragma unroll
            for (int t = 0; t < 2; ++t) { const f32x4 e = {__expf(cm[t].x), __expf(cm[t].y), __expf(cm[t].z), __expf(cm[t].w)};
                dec[t] = (f32x4){__expf(cl[t].x), __expf(cl[t].y), __expf(cl[t].z), __expf(cl[t].w)};
#pragma unroll
                for (int uu = 0; uu < 8; ++uu) { const f32x4 v = S[t][uu] * e; u32x2 w; w.x = cvt_pk_bf16(v.x, v.y); w.y = cvt_pk_bf16(v.z, v.w);
                    *(LAS u32x2*)(ST + (16 * uu + fr) * 264 + 32 * wave + 16 * t + 4 * fq) = w; } }
            SC_LOAD_CMCL(qn);
            __syncthreads();
            SC_WRITE_V((q + 1) & 1); SC_LOAD_V(qnn);
            f32x4 oa[4];
#pragma unroll
            for (int x = 0; x < 4; ++x) oa[x] = (f32x4){0.f, 0.f, 0.f, 0.f};
#pragma unroll
            for (int ks = 0; ks < 8; ++ks) {
#pragma unroll
                for (int x = 0; x < 4; ++x) { const bf16x8 bv = *(const LAS bf16x8*)(ST + (16 * (tj0 + x) + fr) * 264 + 32 * ks + 8 * fq);
                    oa[x] = __builtin_amdgcn_mfma_f32_16x16x32_bf16(bv, qf[ks], oa[x], 0, 0, 0); } }
            __syncthreads();
            SC_LOAD_Q(qn);
#pragma unroll
            for (int x = 0; x < 4; ++x) { u32x2 w; w.x = pk_f16(f16lo(ov[x].x) + sgn * oa[x].x, f16hi(ov[x].x) + sgn * oa[x].y); w.y = pk_f16(f16lo(ov[x].y) + sgn * oa[x].z, f16hi(ov[x].y) + sgn * oa[x].w);
                *(u32x2*)(ob + 16 * x) = w; }
            SC_LOAD_O(qn);
            const LAS bf16_t* vt = (const LAS bf16_t*)(lds + SC_VT + (q & 1) * SC_VTB);
#pragma unroll
            for (int t = 0; t < 2; ++t)
#pragma unroll
                for (int uu = 0; uu < 8; ++uu) S[t][uu] = S[t][uu] * dec[t];
#pragma unroll
            for (int ks = 0; ks < 2; ++ks)
#pragma unroll
                for (int uu = 0; uu < 8; ++uu) { const bf16x8 bv = *(const LAS bf16x8*)(vt + (16 * uu + fr) * 72 + 32 * ks + 8 * fq);
#pragma unroll
                    for (int t = 0; t < 2; ++t) S[t][uu] = __builtin_amdgcn_mfma_f32_16x16x32_bf16(kf[t][ks], bv, S[t][uu], 0, 0, 0); }
            SC_LOAD_K(qn);
        }
        __syncthreads();
#undef SC_CHUNK
#undef SC_LOAD_CMCL
#undef SC_LOAD_Q
#undef SC_LOAD_K
#undef SC_LOAD_V
#undef SC_WRITE_V
#undef SC_LOAD_O
    }
}
__device__ __forceinline__ void gla_finish_phase(const _Float16* O32, const bf16_t* P, const float* gain, bf16_t* O, int G, int bid) {
    const int tid = threadIdx.x, lane = tid & 63, wave = __builtin_amdgcn_readfirstlane(tid >> 6);
    const f32x4 g0 = *(const f32x4*)(gain + 4 * lane), g1 = *(const f32x4*)(gain + 256 + 4 * lane);
    const long total = (long)NT * 4, stride = (long)G * 8;
    constexpr int NI = 4;
    for (long id0 = (long)bid * 8 + wave; id0 < total; id0 += stride * NI) {
        u32x2 qa[NI], qc[NI]; f32x4 a[NI], c[NI]; u32x2 ra[NI], rc[NI]; bf16_t* op[NI]; bool ok[NI];
#pragma unroll
        for (int i = 0; i < NI; ++i) { const long id = id0 + stride * i; ok[i] = id < total; const long idc = ok[i] ? id : id0;
            const int r = (int)(idc >> 2), h = (int)(idc & 3);
            const _Float16* ip = O32 + (size_t)r * 2048 + 512 * h + 4 * lane; qa[i] = *(const u32x2*)ip; qc[i] = *(const u32x2*)(ip + 256);
            const bf16_t* rp = P + (size_t)r * 6144 + 4096 + 512 * h + 4 * lane; ra[i] = *(const u32x2*)rp; rc[i] = *(const u32x2*)(rp + 256);
            op[i] = O + (size_t)r * DM + 512 * h + 4 * lane; }
#pragma unroll
        for (int i = 0; i < NI; ++i) {
            a[i] = (f32x4){f16lo(qa[i].x), f16hi(qa[i].x), f16lo(qa[i].y), f16hi(qa[i].y)}; c[i] = (f32x4){f16lo(qc[i].x), f16hi(qc[i].x), f16lo(qc[i].y), f16hi(qc[i].y)};
            const float ss = wave_sum((a[i].x * a[i].x + a[i].y * a[i].y) + (a[i].z * a[i].z + a[i].w * a[i].w) + (c[i].x * c[i].x + c[i].y * c[i].y) + (c[i].z * c[i].z + c[i].w * c[i].w));
            const float rs = 1.0f / sqrtf(ss * (1.f / 512.f) + NORM_EPS);
            u32x2 o0, o1;
            o0.x = cvt_pk_bf16(a[i].x * rs * g0.x * siluf(bflo(ra[i].x)), a[i].y * rs * g0.y * siluf(bfhi(ra[i].x)));
            o0.y = cvt_pk_bf16(a[i].z * rs * g0.z * siluf(bflo(ra[i].y)), a[i].w * rs * g0.w * siluf(bfhi(ra[i].y)));
            o1.x = cvt_pk_bf16(c[i].x * rs * g1.x * siluf(bflo(rc[i].x)), c[i].y * rs * g1.y * siluf(bfhi(rc[i].x)));
            o1.y = cvt_pk_bf16(c[i].z * rs * g1.z * siluf(bflo(rc[i].y)), c[i].w * rs * g1.w * siluf(bfhi(rc[i].y)));
            if (ok[i]) { *(u32x2*)op[i] = o0; *(u32x2*)(op[i] + 256) = o1; }
        }
    }
}

__device__ __forceinline__ void fnet_nyquist(const bf16_t* DFT2m, const bf16_t* UVT, bf16_t* O, int G, int bid) {
    const int tid = opaque_tid(), lane = tid & 63, wave = __builtin_amdgcn_readfirstlane(tid >> 6), fr = lane & 15, fq = lane >> 4;
    for (int task = bid * 8 + wave; task < NB * 128; task += G * 8) {
        const int b = task >> 7, l0 = (task & 127) * 16;
        const bf16_t* ap = DFT2m + (size_t)(l0 + fr) * 4096 + 8 * fq;
        const bf16_t* bp = UVT + ((size_t)b * 1024 + (size_t)(fr & 3) * 256) * 4096 + 2048 + 8 * fq;
        f32x4 acc = {0.f, 0.f, 0.f, 0.f};
#pragma unroll 8
        for (int ks = 0; ks < 64; ++ks) acc = __builtin_amdgcn_mfma_f32_16x16x32_bf16(*(const bf16x8*)(ap + 32 * ks), *(const bf16x8*)(bp + 32 * ks), acc, 0, 0, 0);
        if (fr < 4) {
#pragma unroll
            for (int r = 0; r < 4; ++r) O[((size_t)b * TPB + CTXL + l0 + 4 * fq + r) * DM + fr * 512 + 256] = (bf16_t)f2bf(acc[r]);
        }
    }
}

__device__ __forceinline__ void fnet_row1024(const bf16_t* UVT, bf16_t* O, int G, int bid) {
    const int tid = opaque_tid(), lane = tid & 63, wave = __builtin_amdgcn_readfirstlane(tid >> 6);
    const float cw = bf2f((unsigned short)f2bf(0.022097086912079608f));
    for (int task = bid * 8 + wave; task < NB * 1024; task += G * 8) {
        const int b = task >> 10, ch = task & 1023, g = ch >> 8, t = ch & 255;
        const bf16_t* up = UVT + ((size_t)b * 1024 + ch) * 4096 + 8 * lane;
        float sum = 0.f;
#pragma unroll
        for (int j = 0; j < 4; ++j) { const u32x4 w = *(const u32x4*)(up + 512 * j);
            sum += (bflo(w.x) - bfhi(w.x)) + (bflo(w.y) - bfhi(w.y)) + (bflo(w.z) - bfhi(w.z)) + (bflo(w.w) - bfhi(w.w)); }
        sum = wave_sum(sum) * cw;
        if (lane == 0) { bf16_t* orow = O + ((size_t)b * TPB + CTXL + 1024) * DM + g * 512; const bf16_t v = (bf16_t)f2bf(sum); orow[t] = v; if (t != 0) orow[256 + t] = v; }
    }
}

constexpr int NPH = 34;
template <int L> __device__ __forceinline__ int c_in(int which) {
    constexpr int base = L == 0 ? 4 : L == 1 ? 17 : L == 2 ? 27 : 42;
    constexpr int n2 = L == 0 ? 14 : L == 1 ? 24 : L == 2 ? 39 : 46;
    return which < 3 ? base + which : n2 + (which - 3);
}
__global__ void __launch_bounds__(512, 2) fwd_kernel(KArgs a) {
    extern __shared__ __attribute__((aligned(16))) unsigned char lds_raw[];
    LAS unsigned char* lds = (LAS unsigned char*)lds_raw;
    const int tid = threadIdx.x, G = gridDim.x, bid = blockIdx.x;
    if (tid < 16) ((LAS unsigned*)(lds + MISC_OFF))[tid] = 0u;
    __syncthreads();
    unsigned* barw = (unsigned*)(a.ws + WS_CTL) + 4096;
    XcdBarrier bar; bar.bar = barw; bar.x = 0; bar.st = (volatile LAS unsigned*)(lds + MISC_OFF);
    if (N_LAUNCH_MODE == 1) bar = xcd_barrier_post(barw, (volatile LAS unsigned*)(lds + MISC_OFF));
    const int lo = a.ph_lo, hi = a.ph_hi;
#ifndef PHSEL
#define PHSEL -1
#endif
#define IN(k) ((PHSEL < 0 || PHSEL == (k)) && lo <= (k) && (k) < hi)
#ifndef STAMP_A
#define STAMP_A -100
#endif
#ifndef STAMP_B
#define STAMP_B -100
#endif
    unsigned long long tA0 = 0, tA1 = 0, tB0 = 0, tB1 = 0;
#define STAMP_AT(k) do { if ((k) + 1 == STAMP_A) tA0 = wall_clock64(); if ((k) == STAMP_A) tA1 = wall_clock64(); if ((k) + 1 == STAMP_B) tB0 = wall_clock64(); if ((k) == STAMP_B) tB1 = wall_clock64(); } while (0)
#define SEAM(k) do { if (IN(k) && IN((k) + 1)) xcd_barrier(bar); STAMP_AT(k); } while (0)
#ifndef PROBE_REP
#define PROBE_REP -1
#endif
#ifndef PROBE_N
#define PROBE_N 2
#endif
#define REPS(k) (PROBE_REP == (k) ? PROBE_N : 1)

#define p_ws (a.ws)
#define p_modv ((float*)(a.ws + WS_MODV))
#define p_rope ((const f32x2*)(a.ws + WS_ROPE))
#define p_DFT1 ((bf16_t*)(a.ws + WS_DFT1))
#define p_DFT2 ((bf16_t*)(a.ws + WS_DFT2))
#define p_Wf1 ((bf16_t*)(a.ws + W_FFN1))
#define p_Wf2 ((bf16_t*)(a.ws + W_FFN2))
#define p_Win ((bf16_t*)(a.ws + W_IN))
#define p_Wout ((bf16_t*)(a.ws + W_OUT))
#define p_xh ((void*)(a.ws + WS_XH))
#define p_xhc ((void*)(a.ws + WS_XHC))
#define p_HN ((bf16_t*)(a.ws + WS_HN))
#define p_OB ((bf16_t*)(a.ws + WS_O))
#define p_BIG ((bf16_t*)(a.ws + WS_BIG))
#define p_out (a.out)

#define PH_PREP(k, L, FIN, FOUT, WI, NIN, WO, LATONLY, ...) if (IN(k)) { \
        convert_layer(a, lds, bid * 8 + (int)(threadIdx.x >> 6), G * 8, FIN, FOUT, WI, NIN, WO, ##__VA_ARGS__); \
        norm_phase<(L != 0)>(L == 0 ? (const void*)a.in[0] : (const void*)p_xh, L == 0 ? (const void*)a.in[2] : (const void*)p_xhc, a.in[c_in<L>(2)], p_modv + (size_t)L * 17 * 12288, 0, 2048, p_HN, LATONLY, G, bid, L == 0 ? p_xh : nullptr, L == 0 ? p_xhc : nullptr); } SEAM(k)
#ifndef SKEW_TICKS
#define SKEW_TICKS 0
#endif
#define PH_SKEW() do { if (SKEW_TICKS > 0) { const unsigned long long t0_ = __builtin_amdgcn_s_memrealtime(); const unsigned long long w_ = (unsigned long long)(bid & 3) * SKEW_TICKS; \
        while (__builtin_amdgcn_s_memrealtime() - t0_ < w_) __builtin_amdgcn_s_sleep(32); } } while (0)
#define PH_PROJ(k, NN, LDC, ZT, ZP, KLO, KHI, KN, PROJTAIL) if (IN(k)) { PH_SKEW(); \
        ProbStd g{p_HN, p_Win, DM, DM, DM, 0}; pg8::UOrder S; S.init(144, NN, 1, G, bid, 4); EpiProj E{p_BIG, LDC, ZT, ZP, KLO, KHI, KN, p_rope}; \
        pg8::gemm_phase<ProbStd, EpiProj>(lds, g, S, E); PROJTAIL } SEAM(k)
#define PROJTAIL_L(L, FIRST) if (G == 256 && bid >= (FIRST)) convert_layer(a, lds, (bid - (FIRST)) * 8 + (int)(threadIdx.x >> 6), (256 - (FIRST)) * 8, nullptr, a.in[c_in<L>(5)], nullptr, 0, nullptr);
#define PH_DELAY(ticks) do { if ((ticks) > 0 && G == 256 && bid >= 128) { const unsigned long long t0_ = __builtin_amdgcn_s_memrealtime(); \
        while (__builtin_amdgcn_s_memrealtime() - t0_ < (unsigned long long)(ticks)) __builtin_amdgcn_s_sleep(32); } } while (0)
#define PH_OUT(k, L, AMAP, OUTTAIL) if (IN(k)) { PH_DELAY(0); \
        ProbStd g{p_OB, p_Wout, DM, DM, DM, AMAP}; pg8::UOrder S; S.init(AMAP ? 128 : 144, 8, 1, G, bid, 4); \
        EpiResT<true, true> E{p_xh, p_xhc, p_xh, p_xhc, p_modv + (size_t)L * 17 * 12288, 4096, AMAP}; \
        pg8::gemm_phase<ProbStd, EpiResT<true, true>>(lds, g, S, E); OUTTAIL } SEAM(k)
#define FFNTAIL(FIRST, FIN, FOUT, SH1, SH2) if (G == 256 && bid >= (FIRST)) convert_layer(a, lds, (bid - (FIRST)) * 8 + (int)(threadIdx.x >> 6), (256 - (FIRST)) * 8, FIN, FOUT, nullptr, 0, nullptr, 0, SH1, SH2); \
        else if (G != 256) convert_layer(a, lds, bid * 8 + (int)(threadIdx.x >> 6), G * 8, FIN, FOUT, nullptr, 0, nullptr, 0, SH1, SH2);
#define PH_NORM2(k, L, AMAP) if (IN(k)) { \
        norm_phase<true>(p_xh, p_xhc, a.in[c_in<L>(3)], p_modv + (size_t)L * 17 * 12288, 6144, 8192, p_HN, AMAP, G, bid); } SEAM(k)
#define PH_FFN1(k, L, AMAP) if (IN(k)) { PH_SKEW(); \
        ProbStd g{p_HN, L == 3 ? (bf16_t*)(p_ws + WS_W3F1) : p_Wf1, DM, DM, DM, AMAP}; pg8::UOrder S; S.init(AMAP ? 128 : 144, 44, 1, G, bid, 4); EpiSwiGLU E{p_BIG, AMAP}; \
        pg8::gemm_phase<ProbStd, EpiSwiGLU>(lds, g, S, E); } SEAM(k)
#define PH_FFN2(k, L, AMAP, TAILCONV) if (IN(k)) { \
        ProbStd g{p_BIG, L == 3 ? (bf16_t*)(p_ws + WS_W3F2) : p_Wf2, FF, FF, FF, AMAP}; pg8::UOrder S; S.init(AMAP ? 128 : 144, 8, 1, G, bid, 4, 1); \
        EpiResT<true, (L != 3)> E{p_xh, p_xhc, L == 3 ? (void*)p_out : p_xh, p_xhc, p_modv + (size_t)L * 17 * 12288, 10240, AMAP}; \
        pg8::gemm_phase<ProbStd, EpiResT<true, (L != 3)>>(lds, g, S, E); TAILCONV } SEAM(k)
#define TAILCONV_L(L1, WI, NIN, WO) if (G == 256 && bid >= 128) convert_layer(a, lds, (bid - 128) * 8 + (int)(threadIdx.x >> 6), 128 * 8, a.in[c_in<L1>(4)], nullptr, WI, NIN, WO); \
        else if (G != 256) { xcd_barrier(bar); convert_layer(a, lds, bid * 8 + (int)(threadIdx.x >> 6), G * 8, a.in[c_in<L1>(4)], nullptr, WI, NIN, WO); }

    if (IN(0)) { ph_prologue(a, lds, G, bid); } SEAM(0);
#if PROBE_REP == 0
    if (IN(0)) { ph_prologue(a, lds, G, bid); } SEAM(0);
#endif
#if PROBE_REP >= 200 && PROBE_REP < 210
    if (IN(0)) { const int tid_ = opaque_tid(), lane_ = tid_ & 63, wv_ = tid_ >> 6;
        char* base_ = (char*)(p_ws + WS_O32) + (size_t)bid * (PROBE_REP == 202 ? (size_t)256 * 11264 : (size_t)131072);
        u32x4 val_ = {(unsigned)tid_, 1u, 2u, 3u}; u32x4 accl_ = {0u, 0u, 0u, 0u};
#pragma unroll 1
        for (int it = 0; it < 1024; it += 8) {
#pragma unroll
            for (int k2 = 0; k2 < 8; ++k2) { const int slot = ((it + k2) & 15) * 8 + wv_;
                char* p_;
                if (PROBE_REP == 200 || PROBE_REP == 203) p_ = base_ + (size_t)slot * 1024 + lane_ * 16;
                else if (PROBE_REP == 201) p_ = base_ + (size_t)((slot >> 3) * 16 + (lane_ & 15)) * 512 + (slot & 7) * 64 + (lane_ >> 4) * 16;
                else if (PROBE_REP == 204) p_ = base_ + (size_t)((slot >> 2) * 8 + (lane_ >> 3)) * 512 + (slot & 3) * 128 + (lane_ & 7) * 16;
                else if (PROBE_REP == 205) p_ = base_ + (size_t)((slot >> 3) * 16 + (lane_ >> 2)) * 512 + (slot & 7) * 64 + (lane_ & 3) * 16;
                else p_ = base_ + (size_t)((slot >> 3) * 16 + (lane_ & 15)) * 11264 + (slot & 7) * 64 + (lane_ >> 4) * 16;
                if (PROBE_REP == 203) { const u32x4 r_ = *(const volatile u32x4*)p_; accl_ += r_; }
                else { val_.y += 1u; *(u32x4*)p_ = val_; } }
        }
        if (PROBE_REP == 203 && accl_.x == 0x12345678u && accl_.y == 77u) *(u32x4*)base_ = accl_;
    } SEAM(0);
#endif

    PH_PREP(1, 0, nullptr, nullptr, a.in[7], 6176, a.in[13], 0);
#if PROBE_REP == 1
    PH_PREP(1, 0, nullptr, nullptr, a.in[7], 6176, a.in[13], 0);
#endif
    PH_PROJ(2, 25, 6144, 24, (float*)(p_ws + WS_Z), 0, 0, nullptr, FFNTAIL(16, a.in[c_in<0>(4)], a.in[c_in<0>(5)], 0, 0));
#if PROBE_REP == 2
    PH_PROJ(2, 25, 6144, 24, (float*)(p_ws + WS_Z), 0, 0, nullptr, FFNTAIL(16, a.in[c_in<0>(4)], a.in[c_in<0>(5)], 0, 0));
#endif
    {
        bf16_t* QT = (bf16_t*)(p_ws + WS_O); bf16_t* KTT = (bf16_t*)(p_ws + WS_KTT); bf16_t* VT = (bf16_t*)(p_ws + WS_HN);
        float* CM = (float*)(p_ws + WS_CMCL); float* CL = CM + (size_t)2 * NB * 36 * 1024; _Float16* O32 = (_Float16*)p_out;
        if (IN(3)) { gla_prep_phase(p_BIG, (const float*)(p_ws + WS_Z), a.in[8], a.in[9], a.in[10], a.in[11], QT, KTT, VT, CM, CL, O32, lds, G, bid); } SEAM(3);
#if PROBE_REP == 3
        if (IN(3)) { gla_prep_phase(p_BIG, (const float*)(p_ws + WS_Z), a.in[8], a.in[9], a.in[10], a.in[11], QT, KTT, VT, CM, CL, O32, lds, G, bid); } SEAM(3);
#endif
#if PROBE_REP == 4
        if (IN(4)) { gla_scan_phase(QT, KTT, VT, CM, CL, O32, lds, G, bid); xcd_barrier(bar); gla_scan_phase(QT, KTT, VT, CM, CL, O32, lds, G, bid, -1.f); xcd_barrier(bar); }
#endif
        if (IN(4)) { gla_scan_phase(QT, KTT, VT, CM, CL, O32, lds, G, bid); } SEAM(4);
        if (IN(5)) { gla_finish_phase(O32, p_BIG, a.in[12], p_OB, G, bid); } SEAM(5);
#if PROBE_REP == 5
        if (IN(5)) { gla_finish_phase(O32, p_BIG, a.in[12], p_OB, G, bid); } SEAM(5);
#endif
    }
    PH_OUT(6, 0, 0, FFNTAIL(128, nullptr, a.in[c_in<3>(5)], 0, WS_W3F2 - W_FFN2));
#if PROBE_REP == 6
    PH_OUT(6, 0, 0, FFNTAIL(128, nullptr, a.in[c_in<3>(5)], 0, WS_W3F2 - W_FFN2));
#endif
    PH_NORM2(7, 0, 0);
#if PROBE_REP == 7
    PH_NORM2(7, 0, 0);
#endif
    PH_FFN1(8, 0, 0);
#if PROBE_REP == 8
    PH_FFN1(8, 0, 0);
#endif
    PH_FFN2(9, 0, 0, TAILCONV_L(1, a.in[20], 3072, a.in[23]));

    PH_PREP(10, 1, nullptr, (G == 256 ? (const float*)nullptr : a.in[c_in<1>(5)]), nullptr, 0, nullptr, 0);
#if PROBE_REP == 10
    PH_PREP(10, 1, nullptr, (G == 256 ? (const float*)nullptr : a.in[c_in<1>(5)]), nullptr, 0, nullptr, 0);
#endif
    PH_PROJ(11, 12, 3072, -1, nullptr, 8, 10, a.in[22], PROJTAIL_L(1, 192));
#if PROBE_REP == 11
    PH_PROJ(11, 12, 3072, -1, nullptr, 8, 10, a.in[22], PROJTAIL_L(1, 192));
#endif
    if (IN(13)) { gqa_attn_phase(p_BIG, p_OB, a.in[21], a.in[22], p_rope, (char*)lds_raw, G, bid); } SEAM(13);
#if PROBE_REP == 13
    if (IN(13)) { gqa_attn_phase(p_BIG, p_OB, a.in[21], a.in[22], p_rope, (char*)lds_raw, G, bid); } SEAM(13);
#endif
    PH_OUT(14, 1, 0, FFNTAIL(128, a.in[c_in<3>(4)], nullptr, WS_W3F1 - W_FFN1, 0));
    PH_NORM2(15, 1, 0);
#if PROBE_REP == 15
    PH_NORM2(15, 1, 0);
#endif
    PH_FFN1(16, 1, 0);
#if PROBE_REP == 16
    PH_FFN1(16, 1, 0);
#endif
    PH_FFN2(17, 1, 0, TAILCONV_L(2, a.in[30], 6144, a.in[38]));

    PH_PREP(18, 2, nullptr, (G == 256 ? (const float*)nullptr : a.in[c_in<2>(5)]), nullptr, 0, nullptr, 0);
#if PROBE_REP == 18
    PH_PREP(18, 2, nullptr, (G == 256 ? (const float*)nullptr : a.in[c_in<2>(5)]), nullptr, 0, nullptr, 0);
#endif
    PH_PROJ(19, 24, 6144, -1, nullptr, 8, 16, a.in[32], PROJTAIL_L(2, 128));
#if PROBE_REP == 19
    PH_PROJ(19, 24, 6144, -1, nullptr, 8, 16, a.in[32], PROJTAIL_L(2, 128));
#endif
    if (IN(21)) { diff_attn_phase(p_BIG, (bf16_t*)(p_ws + WS_GX), p_OB, a.in[31], a.in[32], p_rope, a.in[33], a.in[34], a.in[35], a.in[36], a.in[37], (char*)lds_raw, G, bid); } SEAM(21);
#if PROBE_REP == 21
    if (IN(21)) { diff_attn_phase(p_BIG, (bf16_t*)(p_ws + WS_GX), p_OB, a.in[31], a.in[32], p_rope, a.in[33], a.in[34], a.in[35], a.in[36], a.in[37], (char*)lds_raw, G, bid); } SEAM(21);
#endif
    PH_OUT(23, 2, 1, );
    PH_NORM2(24, 2, 1);
#if PROBE_REP == 24
    PH_NORM2(24, 2, 1);
#endif
    PH_FFN1(25, 2, 1);
#if PROBE_REP == 25
    PH_FFN1(25, 2, 1);
#endif
    PH_FFN2(26, 2, 1, );

    PH_PREP(27, 3, nullptr, nullptr, nullptr, 0, a.in[45], 1, 2);
#if PROBE_REP == 27
    PH_PREP(27, 3, nullptr, nullptr, nullptr, 0, a.in[45], 1, 2);
#endif
    if (IN(28)) { ProbF1 g{p_DFT1, p_HN, 512, DM, 512}; pg8::UOrder S; S.init(2, 8, 64, G, bid); EpiF1 E{p_BIG}; pg8::gemm_phase<ProbF1, EpiF1>(lds, g, S, E); } SEAM(28);
#if PROBE_REP == 28
    if (IN(28)) { ProbF1 g{p_DFT1, p_HN, 512, DM, 512}; pg8::UOrder S; S.init(2, 8, 64, G, bid); EpiF1 E{p_BIG}; pg8::gemm_phase<ProbF1, EpiF1>(lds, g, S, E); } SEAM(28);
#endif
    if (IN(29)) { ProbF2 g{p_DFT2, p_BIG, 4096, 4096, 2048}; pg8::UOrder S; S.init(4, 4, 16, G, bid); EpiF2P E{p_BIG + (size_t)64 * 1024 * 1024};
        pg8::gemm_phase<ProbF2, EpiF2P>(lds, g, S, E); fnet_nyquist(p_DFT2, p_BIG, p_OB, G, bid); fnet_row1024(p_BIG, p_OB, G, bid); } SEAM(29);
    if (IN(29)) { ProbF2 g{p_DFT2 + 2048, p_BIG + 2048, 4096, 4096, 2048}; pg8::UOrder S; S.init(4, 4, 16, G, bid); EpiF2Q E{p_BIG + (size_t)64 * 1024 * 1024, p_OB};
        pg8::gemm_phase<ProbF2, EpiF2Q>(lds, g, S, E); } SEAM(29);
    PH_OUT(30, 3, 1, );
    PH_NORM2(31, 3, 1);
#if PROBE_REP == 31
    PH_NORM2(31, 3, 1);
#endif
    PH_FFN1(32, 3, 1);
#if PROBE_REP == 32
    PH_FFN1(32, 3, 1);
#endif
    PH_FFN2(33, 3, 1, );
#if STAMP_A >= 0
    xcd_barrier(bar); STAMP_AT(33);
    if (bid == 0 && tid == 0) p_out[0] = (float)(tA1 - tA0) * 0.01f;
    if (bid == 1) { const float bv = STAMP_B >= 0 ? (float)(tB1 - tB0) * 0.001f : 50.f; for (int i = 1 + tid; i <= 1000000; i += 512) p_out[i] = bv; }
#endif
#undef IN
#undef SEAM
#undef p_ws
#undef p_modv
#undef p_rope
#undef p_DFT1
#undef p_DFT2
#undef p_Wf1
#undef p_Wf2
#undef p_Win
#undef p_Wout
#undef p_xh
#undef p_xhc
#undef p_HN
#undef p_OB
#undef p_BIG
#undef p_out
}

extern "C" void kernel_launch(void* const* d_in, const int* in_sizes, int n_in, void* d_out, int out_size, void* d_ws, size_t ws_size, hipStream_t stream) {
    static int grid = 0;
    if (grid == 0) {
        if (n_in != 49 || out_size != NLAT * DM || ws_size < WS_END) { fprintf(stderr, "kernel_launch: unexpected shapes: n_in %d out %d ws %zu (need >= %zu)\n", n_in, out_size, ws_size, (size_t)WS_END); grid = -1; return; }
        int dev = 0, cus = 0, per_cu = 0;
        if (hipGetDevice(&dev) != hipSuccess || hipDeviceGetAttribute(&cus, hipDeviceAttributeMultiprocessorCount, dev) != hipSuccess) { grid = -1; return; }
        if (hipFuncSetAttribute((const void*)fwd_kernel, hipFuncAttributeMaxDynamicSharedMemorySize, LDS_BYTES) != hipSuccess) { fprintf(stderr, "kernel_launch: hipFuncSetAttribute failed\n"); grid = -1; return; }
        if (hipOccupancyMaxActiveBlocksPerMultiprocessor(&per_cu, (const void*)fwd_kernel, 512, LDS_BYTES) != hipSuccess || per_cu < 1) { fprintf(stderr, "kernel_launch: occupancy query says %d\n", per_cu); }
        (void)hipGetLastError();
        grid = cus;
    }
    if (grid < 0) return;
    (void)hipMemsetAsync((char*)d_ws + WS_CTL, 0, CTL_ZERO_BYTES, stream);
    KArgs a{};
    for (int i = 0; i < 49; ++i) a.in[i] = (const float*)d_in[i];
    a.out = (float*)d_out; a.ws = (unsigned char*)d_ws;
#if N_LAUNCH_MODE == 1
    a.ph_lo = 0; a.ph_hi = NPH;
    hipLaunchKernelGGL(fwd_kernel, dim3(grid), dim3(512), LDS_BYTES, stream, a);
#else
    for (int k = 0; k < NPH; ++k) { a.ph_lo = k; a.ph_hi = k + 1; hipLaunchKernelGGL(fwd_kernel, dim3(grid), dim3(512), LDS_BYTES, stream, a); }
#endif
    const hipError_t le = hipPeekAtLastError();
    if (le != hipSuccess) fprintf(stderr, "kernel_launch: launch failed: %s\n", hipGetErrorName(le));
}
```

```cpp
#include <hip/hip_runtime.h>
#include <cstdio>
#include <cstdint>

#define LAS __attribute__((address_space(3)))
typedef unsigned short bf16_t;
typedef short bf16x8 __attribute__((ext_vector_type(8)));
typedef short s16x4 __attribute__((ext_vector_type(4)));
typedef float f32x4 __attribute__((ext_vector_type(4)));
typedef float f32x2 __attribute__((ext_vector_type(2)));
typedef float f32x16 __attribute__((ext_vector_type(16)));
typedef unsigned u32x4 __attribute__((ext_vector_type(4)));
typedef unsigned u32x2 __attribute__((ext_vector_type(2)));
typedef _Float16 f16x2 __attribute__((ext_vector_type(2)));

#ifndef N_LAUNCH_MODE
#define N_LAUNCH_MODE 1
#endif

constexpr int NB = 16, SEQ = 2048, DM = 2048, CTXL = 256, TPB = 2304  , NT = NB * TPB, FF = 5632;
constexpr int NLAT = NB * SEQ;
constexpr float NORM_EPS = 1e-6f;

constexpr size_t MiB = 1u << 20;
constexpr size_t WS_CTL = 0, CTL_ZERO_BYTES = 65536;
constexpr size_t WS_MODV = 1 * MiB;
constexpr size_t WS_ROPE = 5 * MiB;
constexpr size_t WS_DFT1 = 6 * MiB;
constexpr size_t WS_DFT2 = 7 * MiB;
constexpr size_t WS_W = 24 * MiB;
constexpr size_t W_FFN1 = WS_W, W_FFN2 = WS_W + 44 * MiB, W_IN = WS_W + 66 * MiB, W_OUT = WS_W + 91 * MiB;
constexpr size_t WS_XCTX = 128 * MiB;
constexpr size_t WS_HN = 160 * MiB;
constexpr size_t WS_O = 304 * MiB;
constexpr size_t WS_BIG = 448 * MiB;
constexpr size_t WS_GX = 880 * MiB;
constexpr size_t WS_KTT = WS_GX, WS_CMCL = WS_GX + 144 * MiB, WS_Z = WS_GX + 154 * MiB;
constexpr size_t WS_O32 = 1039 * MiB;
constexpr size_t WS_W3F1 = 1280 * MiB, WS_W3F2 = 128 * MiB;
constexpr size_t WS_XH = 1136 * MiB;
constexpr size_t WS_XHC = 1264 * MiB;
constexpr size_t WS_END = 1327 * MiB;

constexpr int RING_BYTES = 131072;
constexpr int LDS_BYTES = 147456;
constexpr int MISC_OFF = LDS_BYTES - 64;

__device__ __forceinline__ unsigned f2bf(float f) { unsigned u = __builtin_bit_cast(unsigned, f); return (u + 0x7fffu + ((u >> 16) & 1u)) >> 16; }
__device__ __forceinline__ unsigned pk2(float lo, float hi) { return f2bf(lo) | (f2bf(hi) << 16); }
__device__ __forceinline__ float bf2f(unsigned short b) { return __builtin_bit_cast(float, ((unsigned)b) << 16); }
__device__ __forceinline__ float bflo(unsigned w) { return __builtin_bit_cast(float, w << 16); }
__device__ __forceinline__ float bfhi(unsigned w) { return __builtin_bit_cast(float, w & 0xffff0000u); }
__device__ __forceinline__ unsigned cvt_pk_bf16(float lo, float hi) { unsigned r; asm volatile("v_cvt_pk_bf16_f32 %0, %1, %2" : "=v"(r) : "v"(lo), "v"(hi)); return r; }
__device__ __forceinline__ float wave_sum(float v) {
#pragma unroll
    for (int o = 1; o < 64; o <<= 1) v += __shfl_xor(v, o);
    return v;
}
__device__ __forceinline__ float siluf(float v) { return v * __builtin_amdgcn_rcpf(1.f + __expf(-v)); }
__device__ __forceinline__ int opaque_tid() { int t = threadIdx.x; asm volatile("" : "+v"(t)); return t; }
#define LDS_WAIT() asm volatile("s_waitcnt lgkmcnt(0)" ::: "memory")
#define VM_WAIT() asm volatile("s_waitcnt vmcnt(0)" ::: "memory")

#define XB_TMO      128
#define XB_XCNT(j)  (256  + 64 * (j))
#define XB_XSUB(j)  (1280 + 64 * (j))
#define XB_XGEN(j)  (2304 + 64 * (j))
#define XB_TOP      3328
#define XB_TOPGEN   3392
#define XCD_BAR_WORDS 3456
#define XB_SPIN_CAP (1u << 24)
__device__ __forceinline__ unsigned xb_ld(unsigned* p)              { return __hip_atomic_load(p, __ATOMIC_RELAXED, __HIP_MEMORY_SCOPE_AGENT); }
__device__ __forceinline__ unsigned xb_add(unsigned* p, unsigned v) { return __hip_atomic_fetch_add(p, v, __ATOMIC_RELAXED, __HIP_MEMORY_SCOPE_AGENT); }
__device__ __forceinline__ unsigned xb_xcc_id() { return (unsigned)__builtin_amdgcn_s_getreg((3 << 11) | 20) & 0xFu; }
#define XB_SPIN(cond, bar) do { unsigned _sp = 0; while (cond) { __builtin_amdgcn_s_sleep(1); \
    if ((++_sp & 255u) == 0u) { if (xb_ld(&(bar)[XB_TMO])) break; if (_sp > XB_SPIN_CAP) { atomicAdd(&(bar)[XB_TMO], 1u); break; } } } } while (0)
struct XcdBarrier { unsigned* bar; unsigned x; volatile LAS unsigned* st; };
__device__ __forceinline__ XcdBarrier xcd_barrier_post(unsigned* bar, volatile LAS unsigned* st) {
    XcdBarrier b; b.bar = bar; b.x = xb_xcc_id(); b.st = st;
    if (threadIdx.x == 0) (void)xb_add(&bar[XB_XCNT(b.x)], 1u);
    return b;
}
__device__ __forceinline__ void xcd_barrier_complete(unsigned* bar, unsigned x, unsigned& nloc, unsigned& nx) {
    const unsigned G = gridDim.x * gridDim.y * gridDim.z;
    unsigned sum, cnt, mine, sp = 0u;
    for (;;) {
        sum = 0u; cnt = 0u; mine = 0u;
#pragma unroll
        for (unsigned j = 0; j < 16; ++j) { const unsigned c = xb_ld(&bar[XB_XCNT(j)]); sum += c; cnt += (c > 0u) ? 1u : 0u; mine = (j == x) ? c : mine; }
        if (sum == G) break;
        __builtin_amdgcn_s_sleep(1);
        if ((++sp & 255u) == 0u) { if (xb_ld(&bar[XB_TMO])) break; if (sp > XB_SPIN_CAP) { atomicAdd(&bar[XB_TMO], 1u); break; } }
    }
    nloc = mine > 0u ? mine : 1u; nx = cnt > 0u ? cnt : 1u;
}
__device__ __forceinline__ void xcd_barrier(const XcdBarrier& b) {
    asm volatile("s_waitcnt vmcnt(0)" ::: "memory");
    __syncthreads();
    if (threadIdx.x == 0) {
        unsigned* bar = b.bar;
        __builtin_amdgcn_s_waitcnt(0);
        unsigned nloc = b.st[0], nx = b.st[1];
        if (nloc == 0u) { xcd_barrier_complete(bar, b.x, nloc, nx); b.st[0] = nloc; b.st[1] = nx; }
        const unsigned old = xb_add(&bar[XB_XSUB(b.x)], 1u);
        const unsigned gen = old / nloc;
        if (old + 1u == (gen + 1u) * nloc) {
            __builtin_amdgcn_fence(__ATOMIC_RELEASE, "agent");
            asm volatile("s_waitcnt vmcnt(0)" ::: "memory");
            const unsigned og = xb_add(&bar[XB_TOP], 1u);
            const unsigned tg = og / nx;
            if (og + 1u == (tg + 1u) * nx) xb_add(&bar[XB_TOPGEN], 1u);
            else XB_SPIN(xb_ld(&bar[XB_TOPGEN]) == tg, bar);
            __builtin_amdgcn_fence(__ATOMIC_ACQUIRE, "agent");
            xb_add(&bar[XB_XGEN(b.x)], 1u);
            asm volatile("s_waitcnt vmcnt(0)" ::: "memory");
        } else {
            XB_SPIN(xb_ld(&bar[XB_XGEN(b.x)]) == gen, bar);
            __builtin_amdgcn_fence(__ATOMIC_ACQUIRE, "agent");
            asm volatile("s_waitcnt vmcnt(0)" ::: "memory");
        }
    }
    __syncthreads();
}

namespace pg8 {
constexpr int BM = 256, BK = 64, HALF = 128, HTB = HALF * BK * 2, STAGE_BYTES = 8 * HTB, NXCD = 8, WGM = 8;
__host__ __device__ __forceinline__ int lds_byte(int r, int c) { const int st = (r >> 4) * 2 + (c >> 5), rr = r & 15, cc = c & 31, ob = rr * 64 + cc * 2; return st * 1024 + (ob ^ (((ob >> 9) & 1) << 5)); }
__host__ __device__ __forceinline__ void stage_rc(int b, int& R, int& C) { const int st = b / 1024, sb = b % 1024, swz = sb ^ (((sb >> 9) & 1) << 5); R = (st >> 1) * 16 + swz / 64; C = (st & 1) * 32 + (swz % 64) / 2; }
__host__ __device__ __forceinline__ int perm32(int rho) { const int n = rho >> 4, i = rho & 15; return 8 * (i >> 2) + 4 * n + (i & 3); }

struct Unit { int pm, pn, z; };
struct UOrder {
    int nM, nN, nZ, nwg, G, c, wgm, rev;
    __device__ __forceinline__ void init(int nM_, int nN_, int nZ_, int G_, int c_, int wgm_ = WGM, int rev_ = 0) { nM = nM_; nN = nN_; nZ = nZ_; nwg = nM_ * nN_ * nZ_; G = G_; c = c_; wgm = wgm_; rev = rev_; }
    __device__ __forceinline__ bool next(int i, Unit& u) const {
        const long L = (long)i * G + c; if (L >= nwg) return false;
        int wgid = (int)L; { const int q = nwg / NXCD, r = nwg % NXCD, xcd = wgid % NXCD, off = wgid / NXCD; wgid = (xcd < r ? xcd * (q + 1) : r * (q + 1) + (xcd - r) * q) + off; }
        if (rev) wgid = nwg - 1 - wgid;
        const int per = nM * nN; u.z = wgid / per; const int w2 = wgid - u.z * per;
        const int nig = wgm * nN, gid = w2 / nig, fm = gid * wgm, gsz = (nM - fm) < wgm ? (nM - fm) : wgm;
        u.pm = fm + ((w2 % nig) % gsz); u.pn = (w2 % nig) / gsz; return true;
    }
};

template <class Prob, class Epi>
__device__ __forceinline__ void gemm_phase(LAS unsigned char* lds, const Prob g, const UOrder& S, const Epi& E) {
    const int tid = opaque_tid(), wid = __builtin_amdgcn_readfirstlane(tid >> 6), lane = tid & 63, wr = wid >> 2, wc = wid & 3, fr = lane & 15, fq = lane >> 4;
    const int K = g.K, nt = K / BK;
    unsigned voffA[2], voffB[2];
#pragma unroll
    for (int i = 0; i < 2; ++i) { int R, C; stage_rc(tid * 16 + i * 8192, R, C); const int Rb = Epi::PERM ? ((R & ~31) + perm32(R & 31)) : R;
        voffA[i] = (unsigned)(R * g.lda + C) * 2u; voffB[i] = (unsigned)(Rb * g.ldb + C) * 2u; }
    const size_t kstep = (size_t)(BK * 2);
    const size_t hstepA = (size_t)HALF * g.lda * 2, hstepB = (size_t)HALF * g.ldb * 2;
    const unsigned ldsw = (unsigned)wid * 1024u;
    const int aoff = lds_byte(wr * 64 + fr, fq * 8), boff = lds_byte(wc * 32 + fr, fq * 8);
#define PG8_SA(b, h) (((b) * 2 + (h)) * HTB)
#define PG8_SB(b, h) ((4 + (b) * 2 + (h)) * HTB)
#define PG8_STAGE(bufoff, gbase, voff) do { _Pragma("unroll") for (int _i = 0; _i < 2; ++_i) \
        __builtin_amdgcn_global_load_lds((const unsigned*)((const char*)(gbase) + (voff)[_i]), (LAS unsigned*)(lds + (bufoff) + ldsw + _i * 8192), 16, 0, 0); } while (0)
#define PG8_LDA(dst, b, h) do { _Pragma("unroll") for (int m = 0; m < 4; ++m) _Pragma("unroll") for (int k = 0; k < 2; ++k) dst[m][k] = *(const LAS bf16x8*)(lds + PG8_SA(b, h) + aoff + m * 2048 + k * 1024); } while (0)
#define PG8_LDB(dst, b, h) do { _Pragma("unroll") for (int n = 0; n < 2; ++n) _Pragma("unroll") for (int k = 0; k < 2; ++k) dst[n][k] = *(const LAS bf16x8*)(lds + PG8_SB(b, h) + boff + n * 2048 + k * 1024); } while (0)
#define PG8_MMA(ai, bj, At, Bt) do { __builtin_amdgcn_s_setprio(1); _Pragma("unroll") for (int m = 0; m < 4; ++m) _Pragma("unroll") for (int n = 0; n < 2; ++n) _Pragma("unroll") for (int k = 0; k < 2; ++k) \
        acc[ai][bj][m][n] = __builtin_amdgcn_mfma_f32_16x16x32_bf16(Bt[n][k], At[m][k], acc[ai][bj][m][n], 0, 0, 0); __builtin_amdgcn_s_setprio(0); } while (0)
#define PG8_WAIT_V(n) asm volatile("s_waitcnt vmcnt(" #n ")" ::: "memory")
#define PG8_WAIT_L(n) asm volatile("s_waitcnt lgkmcnt(" #n ")" ::: "memory")
#define PG8_BAR __builtin_amdgcn_s_barrier()
#define PG8_SCHED __builtin_amdgcn_sched_barrier(0)
    Unit cur, nxt; int ui = 0;
    if (!S.next(0, cur)) return;
    f32x4 acc[2][2][4][2];
#pragma unroll
    for (int a = 0; a < 2; ++a)
#pragma unroll
        for (int b = 0; b < 2; ++b)
#pragma unroll
            for (int m = 0; m < 4; ++m)
#pragma unroll
                for (int n = 0; n < 2; ++n) acc[a][b][m][n] = (f32x4){0.f, 0.f, 0.f, 0.f};
    bf16x8 At[4][2], B0[2][2], B1[2][2];
    const char* cA = g.a_tile(cur); const char* cB = g.b_tile(cur);
    PG8_STAGE(PG8_SB(0, 0), cB, voffB); PG8_STAGE(PG8_SB(0, 1), cB + hstepB, voffB); PG8_STAGE(PG8_SA(0, 0), cA, voffA); PG8_STAGE(PG8_SA(0, 1), cA + hstepA, voffA);
    if (wr == 1) PG8_BAR;
    PG8_WAIT_V(2); PG8_BAR;
    PG8_STAGE(PG8_SB(1, 0), cB + kstep, voffB); PG8_STAGE(PG8_SA(1, 0), cA + kstep, voffA); PG8_STAGE(PG8_SB(1, 1), cB + hstepB + kstep, voffB);
    PG8_WAIT_V(6); PG8_BAR;
    for (;;) {
        const bool has_next = S.next(ui + 1, nxt);
        const char* nA = has_next ? g.a_tile(nxt) : cA; const char* nB = has_next ? g.b_tile(nxt) : cB;
        for (int t = 0; t < nt; t += 2) {
            const bool last = (t == nt - 2);
            const char* a1 = cA + (size_t)(t + 1) * kstep;
            const char* a2 = last ? nA : cA + (size_t)(t + 2) * kstep; const char* b2 = last ? nB : cB + (size_t)(t + 2) * kstep;
            const char* a3 = a2 + kstep; const char* b3 = b2 + kstep;
            PG8_LDB(B0, 0, 0); PG8_LDB(B1, 0, 1); PG8_SCHED; PG8_LDA(At, 0, 0); PG8_STAGE(PG8_SA(1, 1), a1 + hstepA, voffA);
            PG8_WAIT_V(8); PG8_WAIT_L(0); PG8_BAR; PG8_MMA(0, 0, At, B0); PG8_MMA(0, 1, At, B1); PG8_BAR; PG8_SCHED;
            PG8_LDA(At, 0, 1); PG8_STAGE(PG8_SB(0, 0), b2, voffB); PG8_STAGE(PG8_SB(0, 1), b2 + hstepB, voffB); PG8_STAGE(PG8_SA(0, 0), a2, voffA);
            PG8_WAIT_V(8); PG8_WAIT_L(0); PG8_BAR; PG8_MMA(1, 0, At, B0); PG8_MMA(1, 1, At, B1); PG8_BAR; PG8_SCHED;
            PG8_LDB(B0, 1, 0); PG8_LDB(B1, 1, 1); PG8_SCHED; PG8_LDA(At, 1, 0); PG8_STAGE(PG8_SA(0, 1), a2 + hstepA, voffA);
            PG8_WAIT_V(8); PG8_WAIT_L(0); PG8_BAR; PG8_MMA(0, 0, At, B0); PG8_MMA(0, 1, At, B1); PG8_BAR; PG8_SCHED;
            PG8_LDA(At, 1, 1); PG8_STAGE(PG8_SB(1, 0), b3, voffB); PG8_STAGE(PG8_SB(1, 1), b3 + hstepB, voffB); PG8_STAGE(PG8_SA(1, 0), a3, voffA);
            PG8_WAIT_V(8); PG8_WAIT_L(0); PG8_BAR; PG8_MMA(1, 0, At, B0); PG8_MMA(1, 1, At, B1); PG8_BAR; PG8_SCHED;
        }
        if (wr == 0) PG8_BAR;
        E(acc, cur, wr, wc, fr, fq);
        if (!has_next) break;
#pragma unroll
        for (int a = 0; a < 2; ++a)
#pragma unroll
            for (int b = 0; b < 2; ++b)
#pragma unroll
                for (int m = 0; m < 4; ++m)
#pragma unroll
                    for (int n = 0; n < 2; ++n) acc[a][b][m][n] = (f32x4){0.f, 0.f, 0.f, 0.f};
        cur = nxt; cA = nA; cB = nB; ++ui;
        if (wr == 1) PG8_BAR;
    }
    PG8_WAIT_V(0);
    PG8_BAR;
#undef PG8_SA
#undef PG8_SB
#undef PG8_STAGE
#undef PG8_LDA
#undef PG8_LDB
#undef PG8_MMA
#undef PG8_WAIT_V
#undef PG8_WAIT_L
#undef PG8_BAR
#undef PG8_SCHED
}
}
using pg8::Unit;

__device__ __forceinline__ int row_tile(int pm, int amap) { return amap ? 9 * (pm >> 3) + 1 + (pm & 7) : pm; }

struct ProbStd {
    const bf16_t* A; const bf16_t* Bt; int lda, ldb, K, amap;
    __device__ __forceinline__ const char* a_tile(const Unit& u) const { return (const char*)(A + (size_t)row_tile(u.pm, amap) * 256 * lda); }
    __device__ __forceinline__ const char* b_tile(const Unit& u) const { return (const char*)(Bt + (size_t)u.pn * 256 * ldb); }
};
struct ProbF1 {
    const bf16_t* A; const bf16_t* HN; int lda, ldb, K;
    __device__ __forceinline__ const char* a_tile(const Unit& u) const { return (const char*)(A + (size_t)u.pm * 256 * 512); }
    __device__ __forceinline__ const char* b_tile(const Unit& u) const { return (const char*)(HN + ((size_t)(u.z >> 2) * TPB + CTXL + (size_t)u.pn * 256) * DM + (u.z & 3) * 512); }
};
struct ProbF2 {
    const bf16_t* A; const bf16_t* UVT; int lda, ldb, K; static constexpr int akstep = 128;
    __device__ __forceinline__ const char* a_tile(const Unit& u) const { return (const char*)(A + (size_t)u.pm * 256 * 4096); }
    __device__ __forceinline__ const char* b_tile(const Unit& u) const { return (const char*)(UVT + ((size_t)u.z * 1024 + (size_t)u.pn * 256) * 4096); }
};

__device__ __forceinline__ void store_tile_bf16(const f32x4 (&acc)[2][2][4][2], bf16_t* base, size_t ldc, int wr, int wc, int fr, int fq) {
#pragma unroll
    for (int ai = 0; ai < 2; ++ai)
#pragma unroll
        for (int m = 0; m < 4; ++m) { bf16_t* rowp = base + (size_t)(ai * 128 + wr * 64 + m * 16 + fr) * ldc + wc * 32 + 8 * fq;
#pragma unroll
            for (int bj = 0; bj < 2; ++bj) { const f32x4 v0 = acc[ai][bj][m][0], v1 = acc[ai][bj][m][1];
                u32x4 w; w.x = cvt_pk_bf16(v0[0], v0[1]); w.y = cvt_pk_bf16(v0[2], v0[3]); w.z = cvt_pk_bf16(v1[0], v1[1]); w.w = cvt_pk_bf16(v1[2], v1[3]);
                *(u32x4*)(rowp + bj * 128) = w; } }
}
struct EpiProj {
    static constexpr bool PERM = true;
    bf16_t* O; int ldc; int zt; float* Z; int k_lo, k_hi; const float* kn; const f32x2* rope;
    __device__ __forceinline__ void operator()(const f32x4 (&acc)[2][2][4][2], const Unit& u, int wr, int wc, int fr, int fq) const {
        if (u.pn == zt) {
            if (wc == 0) {
#pragma unroll
                for (int ai = 0; ai < 2; ++ai)
#pragma unroll
                    for (int m = 0; m < 4; ++m) { float* zp = Z + (size_t)(u.pm * 256 + ai * 128 + wr * 64 + m * 16 + fr) * 32 + 8 * fq;
                        *(f32x4*)zp = acc[ai][0][m][0]; *(f32x4*)(zp + 4) = acc[ai][0][m][1]; }
            }
            return;
        }
        bf16_t* tb = O + (size_t)u.pm * 256 * ldc + (size_t)u.pn * 256;
        store_tile_bf16(acc, tb, (size_t)ldc, wr, wc, fr, fq);
        if (u.pn >= k_lo && u.pn < k_hi) {
            asm volatile("s_waitcnt vmcnt(0)" ::: "memory"); __builtin_amdgcn_s_barrier(); asm volatile("" ::: "memory");
            int ln_ = fq * 16 + fr; asm volatile("" : "+v"(ln_));
            const int wid = wr * 4 + wc, li = ln_ & 15, sub = ln_ >> 4, quarter = li >> 2;
            const float* gp = kn + 8 * li; const f32x4 g0 = *(const f32x4*)gp, g1 = *(const f32x4*)(gp + 4);
#pragma unroll 1
            for (int s0 = 0; s0 < 16; s0 += 4) {
                u32x4 w[4]; bf16_t* pp[4]; int tt[4];
#pragma unroll
                for (int i = 0; i < 4; ++i) { const int item = wid * 64 + (s0 + i) * 4 + sub, row = item >> 1, hd = item & 1;
                    pp[i] = tb + (size_t)row * ldc + hd * 128 + 8 * li; w[i] = *(const u32x4*)pp[i]; tt[i] = (u.pm * 256 + row) % TPB; }
#pragma unroll
                for (int i = 0; i < 4; ++i) {
                    float x[8] = {bflo(w[i].x), bfhi(w[i].x), bflo(w[i].y), bfhi(w[i].y), bflo(w[i].z), bfhi(w[i].z), bflo(w[i].w), bfhi(w[i].w)};
                    float ss = 0.f;
#pragma unroll
                    for (int e = 0; e < 8; ++e) ss += x[e] * x[e];
                    ss += __shfl_xor(ss, 1); ss += __shfl_xor(ss, 2); ss += __shfl_xor(ss, 4); ss += __shfl_xor(ss, 8);
                    const float rstd = 1.0f / sqrtf(ss * (1.f / 128.f) + NORM_EPS);
                    x[0] *= rstd * g0.x; x[1] *= rstd * g0.y; x[2] *= rstd * g0.z; x[3] *= rstd * g0.w;
                    x[4] *= rstd * g1.x; x[5] *= rstd * g1.y; x[6] *= rstd * g1.z; x[7] *= rstd * g1.w;
                    if (tt[i] >= CTXL) {
                        const f32x2* rp = rope + (size_t)(tt[i] - CTXL) * 64 + (quarter >> 1) * 32 + (li & 3) * 8;
                        const float sgn = (quarter & 1) ? 1.f : -1.f;
#pragma unroll
                        for (int e = 0; e < 8; ++e) { const f32x2 cs = rp[e]; const float pv = __shfl_xor(x[e], 4); x[e] = x[e] * cs.x + sgn * pv * cs.y; }
                    }
                    u32x4 o; o.x = cvt_pk_bf16(x[0], x[1]); o.y = cvt_pk_bf16(x[2], x[3]); o.z = cvt_pk_bf16(x[4], x[5]); o.w = cvt_pk_bf16(x[6], x[7]);
                    *(u32x4*)pp[i] = o;
                }
            }
        }
    }
};
struct EpiF1 {
    static constexpr bool PERM = true;
    bf16_t* UVT;
    __device__ __forceinline__ void operator()(const f32x4 (&acc)[2][2][4][2], const Unit& u, int wr, int wc, int fr, int fq) const {
        bf16_t* base = UVT + ((size_t)(u.z >> 2) * 1024 + (u.z & 3) * 256) * 4096 + (size_t)u.pm * 2048 + (size_t)u.pn * 256;
        store_tile_bf16(acc, base, 4096, wr, wc, fr, fq);
    }
};
struct EpiF2P {
    static constexpr bool PERM = true;
    bf16_t* P;
    __device__ __forceinline__ void operator()(const f32x4 (&acc)[2][2][4][2], const Unit& u, int wr, int wc, int fr, int fq) const {
        store_tile_bf16(acc, P + ((size_t)u.z * 1024 + (size_t)u.pm * 256) * 1024 + (size_t)u.pn * 256, 1024, wr, wc, fr, fq);
    }
};
struct EpiF2Q {
    static constexpr bool PERM = true;
    const bf16_t* P; bf16_t* O;
    __device__ __forceinline__ void store_mirror(bf16_t* om, const u32x4& y, bool t0) const {
        if (!t0) *(u32x4*)om = y;
        else { om[1] = (bf16_t)(y.x >> 16); *(unsigned*)(om + 2) = y.y; *(unsigned*)(om + 4) = y.z; *(unsigned*)(om + 6) = y.w; }
    }
    __device__ __forceinline__ void operator()(const f32x4 (&acc)[2][2][4][2], const Unit& u, int wr, int wc, int fr, int fq) const {
        const bf16_t* pb = P + ((size_t)u.z * 1024 + (size_t)u.pm * 256) * 1024 + (size_t)u.pn * 256 + wc * 32 + 8 * fq;
        bf16_t* ob = O + ((size_t)u.z * TPB + CTXL) * DM + (size_t)u.pn * 512 + wc * 32 + 8 * fq;
#pragma unroll
        for (int ai = 0; ai < 2; ++ai)
#pragma unroll
            for (int m = 0; m < 4; ++m) { const int row = ai * 128 + wr * 64 + m * 16 + fr, lp = u.pm * 256 + row;
                u32x4 pw[2];
#pragma unroll
                for (int bj = 0; bj < 2; ++bj) pw[bj] = *(const u32x4*)(pb + (size_t)row * 1024 + bj * 128);
#pragma unroll
                for (int bj = 0; bj < 2; ++bj) { const f32x4 q0 = acc[ai][bj][m][0], q1 = acc[ai][bj][m][1];
                    const float p[8] = {bflo(pw[bj].x), bfhi(pw[bj].x), bflo(pw[bj].y), bfhi(pw[bj].y), bflo(pw[bj].z), bfhi(pw[bj].z), bflo(pw[bj].w), bfhi(pw[bj].w)};
                    const bool t0 = (bj == 0) && (wc == 0) && (fq == 0);
                    u32x4 yd, ym;
                    yd.x = cvt_pk_bf16(t0 ? p[0] : p[0] + q0[0], p[1] + q0[1]); yd.y = cvt_pk_bf16(p[2] + q0[2], p[3] + q0[3]);
                    yd.z = cvt_pk_bf16(p[4] + q1[0], p[5] + q1[1]); yd.w = cvt_pk_bf16(p[6] + q1[2], p[7] + q1[3]);
                    ym.x = cvt_pk_bf16(t0 ? p[0] : p[0] - q0[0], p[1] - q0[1]); ym.y = cvt_pk_bf16(p[2] - q0[2], p[3] - q0[3]);
                    ym.z = cvt_pk_bf16(p[4] - q1[0], p[5] - q1[1]); ym.w = cvt_pk_bf16(p[6] - q1[2], p[7] - q1[3]);
                    bf16_t* od = ob + (size_t)lp * DM + bj * 128;
                    *(u32x4*)od = yd; store_mirror(od + 256, ym, t0);
                    if (lp != 0) { bf16_t* o2 = ob + (size_t)(2048 - lp) * DM + bj * 128; *(u32x4*)o2 = ym; store_mirror(o2 + 256, yd, t0); }
                } }
    }
};
__device__ __forceinline__ f32x4 swiglu4(const f32x4 g, const f32x4 u) {
    const f32x4 t = g * -1.4426950408889634f;
    const f32x4 e = {__builtin_amdgcn_exp2f(t.x), __builtin_amdgcn_exp2f(t.y), __builtin_amdgcn_exp2f(t.z), __builtin_amdgcn_exp2f(t.w)};
    const f32x4 d = e + 1.0f;
    const f32x4 r = {__builtin_amdgcn_rcpf(d.x), __builtin_amdgcn_rcpf(d.y), __builtin_amdgcn_rcpf(d.z), __builtin_amdgcn_rcpf(d.w)};
    return (g * u) * r;
}
struct EpiSwiGLU {
    static constexpr bool PERM = true;
    bf16_t* H; int amap;
    __device__ __forceinline__ void operator()(const f32x4 (&acc)[2][2][4][2], const Unit& u, int wr, int wc, int fr, int fq) const {
        bf16_t* base = H + (size_t)row_tile(u.pm, amap) * 256 * FF + (size_t)u.pn * 128 + wc * 32 + 8 * fq;
#pragma unroll
        for (int ai = 0; ai < 2; ++ai)
#pragma unroll
            for (int m = 0; m < 4; ++m) { bf16_t* rowp = base + (size_t)(ai * 128 + wr * 64 + m * 16 + fr) * FF;
                const f32x4 g0 = acc[ai][0][m][0], g1 = acc[ai][0][m][1], u0 = acc[ai][1][m][0], u1 = acc[ai][1][m][1];
                const f32x4 s0 = swiglu4(g0, u0), s1 = swiglu4(g1, u1);
                u32x4 w; w.x = cvt_pk_bf16(s0.x, s0.y); w.y = cvt_pk_bf16(s0.z, s0.w); w.z = cvt_pk_bf16(s1.x, s1.y); w.w = cvt_pk_bf16(s1.z, s1.w);
                *(u32x4*)rowp = w; }
    }
};
__device__ __forceinline__ unsigned pk_f16(float a, float b) { const f16x2 p = {(_Float16)a, (_Float16)b}; return __builtin_bit_cast(unsigned, p); }
__device__ __forceinline__ float f16lo(unsigned u) { return (float)__builtin_bit_cast(f16x2, u).x; }
__device__ __forceinline__ float f16hi(unsigned u) { return (float)__builtin_bit_cast(f16x2, u).y; }
template <bool SRC16, bool DST16>
struct EpiResT {
    static constexpr bool PERM = false;
    const void* src_lat; const void* src_ctx; void* dst_lat; void* dst_ctx; const float* modv; int goff; int amap; LAS unsigned char* xl;
    __device__ __forceinline__ void operator()(const f32x4 (&acc)[2][2][4][2], const Unit& u, int wr, int wc, int fr, int fq) const {
        const int rt = row_tile(u.pm, amap & 1), b = rt / 9, j = rt - b * 9;
        const size_t eoff = (j == 0) ? (size_t)b * CTXL * DM : ((size_t)b * SEQ + (size_t)(j - 1) * 256) * DM;
        const char* sb = (const char*)(j == 0 ? src_ctx : src_lat) + eoff * (SRC16 ? 2 : 4);
        char* db = (char*)(j == 0 ? dst_ctx : dst_lat) + eoff * (DST16 ? 2 : 4);
        const float* gv = modv + (size_t)(j == 0 ? 16 : b) * 12288 + goff;
        const int lane = fq * 16 + fr;
        if constexpr (DST16) {
            const int scol = u.pn * 256 + wc * 32 + 4 * fq;
            f32x4 gt[2][2];
#pragma unroll
            for (int bj = 0; bj < 2; ++bj)
#pragma unroll
                for (int n = 0; n < 2; ++n) gt[bj][n] = *(const f32x4*)(gv + scol + bj * 128 + n * 16);
            const int prow = lane >> 2, pc = lane & 3; const bool nj = (pc & 2) != 0;
            const int addrA = ((((pc & 1) * 2) << 4) | prow) << 2, addrB = addrA + 64;
            const int dcol = u.pn * 256 + wc * 32 + 8 * pc;
            constexpr int MB = SRC16 ? 4 : 2;
#pragma unroll
            for (int ai = 0; ai < 2; ++ai)
#pragma unroll
              for (int m0 = 0; m0 < 4; m0 += MB) {
                u32x4 xb[MB][2]; f32x4 xfb[MB][2][2];
#pragma unroll
                for (int mm = 0; mm < MB; ++mm)
#pragma unroll
                    for (int bj = 0; bj < 2; ++bj) { const char* xp = sb + ((size_t)(ai * 128 + wr * 64 + (m0 + mm) * 16 + prow) * DM + dcol + bj * 128) * (SRC16 ? 2 : 4);
                        if constexpr (SRC16) xb[mm][bj] = *(const u32x4*)xp;
                        else { xfb[mm][bj][0] = *(const f32x4*)xp; xfb[mm][bj][1] = *(const f32x4*)(xp + 16); } }
#pragma unroll
                for (int mm = 0; mm < MB; ++mm) { const int m = m0 + mm; const size_t roff = (size_t)(ai * 128 + wr * 64 + m * 16 + prow) * DM + dcol;
                    u32x4 xh[2]; f32x4 xf[2][2];
#pragma unroll
                    for (int bj = 0; bj < 2; ++bj) {
                        if constexpr (SRC16) xh[bj] = xb[mm][bj];
                        else { xf[bj][0] = xfb[mm][bj][0]; xf[bj][1] = xfb[mm][bj][1]; } }
#pragma unroll
                    for (int bj = 0; bj < 2; ++bj) { unsigned P[2][2], o[4];
#pragma unroll
                        for (int n = 0; n < 2; ++n) { const f32x4 up = gt[bj][n] * acc[ai][bj][m][n]; P[n][0] = pk_f16(up.x, up.y); P[n][1] = pk_f16(up.z, up.w); }
#pragma unroll
                        for (int k = 0; k < 4; ++k) o[k] = 0u;
                        {
                            LAS unsigned char* xw = xl + (wr * 4 + wc) * 1280;
                            *(LAS u32x2*)(xw + fr * 80 + fq * 8) = (u32x2){P[0][0], P[0][1]}; *(LAS u32x2*)(xw + fr * 80 + 32 + fq * 8) = (u32x2){P[1][0], P[1][1]};
                            const u32x4 ov = *(const LAS u32x4*)(xw + prow * 80 + pc * 16); o[0] = ov.x; o[1] = ov.y; o[2] = ov.z; o[3] = ov.w; }
                        float x[8];
                        if constexpr (SRC16) { x[0] = f16lo(xh[bj].x); x[1] = f16hi(xh[bj].x); x[2] = f16lo(xh[bj].y); x[3] = f16hi(xh[bj].y); x[4] = f16lo(xh[bj].z); x[5] = f16hi(xh[bj].z); x[6] = f16lo(xh[bj].w); x[7] = f16hi(xh[bj].w); }
                        else { x[0] = xf[bj][0].x; x[1] = xf[bj][0].y; x[2] = xf[bj][0].z; x[3] = xf[bj][0].w; x[4] = xf[bj][1].x; x[5] = xf[bj][1].y; x[6] = xf[bj][1].z; x[7] = xf[bj][1].w; }
                        u32x4 w; w.x = pk_f16(x[0] + f16lo(o[0]), x[1] + f16hi(o[0])); w.y = pk_f16(x[2] + f16lo(o[1]), x[3] + f16hi(o[1]));
                        w.z = pk_f16(x[4] + f16lo(o[2]), x[5] + f16hi(o[2])); w.w = pk_f16(x[6] + f16lo(o[3]), x[7] + f16hi(o[3]));
                        *(u32x4*)(db + (roff + bj * 128) * 2) = w; }
                    asm volatile("" ::: "memory"); }
            }
        } else {
            const int prow = lane >> 3, pch = lane & 7, paddr = (((lane & 3) << 4) | (((lane >> 2) & 1) << 3) | prow) << 2;
            const bool lo = (fr & 8) == 0;
            const int col0 = u.pn * 256 + wc * 32 + 4 * pch;
            f32x4 gt[2];
#pragma unroll
            for (int bj = 0; bj < 2; ++bj) gt[bj] = *(const f32x4*)(gv + col0 + bj * 128);
#pragma unroll
            for (int ai = 0; ai < 2; ++ai)
#pragma unroll
                for (int m = 0; m < 4; ++m) { const size_t off = (size_t)(ai * 128 + wr * 64 + m * 16 + prow) * DM + col0;
                    f32x4 xs[2][2];
#pragma unroll
                    for (int bj = 0; bj < 2; ++bj)
#pragma unroll
                        for (int h = 0; h < 2; ++h) {
                            if constexpr (SRC16) { const u32x2 r = *(const u32x2*)(sb + (off + (size_t)h * 8 * DM + bj * 128) * 2); xs[bj][h] = (f32x4){f16lo(r.x), f16hi(r.x), f16lo(r.y), f16hi(r.y)}; }
                            else xs[bj][h] = *(const f32x4*)(sb + (off + (size_t)h * 8 * DM + bj * 128) * 4); }
#pragma unroll
                    for (int bj = 0; bj < 2; ++bj) { const f32x4 a0 = acc[ai][bj][m][0], a1 = acc[ai][bj][m][1]; f32x4 o0, o1;
#pragma unroll
                        for (int c = 0; c < 4; ++c) { const int send = __float_as_int(lo ? a1[c] : a0[c]);
                            const int recv = __builtin_amdgcn_mov_dpp(send, 0x128, 0xf, 0xf, false);
                            const int t0 = lo ? __float_as_int(a0[c]) : recv, t1 = lo ? recv : __float_as_int(a1[c]);
                            o0[c] = __int_as_float(__builtin_amdgcn_ds_bpermute(paddr, t0)); o1[c] = __int_as_float(__builtin_amdgcn_ds_bpermute(paddr, t1)); }
                        *(f32x4*)(db + (off + bj * 128) * 4) = xs[bj][0] + gt[bj] * o0; *(f32x4*)(db + (off + (size_t)8 * DM + bj * 128) * 4) = xs[bj][1] + gt[bj] * o1; }
                    asm volatile("" ::: "memory"); }
        }
    }
};

struct KArgs { const float* in[49]; float* out; unsigned char* ws; int ph_lo, ph_hi; };
__device__ __forceinline__ int idx_modw(int L) { return L == 0 ? 4 : L == 1 ? 17 : L == 2 ? 27 : 42; }
__device__ __forceinline__ int idx_norm2(int L) { return L == 0 ? 14 : L == 1 ? 24 : L == 2 ? 39 : 46; }

__device__ __forceinline__ void ph_prologue(const KArgs& a, LAS unsigned char* lds, int G, int bid) {
    const int tid = threadIdx.x, lane = tid & 63, wave = __builtin_amdgcn_readfirstlane(tid >> 6);
    LAS float* sl = (LAS float*)lds;
    LAS float* red = (LAS float*)(lds + 139264);
    float* modv = (float*)(a.ws + WS_MODV);
    {
        const float* c = a.in[1]; const float* cc = a.in[3];
        for (int i = tid; i < 17 * 2048; i += 512) { const float v = i < 16 * 2048 ? c[i] : cc[i - 16 * 2048]; sl[i] = v / (1.f + __expf(-v)); }
    }
    __syncthreads();
    for (int u = bid; u < 768; u += G) {
        const int L = u / 192, n0 = (u % 192) * 64;
        const float* W = a.in[idx_modw(L)]; const float* bias = a.in[idx_modw(L) + 1];
        float acc[17];
#pragma unroll
        for (int r = 0; r < 17; ++r) acc[r] = 0.f;
        const int k0 = wave * 256;
        const float* Wp = W + (size_t)k0 * 12288 + n0 + lane;
        float wv[16];
#pragma unroll
        for (int kk = 0; kk < 16; ++kk) wv[kk] = Wp[(size_t)kk * 12288];
        for (int k = 0; k < 256; k += 16) {
            float wn[16];
            const float* Wn = Wp + (size_t)(k + 16 < 256 ? k + 16 : k) * 12288;
#pragma unroll
            for (int kk = 0; kk < 16; ++kk) wn[kk] = Wn[(size_t)kk * 12288];
#pragma unroll
            for (int q = 0; q < 4; ++q)
#pragma unroll
                for (int r = 0; r < 17; ++r) { const f32x4 s4 = *(const LAS f32x4*)(sl + r * 2048 + k0 + k + 4 * q);
                    acc[r] += s4.x * wv[4 * q] + s4.y * wv[4 * q + 1] + s4.z * wv[4 * q + 2] + s4.w * wv[4 * q + 3]; }
#pragma unroll
            for (int kk = 0; kk < 16; ++kk) wv[kk] = wn[kk];
        }
        for (int w = 0; w < 8; ++w) {
            if (wave == w) {
#pragma unroll
                for (int r = 0; r < 17; ++r) red[r * 64 + lane] = (w == 0 ? 0.f : red[r * 64 + lane]) + acc[r];
            }
            __syncthreads();
        }
        for (int i = tid; i < 17 * 64; i += 512) { const int r = i >> 6, l = i & 63; modv[((size_t)L * 17 + r) * 12288 + n0 + l] = red[i] + bias[n0 + l]; }
        __syncthreads();
    }
    const size_t gt = (size_t)bid * 512 + tid, GT = (size_t)G * 512;
    {
        f32x2* rope = (f32x2*)(a.ws + WS_ROPE);
        for (size_t e = gt; e < 2048 * 64; e += GT) {
            const int p = (int)(e >> 6), i = (int)(e & 63), f = i & 31;
            const float inv = exp2f(-(float)(2 * f) * (13.287712379549449f / 64.f));
            const float ang = (float)(i < 32 ? (p >> 6) : (p & 63)) * inv;
            const float kf = rintf(ang * 0.15915494309189535f);
            float r = fmaf(-kf, 6.28318548202514648f, ang); r = fmaf(-kf, -1.7484556000744883e-7f, r);
            rope[e] = (f32x2){cosf(r), sinf(r)};
        }
    }
    {
        bf16_t* d1 = (bf16_t*)(a.ws + WS_DFT1);
        for (size_t e = gt; e < 512 * 512; e += GT) {
            const int m = (int)(e >> 9), k = (int)(e & 511), part = m >> 8, cp = m & 255;
            const int rr = (k * cp) & 511; const float rev = (float)rr * (1.f / 512.f);
            float v = part ? __builtin_amdgcn_sinf(rev) : __builtin_amdgcn_cosf(rev);
            if (m == 256) v = (k & 1) ? -1.f : 1.f;
            d1[e] = (bf16_t)f2bf(v * 0.044194173824159216f);
        }
        bf16_t* d2 = (bf16_t*)(a.ws + WS_DFT2);
        for (size_t e = gt; e < (size_t)2048 * 4096; e += GT) {
            const int lp = (int)(e >> 12), k = (int)(e & 4095), part = k >> 11, l = k & 2047;
            const int rr = (l * lp) & 2047; const float rev = (float)rr * (1.f / 2048.f);
            const float v = (part ? -__builtin_amdgcn_sinf(rev) : __builtin_amdgcn_cosf(rev)) * 0.022097086912079608f;
            d2[e] = (bf16_t)f2bf(v);
        }
    }
}

__device__ __forceinline__ void transpose_item(const float* W, int K, int N, bf16_t* WT, int mode, LAS unsigned* scr, int item, int lane) {
    const int nblk = (N + 63) / 64, kb = item / nblk, nb = item - kb * nblk, k0 = 64 * kb, n0 = 64 * nb;
    const int q = lane >> 4, c4 = (lane & 15) * 4;
    const bool ldok = n0 + c4 < N;
    f32x4 v[16];
#pragma unroll
    for (int i = 0; i < 16; ++i) { const int k = (i >> 1) * 8 + q * 2 + (i & 1); int ks = k0 + k;
        if (mode == 2) { const int pos = ks & 511; ks = (ks & ~511) + (pos <= 256 ? pos : 768 - pos); }
        v[i] = ldok ? *(const f32x4*)(W + (size_t)ks * N + n0 + c4) : (f32x4){0.f, 0.f, 0.f, 0.f}; }
#pragma unroll
    for (int j = 0; j < 8; ++j) { const int kd = j * 4 + q;
        scr[(c4 + 0) * 33 + kd] = cvt_pk_bf16(v[2 * j].x, v[2 * j + 1].x); scr[(c4 + 1) * 33 + kd] = cvt_pk_bf16(v[2 * j].y, v[2 * j + 1].y);
        scr[(c4 + 2) * 33 + kd] = cvt_pk_bf16(v[2 * j].z, v[2 * j + 1].z); scr[(c4 + 3) * 33 + kd] = cvt_pk_bf16(v[2 * j].w, v[2 * j + 1].w); }
    LDS_WAIT(); asm volatile("" ::: "memory");
    const int c = lane & 7;
#pragma unroll
    for (int j = 0; j < 8; ++j) { const int n = (lane >> 3) + 8 * j; const LAS unsigned* sp = scr + n * 33 + 4 * c;
        u32x4 o; o.x = sp[0]; o.y = sp[1]; o.z = sp[2]; o.w = sp[3];
        int drow = n0 + n;
        if (mode == 1) { const int part = drow >= FF ? 1 : 0, hid = drow - part * FF; drow = 256 * (hid >> 7) + 128 * part + (hid & 127); }
        if (n0 + n < N) *(u32x4*)(WT + (size_t)drow * K + k0 + 8 * c) = o; }
    LDS_WAIT(); asm volatile("" ::: "memory");
}
__device__ __forceinline__ void convert_layer(const KArgs& a, LAS unsigned char* lds, int gw, int NGW, const float* f_in, const float* f_out, const float* wi, int Nin, const float* wo, int wo_mode = 0, size_t sh1 = 0, size_t sh2 = 0) {
    const int tid = threadIdx.x, lane = tid & 63, wave = __builtin_amdgcn_readfirstlane(tid >> 6);
    LAS unsigned* scr = (LAS unsigned*)(lds + wave * 16384);
    const int I1 = f_in ? (DM / 64) * (2 * FF / 64) : 0, I2 = f_out ? (FF / 64) * (DM / 64) : 0, I3 = wi ? (DM / 64) * ((Nin + 63) / 64) : 0, I4 = wo ? (DM / 64) * (DM / 64) : 0;
    const int NI = I1 + I2 + I3 + I4;
    for (int it = gw; it < NI; it += NGW) {
        int r = it;
        if (r < I1) { transpose_item(f_in, DM, 2 * FF, (bf16_t*)(a.ws + W_FFN1 + sh1), 1, scr, r, lane); continue; } r -= I1;
        if (r < I2) { transpose_item(f_out, FF, DM, (bf16_t*)(a.ws + W_FFN2 + sh2), 0, scr, r, lane); continue; } r -= I2;
        if (r < I3) { transpose_item(wi, DM, Nin, (bf16_t*)(a.ws + W_IN), 0, scr, r, lane); continue; } r -= I3;
        transpose_item(wo, DM, DM, (bf16_t*)(a.ws + W_OUT), wo_mode, scr, r, lane);
    }
}

template <bool SRC16>
__device__ __forceinline__ void norm_phase(const void* lat, const void* ctx, const float* gain, const float* modvL, int shoff, int scoff, bf16_t* HN, int lat_only, int G, int bid,
                                           void* copy_lat = nullptr, void* copy_ctx = nullptr) {
    const int tid = threadIdx.x, lane = tid & 63, wave = __builtin_amdgcn_readfirstlane(tid >> 6);
    const int nunits = lat_only ? NLAT / 16 : NT / 16;
    for (int u = bid; u < nunits; u += G) {
        int r0;
        if (lat_only) { const int lr = u * 16, b = lr / SEQ; r0 = b * TPB + CTXL + (lr - b * SEQ); } else r0 = u * 16;
        const int ra = r0 + wave * 2;
        const int b = ra / TPB, t = ra - b * TPB;
        const size_t eoff = t < CTXL ? ((size_t)b * CTXL + t) * DM : ((size_t)b * SEQ + (t - CTXL)) * DM;
        const char* xa = (const char*)(t < CTXL ? ctx : lat) + eoff * (SRC16 ? 2 : 4);
        const float* mv = modvL + (size_t)(t < CTXL ? 16 : b) * 12288;
        f32x4 v[2][8]; float ss[2] = {0.f, 0.f};
        if constexpr (SRC16) {
            u32x4 raw[2][4];
#pragma unroll
            for (int rr = 0; rr < 2; ++rr)
#pragma unroll
                for (int j = 0; j < 4; ++j) raw[rr][j] = *(const u32x4*)(xa + ((size_t)rr * DM + 8 * lane + 512 * j) * 2);
#pragma unroll
            for (int rr = 0; rr < 2; ++rr)
#pragma unroll
                for (int j = 0; j < 4; ++j) { const u32x4 w = raw[rr][j];
                    v[rr][2 * j] = (f32x4){f16lo(w.x), f16hi(w.x), f16lo(w.y), f16hi(w.y)}; v[rr][2 * j + 1] = (f32x4){f16lo(w.z), f16hi(w.z), f16lo(w.w), f16hi(w.w)}; }
        } else {
#pragma unroll
            for (int rr = 0; rr < 2; ++rr)
#pragma unroll
                for (int j = 0; j < 8; ++j) v[rr][j] = *(const f32x4*)(xa + ((size_t)rr * DM + 4 * lane + 256 * j) * 4);
            if (copy_lat) { char* xc = (char*)(t < CTXL ? copy_ctx : copy_lat) + eoff * 2;
#pragma unroll
                for (int rr = 0; rr < 2; ++rr)
#pragma unroll
                    for (int j = 0; j < 8; ++j) { u32x2 w; w.x = pk_f16(v[rr][j].x, v[rr][j].y); w.y = pk_f16(v[rr][j].z, v[rr][j].w); *(u32x2*)(xc + ((size_t)rr * DM + 4 * lane + 256 * j) * 2) = w; } }
        }
#pragma unroll
        for (int rr = 0; rr < 2; ++rr)
#pragma unroll
            for (int j = 0; j < 8; ++j) ss[rr] += (v[rr][j].x * v[rr][j].x + v[rr][j].y * v[rr][j].y) + (v[rr][j].z * v[rr][j].z + v[rr][j].w * v[rr][j].w);
        const float rstd0 = 1.0f / sqrtf(wave_sum(ss[0]) * (1.f / DM) + NORM_EPS), rstd1 = 1.0f / sqrtf(wave_sum(ss[1]) * (1.f / DM) + NORM_EPS);
        bf16_t* orow = HN + (size_t)ra * DM;
#pragma unroll
        for (int j = 0; j < 8; ++j) {
            const int c = SRC16 ? (8 * lane + 512 * (j >> 1) + 4 * (j & 1)) : (4 * lane + 256 * j);
            const f32x4 g = *(const f32x4*)(gain + c), sc = *(const f32x4*)(mv + scoff + c), sh = *(const f32x4*)(mv + shoff + c);
            const f32x4 gs = g * (1.f + sc);
            const f32x4 o0 = v[0][j] * rstd0 * gs + sh, o1 = v[1][j] * rstd1 * gs + sh;
            u32x2 w0, w1; w0.x = cvt_pk_bf16(o0.x, o0.y); w0.y = cvt_pk_bf16(o0.z, o0.w); w1.x = cvt_pk_bf16(o1.x, o1.y); w1.y = cvt_pk_bf16(o1.z, o1.w);
            *(u32x2*)(orow + c) = w0; *(u32x2*)(orow + DM + c) = w1;
        }
    }
}

__device__ __forceinline__ void qknorm_rope_phase(bf16_t* P, int ld, int nh, const float* qn, const float* kn, const f32x2* rope, int G, int bid) {
    const int tid = threadIdx.x, lane = tid & 63, wave = __builtin_amdgcn_readfirstlane(tid >> 6);
    const int nq = (nh - 16) >> 2, sub = lane >> 4, li = lane & 15, quarter = li >> 2;
    const long total = (long)NT * nq, stride = (long)G * 8;
    constexpr int NI = 4;
    for (long id0 = (long)bid * 8 + wave; id0 < total; id0 += stride * NI) {
        u32x4 w[NI]; bf16_t* pp[NI]; int tt[NI], hh[NI]; bool ok[NI];
#pragma unroll
        for (int i = 0; i < NI; ++i) {
            const long id = id0 + stride * i; ok[i] = id < total; const long idc = ok[i] ? id : id0;
            const int r = (int)(idc / nq), quad = (int)(idc - (long)r * nq); hh[i] = 16 + quad * 4 + sub; tt[i] = r % TPB;
            pp[i] = P + (size_t)r * ld + hh[i] * 128 + 8 * li; w[i] = *(const u32x4*)pp[i];
        }
#pragma unroll
        for (int i = 0; i < NI; ++i) {
            float x[8] = {bflo(w[i].x), bfhi(w[i].x), bflo(w[i].y), bfhi(w[i].y), bflo(w[i].z), bfhi(w[i].z), bflo(w[i].w), bfhi(w[i].w)};
            float ss = 0.f;
#pragma unroll
            for (int e = 0; e < 8; ++e) ss += x[e] * x[e];
            ss += __shfl_xor(ss, 1); ss += __shfl_xor(ss, 2); ss += __shfl_xor(ss, 4); ss += __shfl_xor(ss, 8);
            const float rstd = 1.0f / sqrtf(ss * (1.f / 128.f) + NORM_EPS);
            const float* gp = (hh[i] < 16 ? qn : kn) + 8 * li;
            const f32x4 g0 = *(const f32x4*)gp, g1 = *(const f32x4*)(gp + 4);
            x[0] *= rstd * g0.x; x[1] *= rstd * g0.y; x[2] *= rstd * g0.z; x[3] *= rstd * g0.w;
            x[4] *= rstd * g1.x; x[5] *= rstd * g1.y; x[6] *= rstd * g1.z; x[7] *= rstd * g1.w;
            if (tt[i] >= CTXL) {
                const f32x2* rp = rope + (size_t)(tt[i] - CTXL) * 64 + (quarter >> 1) * 32 + (li & 3) * 8;
                const float sgn = (quarter & 1) ? 1.f : -1.f;
#pragma unroll
                for (int e = 0; e < 8; ++e) { const f32x2 cs = rp[e]; const float pv = __shfl_xor(x[e], 4); x[e] = x[e] * cs.x + sgn * pv * cs.y; }
            }
            u32x4 o; o.x = cvt_pk_bf16(x[0], x[1]); o.y = cvt_pk_bf16(x[2], x[3]); o.z = cvt_pk_bf16(x[4], x[5]); o.w = cvt_pk_bf16(x[6], x[7]);
            if (ok[i]) *(u32x4*)pp[i] = o;
        }
    }
}

namespace att {
constexpr int D = 128, NW = 8, QBLK = 32, KVBLK = 64;
constexpr float SCALE = 0.088388347648318440f;
constexpr float THR = 8.f;
constexpr size_t SHM_V = KVBLK * D * 2, SHM_K = KVBLK * D * 2, SHM_ATTN = 2 * SHM_V + 2 * SHM_K + NW * 64 * 4;
#define KSWZ(row, colB) ((row) * 256 + ((colB) ^ (((row) & 7) << 4)))
#define SBAR() __builtin_amdgcn_sched_barrier(0)
__device__ __forceinline__ int crow(int r, int hi) { return (r & 3) + 8 * (r >> 2) + 4 * hi; }
template <bool SUB> __device__ __forceinline__ void partialSM(f32x16& p0, f32x16& p1, float rsub) {
  if constexpr (SUB) { for (int r = 0; r < 16; ++r) p0[r] -= rsub; for (int r = 0; r < 16; ++r) p1[r] -= rsub; }
  for (int r = 0; r < 16; ++r) p0[r] = __builtin_amdgcn_exp2f(p0[r]);
}
__device__ __forceinline__ void finishSM(f32x16& p0, f32x16& p1, float& l_reg, bf16x8& pa0, bf16x8& pa1, bf16x8& pa2, bf16x8& pa3) {
  for (int r = 0; r < 16; ++r) p1[r] = __builtin_amdgcn_exp2f(p1[r]);
  float ps = 0; for (int r = 0; r < 16; ++r) ps += p0[r]; for (int r = 0; r < 16; ++r) ps += p1[r];
  { auto rr = __builtin_amdgcn_permlane32_swap(__float_as_uint(ps), __float_as_uint(ps), false, false);
    ps = __uint_as_float(rr[0]) + __uint_as_float(rr[1]); }
  l_reg += ps;
#define PK4(P, BASE, OUT) do { unsigned a0 = cvt_pk_bf16(P[BASE + 0], P[BASE + 1]), a1 = cvt_pk_bf16(P[BASE + 2], P[BASE + 3]);   \
    unsigned b0 = cvt_pk_bf16(P[BASE + 4], P[BASE + 5]), b1 = cvt_pk_bf16(P[BASE + 6], P[BASE + 7]);                              \
    auto r0 = __builtin_amdgcn_permlane32_swap(a0, b0, false, false); auto r1 = __builtin_amdgcn_permlane32_swap(a1, b1, false, false); \
    u32x4 w = {r0[0], r1[0], r0[1], r1[1]}; OUT = *reinterpret_cast<bf16x8*>(&w); } while (0)
  PK4(p0, 0, pa0); PK4(p0, 8, pa1); PK4(p1, 0, pa2); PK4(p1, 8, pa3);
#undef PK4
}
__device__ __forceinline__ void qkt(f32x16& p0, f32x16& p1, const bf16_t* Ks, const bf16x8* qr, int r32, int hi) {
  p0 = f32x16{}; p1 = f32x16{};
  for (int d0 = 0; d0 < 8; ++d0) { int cb = (d0 * 16 + hi * 8) * 2;
    bf16x8 b0 = *reinterpret_cast<const bf16x8*>((const char*)Ks + KSWZ(r32, cb));
    bf16x8 b1 = *reinterpret_cast<const bf16x8*>((const char*)Ks + KSWZ(32 + r32, cb));
    p0 = __builtin_amdgcn_mfma_f32_32x32x16_bf16(b0, qr[d0], p0, 0, 0, 0);
    p1 = __builtin_amdgcn_mfma_f32_32x32x16_bf16(b1, qr[d0], p1, 0, 0, 0); }
}
__device__ __forceinline__ int v_st(int k, int c) { const int kk = (k & ~0xC) | ((k & 4) << 1) | ((k & 8) >> 1); return ((kk >> 3) * 4 + (c >> 5)) * 512 + ((kk & 7) * 32 + (c & 31)) * 2; }
__device__ __forceinline__ int v_rd_base(int lane) { return ((lane & 3) << 3) | (((lane >> 2) & 3) << 6) | (((lane >> 4) & 1) << 5) | (((lane >> 5) & 1) << 8); }
constexpr int v_rd_off(int d0, int ks, int half) { return d0 * 512 + ks * 4096 + half * 2048; }
template <int OFF> __device__ __forceinline__ s16x4 tr_read(int vb) {
  s16x4 r; asm volatile("ds_read_b64_tr_b16 %0, %1 offset:%2" : "=&v"(r) : "v"(vb), "i"(OFF) : "memory"); return r;
}
template <int D0> __device__ __forceinline__ void pv_one(f32x16& od, int vb, bf16x8 pa0, bf16x8 pa1, bf16x8 pa2, bf16x8 pa3) {
  const s16x4 l0 = tr_read<v_rd_off(D0, 0, 0)>(vb), h0 = tr_read<v_rd_off(D0, 0, 1)>(vb), l1 = tr_read<v_rd_off(D0, 1, 0)>(vb), h1 = tr_read<v_rd_off(D0, 1, 1)>(vb);
  const s16x4 l2 = tr_read<v_rd_off(D0, 2, 0)>(vb), h2 = tr_read<v_rd_off(D0, 2, 1)>(vb), l3 = tr_read<v_rd_off(D0, 3, 0)>(vb), h3 = tr_read<v_rd_off(D0, 3, 1)>(vb);
  asm volatile("s_waitcnt lgkmcnt(0)" ::: "memory"); SBAR();
#define PK(L, H) (bf16x8){L[0], L[1], L[2], L[3], H[0], H[1], H[2], H[3]}
  od = __builtin_amdgcn_mfma_f32_32x32x16_bf16(pa0, PK(l0, h0), od, 0, 0, 0);
  od = __builtin_amdgcn_mfma_f32_32x32x16_bf16(pa1, PK(l1, h1), od, 0, 0, 0);
  od = __builtin_amdgcn_mfma_f32_32x32x16_bf16(pa2, PK(l2, h2), od, 0, 0, 0);
  od = __builtin_amdgcn_mfma_f32_32x32x16_bf16(pa3, PK(l3, h3), od, 0, 0, 0);
#undef PK
}
__device__ __forceinline__ void pv_d0(f32x16* o, int vb, bf16x8 pa0, bf16x8 pa1, bf16x8 pa2, bf16x8 pa3) {
  pv_one<0>(o[0], vb, pa0, pa1, pa2, pa3); pv_one<1>(o[1], vb, pa0, pa1, pa2, pa3); pv_one<2>(o[2], vb, pa0, pa1, pa2, pa3); pv_one<3>(o[3], vb, pa0, pa1, pa2, pa3);
}
__device__ __forceinline__ void q_norm_rope(bf16x8 (&qr)[8], const float* __restrict__ qn, const f32x2* __restrict__ rope, int pos, int hi_) {
  int hi = hi_; asm volatile("" : "+v"(hi));
  float x[8][8]; float ss = 0.f;
#pragma unroll
  for (int d0 = 0; d0 < 8; ++d0) { const u32x4 w = __builtin_bit_cast(u32x4, qr[d0]);
    x[d0][0] = bflo(w.x); x[d0][1] = bfhi(w.x); x[d0][2] = bflo(w.y); x[d0][3] = bfhi(w.y); x[d0][4] = bflo(w.z); x[d0][5] = bfhi(w.z); x[d0][6] = bflo(w.w); x[d0][7] = bfhi(w.w);
#pragma unroll
    for (int j = 0; j < 8; ++j) ss += x[d0][j] * x[d0][j]; }
  ss += __shfl_xor(ss, 32);
  const float rstd = (SCALE * 1.4426950408889634f) / sqrtf(ss * (1.f / 128.f) + NORM_EPS);
#pragma unroll
  for (int d0 = 0; d0 < 8; ++d0) { const float* gp = qn + d0 * 16 + hi * 8; const f32x4 g0 = *(const f32x4*)gp, g1 = *(const f32x4*)(gp + 4);
    x[d0][0] *= rstd * g0.x; x[d0][1] *= rstd * g0.y; x[d0][2] *= rstd * g0.z; x[d0][3] *= rstd * g0.w;
    x[d0][4] *= rstd * g1.x; x[d0][5] *= rstd * g1.y; x[d0][6] *= rstd * g1.z; x[d0][7] *= rstd * g1.w; }
  if (pos >= 0) {
#pragma unroll
    for (int hf = 0; hf < 2; ++hf)
#pragma unroll
      for (int e = 0; e < 2; ++e) { const int da = hf * 4 + e, db = da + 2; const f32x2* rp = rope + (size_t)pos * 64 + hf * 32 + e * 16 + hi * 8;
#pragma unroll
        for (int j = 0; j < 8; ++j) { const f32x2 cs = rp[j]; const float a = x[da][j], b = x[db][j]; x[da][j] = a * cs.x - b * cs.y; x[db][j] = b * cs.x + a * cs.y; } }
  }
#pragma unroll
  for (int d0 = 0; d0 < 8; ++d0) { u32x4 w; w.x = cvt_pk_bf16(x[d0][0], x[d0][1]); w.y = cvt_pk_bf16(x[d0][2], x[d0][3]); w.z = cvt_pk_bf16(x[d0][4], x[d0][5]); w.w = cvt_pk_bf16(x[d0][6], x[d0][7]);
    qr[d0] = __builtin_bit_cast(bf16x8, w); }
}
constexpr int OT_PITCH = 272, OT_BYTES = 32 * OT_PITCH;
template <int LDO>
__device__ __forceinline__ void store_o_tile(const f32x16 (&o)[4], const float (&rli)[16], char* tb, bf16_t* Ow, int lane) {
  const int r32 = lane & 31, hi = lane >> 5, odd = lane & 1;
#pragma unroll
  for (int d0 = 0; d0 < 4; ++d0)
#pragma unroll
    for (int q = 0; q < 8; ++q) {
      const unsigned ba = f2bf(o[d0][2 * q] * rli[2 * q]), bb = f2bf(o[d0][2 * q + 1] * rli[2 * q + 1]);
      const unsigned recv = (unsigned)__shfl_xor((int)(odd ? ba : bb), 1);
      const unsigned word = odd ? (recv | (bb << 16)) : (ba | (recv << 16));
      const int row = crow(2 * q + odd, hi);
      *(unsigned*)(tb + row * OT_PITCH + ((d0 * 32 + r32) >> 1) * 4) = word;
    }
  if (Ow == nullptr) return;
#pragma unroll
  for (int it = 0; it < 8; ++it) { const int idx = it * 64 + lane, row = idx >> 4, ch = idx & 15;
    *(u32x4*)(Ow + (long)row * LDO + ch * 8) = *(const u32x4*)(tb + row * OT_PITCH + ch * 16); }
}
template <int LDQ, int LDK, int LDO, bool SUB>
__device__ __forceinline__ void attn_dense_body(const bf16_t* __restrict__ Qb, const bf16_t* __restrict__ Kh, const bf16_t* __restrict__ Vh,
                                                bf16_t* __restrict__ Ob, int seq, float mfix, const float* __restrict__ qn, const f32x2* __restrict__ rope, int pos0, char* lds) {
  const int tid = opaque_tid(), wid = tid >> 6, lane = tid & 63, r32 = lane & 31, hi = lane >> 5;
  bf16_t* V_lds = (bf16_t*)lds; bf16_t* K_lds = (bf16_t*)(lds + 2 * SHM_V);
  float* ws = (float*)(lds + 2 * SHM_V + 2 * SHM_K) + wid * 64; float* li_l = ws;
  const float mnC = mfix * (SCALE * 1.4426950408889634f) - 80.f; float l_reg = 0; f32x16 o[4] = {}; bf16x8 qr[8];
  const bf16_t* Qw = Qb + (long)(wid * QBLK + r32) * LDQ + hi * 8;
#pragma unroll
  for (int d0 = 0; d0 < 8; ++d0) qr[d0] = *reinterpret_cast<const bf16x8*>(Qw + d0 * 16);
  q_norm_rope(qr, qn, rope, pos0 < 0 ? -1 : pos0 + wid * QBLK + r32, hi);
  SBAR();
  const int sr = tid >> 4, sc = (tid & 15) * 8, vst0 = v_st(sr, sc), vst1 = v_st(32 + sr, sc);
  const int vb0 = (int)(uintptr_t)V_lds + v_rd_base(lane);
  struct { bf16x8 vs0, vs1, ks0, ks1; } sr_[1];
  const unsigned goff0 = (unsigned)(sr * LDK + sc) * 2u, goff1 = (unsigned)((32 + sr) * LDK + sc) * 2u;
  const __amdgpu_buffer_rsrc_t rsK = __builtin_amdgcn_make_buffer_rsrc((void*)Kh, (short)0, seq * (LDK * 2), 0x00020000);
  const __amdgpu_buffer_rsrc_t rsV = __builtin_amdgcn_make_buffer_rsrc((void*)Vh, (short)0, seq * (LDK * 2), 0x00020000);
#define SLOAD(i, k0) do { const unsigned so_ = (unsigned)(k0) * (unsigned)(LDK * 2); \
    sr_[i].vs0 = __builtin_bit_cast(bf16x8, __builtin_amdgcn_raw_buffer_load_b128(rsV, goff0, so_, 0)); sr_[i].vs1 = __builtin_bit_cast(bf16x8, __builtin_amdgcn_raw_buffer_load_b128(rsV, goff1, so_, 0)); \
    sr_[i].ks0 = __builtin_bit_cast(bf16x8, __builtin_amdgcn_raw_buffer_load_b128(rsK, goff0, so_, 0)); sr_[i].ks1 = __builtin_bit_cast(bf16x8, __builtin_amdgcn_raw_buffer_load_b128(rsK, goff1, so_, 0)); } while (0)
#define SWRITE(b, i) do { *(bf16x8*)((char*)V_lds + (b) * SHM_V + vst0) = sr_[i].vs0;          \
    *(bf16x8*)((char*)V_lds + (b) * SHM_V + vst1) = sr_[i].vs1; int kc = sc * 2;               \
    *(bf16x8*)((char*)K_lds + (b) * SHM_K + KSWZ(sr, kc)) = sr_[i].ks0;                       \
    *(bf16x8*)((char*)K_lds + (b) * SHM_K + KSWZ(32 + sr, kc)) = sr_[i].ks1; } while (0)
#define SWAIT() asm volatile("s_waitcnt vmcnt(0)" ::: "memory")
  f32x16 pA0, pA1, pB0, pB1; bf16x8 pa0, pa1, pa2, pa3; const int NTL = seq / KVBLK;
  constexpr int SE = 0, SO = 0;
  SLOAD(SE, 0); asm volatile("s_waitcnt vmcnt(0)" ::: "memory"); SWRITE(0, SE); __syncthreads();
  qkt(pA0, pA1, K_lds, qr, r32, hi); partialSM<SUB>(pA0, pA1, mnC);
  SLOAD(SO, KVBLK);
  SWAIT(); SWRITE(1, SO); __syncthreads();
  for (int j = 1; j + 1 < NTL; j += 2) {
    SBAR(); qkt(pB0, pB1, (bf16_t*)((char*)K_lds + SHM_K), qr, r32, hi);
    finishSM(pA0, pA1, l_reg, pa0, pa1, pa2, pa3); SBAR();
    SLOAD(SO, (j + 1) * KVBLK); SBAR();
    pv_d0(o, vb0, pa0, pa1, pa2, pa3); partialSM<SUB>(pB0, pB1, mnC);
    __syncthreads(); SWAIT(); SWRITE(0, SE);
    __syncthreads();
    SBAR(); qkt(pA0, pA1, K_lds, qr, r32, hi);
    finishSM(pB0, pB1, l_reg, pa0, pa1, pa2, pa3); SBAR();
    SLOAD(SE, (j + 2) * KVBLK); SBAR();
    pv_d0(o, vb0 + (int)SHM_V, pa0, pa1, pa2, pa3); partialSM<SUB>(pA0, pA1, mnC);
    __syncthreads(); SWAIT(); SWRITE(1, SO);
    __syncthreads();
  }
  SBAR(); qkt(pB0, pB1, (bf16_t*)((char*)K_lds + SHM_K), qr, r32, hi);
  finishSM(pA0, pA1, l_reg, pa0, pa1, pa2, pa3); SBAR();
  pv_d0(o, vb0, pa0, pa1, pa2, pa3); partialSM<SUB>(pB0, pB1, mnC);
  __syncthreads();
  finishSM(pB0, pB1, l_reg, pa0, pa1, pa2, pa3); SBAR();
  pv_d0(o, vb0 + (int)SHM_V, pa0, pa1, pa2, pa3);
  if (hi == 0) li_l[r32] = l_reg; asm volatile("s_waitcnt lgkmcnt(0)" ::: "memory");
  float rli[16];
#pragma unroll
  for (int r = 0; r < 16; ++r) rli[r] = __builtin_amdgcn_rcpf(li_l[crow(r, hi)]);
  store_o_tile<LDO>(o, rli, lds + SHM_ATTN + wid * OT_BYTES, Ob + (long)(wid * QBLK) * LDO, lane);
  __syncthreads();
#undef SLOAD
#undef SWRITE
#undef SWAIT
}

constexpr int DF_K = 0, DF_V = 32768, DF_PX = 98304, DF_LI = 131072, DF_LDS = 131072 + 1024;
template <int LDK, int LDO, bool SUB>
__device__ __forceinline__ void attn_diff_body(const bf16_t* __restrict__ Qb, const bf16_t* __restrict__ Kh, const bf16_t* __restrict__ Vh,
                                               bf16_t* Ob, int seq, float mfix, const float* __restrict__ qn, const f32x2* __restrict__ rope, int pos0, char* lds,
                                               bool comb, bf16_t* Ofin, float lam, float oscale, const float* __restrict__ gain) {
  const int tid = opaque_tid(), wid = tid >> 6, lane = tid & 63, r32 = lane & 31, hi = lane >> 5, rg = wid & 3, half = wid >> 2;
  char* K_lds = lds + DF_K; char* V_lds = lds + DF_V; char* PXm = lds + DF_PX + wid * 4096; char* PXo = lds + DF_PX + (wid ^ 4) * 4096;
  float* li = (float*)(lds + DF_LI);
  const float mnC = mfix * (SCALE * 1.4426950408889634f) - 80.f; float l_reg = 0; f32x16 o[4] = {}; bf16x8 qr[8];
  const bf16_t* Qw = Qb + (long)(rg * QBLK + r32) * LDK + hi * 8;
#pragma unroll
  for (int d0 = 0; d0 < 8; ++d0) qr[d0] = *reinterpret_cast<const bf16x8*>(Qw + d0 * 16);
  q_norm_rope(qr, qn, rope, pos0 + rg * QBLK + r32, hi);
  const int sr = tid >> 4, sc = (tid & 15) * 8, vst0 = v_st(sr, sc), vst1 = v_st(32 + sr, sc), kc = sc * 2;
  const unsigned goff0 = (unsigned)(sr * LDK + sc) * 2u, goff1 = (unsigned)((32 + sr) * LDK + sc) * 2u;
  const __amdgpu_buffer_rsrc_t rsK = __builtin_amdgcn_make_buffer_rsrc((void*)Kh, (short)0, seq * (LDK * 2), 0x00020000);
  const __amdgpu_buffer_rsrc_t rsV = __builtin_amdgcn_make_buffer_rsrc((void*)Vh, (short)0, seq * (LDK * 2), 0x00020000);
  bf16x8 kr[2][2], vr[2][4];
#define DF_LDK(t0) do { _Pragma("unroll") for (int tt = 0; tt < 2; ++tt) { const unsigned so_ = (unsigned)(((t0) + tt) * KVBLK) * (unsigned)(LDK * 2); \
    kr[tt][0] = __builtin_bit_cast(bf16x8, __builtin_amdgcn_raw_buffer_load_b128(rsK, goff0, so_, 0)); kr[tt][1] = __builtin_bit_cast(bf16x8, __builtin_amdgcn_raw_buffer_load_b128(rsK, goff1, so_, 0)); } } while (0)
#define DF_LDV(t0) do { _Pragma("unroll") for (int tt = 0; tt < 2; ++tt) { const unsigned so_ = (unsigned)(((t0) + tt) * KVBLK) * (unsigned)(LDK * 2); \
    vr[tt][0] = __builtin_bit_cast(bf16x8, __builtin_amdgcn_raw_buffer_load_b128(rsV, goff0, so_, 0)); vr[tt][1] = __builtin_bit_cast(bf16x8, __builtin_amdgcn_raw_buffer_load_b128(rsV, goff1, so_, 0)); \
    vr[tt][2] = __builtin_bit_cast(bf16x8, __builtin_amdgcn_raw_buffer_load_b128(rsV, goff0 + 256u, so_, 0)); vr[tt][3] = __builtin_bit_cast(bf16x8, __builtin_amdgcn_raw_buffer_load_b128(rsV, goff1 + 256u, so_, 0)); } } while (0)
#define DF_WRK() do { _Pragma("unroll") for (int tt = 0; tt < 2; ++tt) { *(bf16x8*)(K_lds + tt * 16384 + KSWZ(sr, kc)) = kr[tt][0]; *(bf16x8*)(K_lds + tt * 16384 + KSWZ(32 + sr, kc)) = kr[tt][1]; } } while (0)
#define DF_WRV() do { _Pragma("unroll") for (int tt = 0; tt < 2; ++tt) { *(bf16x8*)(V_lds + tt * 32768 + vst0) = vr[tt][0]; *(bf16x8*)(V_lds + tt * 32768 + vst1) = vr[tt][1]; \
    *(bf16x8*)(V_lds + tt * 32768 + 16384 + vst0) = vr[tt][2]; *(bf16x8*)(V_lds + tt * 32768 + 16384 + vst1) = vr[tt][3]; } } while (0)
  const int NP = seq / (2 * KVBLK);
  const int vb = (int)(uintptr_t)V_lds + half * 16384 + v_rd_base(lane);
  DF_LDK(0); DF_LDV(0); DF_WRK(); DF_WRV(); __syncthreads();
  for (int p = 0; p < NP; ++p) {
    const bool more = p + 1 < NP;
    if (more) DF_LDK(2 * p + 2);
    SBAR();
    f32x16 p0, p1; bf16x8 pa0, pa1, pa2, pa3;
    qkt(p0, p1, (const bf16_t*)(K_lds + half * 16384), qr, r32, hi);
    partialSM<SUB>(p0, p1, mnC);
    finishSM(p0, p1, l_reg, pa0, pa1, pa2, pa3);
    *(bf16x8*)(PXm + lane * 16) = pa0; *(bf16x8*)(PXm + 1024 + lane * 16) = pa1; *(bf16x8*)(PXm + 2048 + lane * 16) = pa2; *(bf16x8*)(PXm + 3072 + lane * 16) = pa3;
    __syncthreads();
    if (more) { DF_WRK(); DF_LDV(2 * p + 2); }
    const bf16x8 po0 = *(const bf16x8*)(PXo + lane * 16), po1 = *(const bf16x8*)(PXo + 1024 + lane * 16), po2 = *(const bf16x8*)(PXo + 2048 + lane * 16), po3 = *(const bf16x8*)(PXo + 3072 + lane * 16);
    asm volatile("s_waitcnt lgkmcnt(0)" ::: "memory"); SBAR();
    if (half == 0) { pv_d0(o, vb, pa0, pa1, pa2, pa3); pv_d0(o, vb + 32768, po0, po1, po2, po3); }
    else           { pv_d0(o, vb, po0, po1, po2, po3); pv_d0(o, vb + 32768, pa0, pa1, pa2, pa3); }
    __syncthreads();
    if (more) DF_WRV();
  }
  if (hi == 0) li[wid * 32 + r32] = l_reg;
  __syncthreads();
  float rli[16];
#pragma unroll
  for (int r = 0; r < 16; ++r) rli[r] = __builtin_amdgcn_rcpf(li[wid * 32 + crow(r, hi)] + li[(wid ^ 4) * 32 + crow(r, hi)]);
  char* tb = V_lds + wid * OT_BYTES;
  bf16_t* Ow = Ob + (long)(rg * QBLK) * LDO + half * 128;
  if (!comb) store_o_tile<LDO>(o, rli, tb, Ow, lane);
  else {
    store_o_tile<LDO>(o, rli, tb, nullptr, lane);
    float* ss2 = (float*)(lds + DF_LI + 1024);
    const int ch = lane & 15, rq = lane >> 4;
    const bf16_t* O0w = Ow - 256;
    u32x4 o0[8]; float ssv[8];
#pragma unroll
    for (int it = 0; it < 8; ++it) o0[it] = *(const u32x4*)(O0w + (long)(it * 4 + rq) * LDO + ch * 8);
#pragma unroll
    for (int it = 0; it < 8; ++it) { const int row = it * 4 + rq; const u32x4 o1 = *(const u32x4*)(tb + row * OT_PITCH + ch * 16);
      const float x[8] = {bflo(o0[it].x) - lam * bflo(o1.x), bfhi(o0[it].x) - lam * bfhi(o1.x), bflo(o0[it].y) - lam * bflo(o1.y), bfhi(o0[it].y) - lam * bfhi(o1.y),
                          bflo(o0[it].z) - lam * bflo(o1.z), bfhi(o0[it].z) - lam * bfhi(o1.z), bflo(o0[it].w) - lam * bflo(o1.w), bfhi(o0[it].w) - lam * bfhi(o1.w)};
      float ss = 0.f;
#pragma unroll
      for (int e = 0; e < 8; ++e) ss += x[e] * x[e];
      ss += __shfl_xor(ss, 1); ss += __shfl_xor(ss, 2); ss += __shfl_xor(ss, 4); ss += __shfl_xor(ss, 8);
      ssv[it] = ss; if (ch == 0) ss2[wid * 32 + row] = ss; }
    __syncthreads();
    const f32x4 g0 = *(const f32x4*)(gain + half * 128 + ch * 8), g1 = *(const f32x4*)(gain + half * 128 + ch * 8 + 4);
    bf16_t* Of = Ofin + (long)(rg * QBLK) * DM + half * 128 + ch * 8;
#pragma unroll
    for (int it = 0; it < 8; ++it) { const int row = it * 4 + rq; const u32x4 o1 = *(const u32x4*)(tb + row * OT_PITCH + ch * 16);
      const float x[8] = {bflo(o0[it].x) - lam * bflo(o1.x), bfhi(o0[it].x) - lam * bfhi(o1.x), bflo(o0[it].y) - lam * bflo(o1.y), bfhi(o0[it].y) - lam * bfhi(o1.y),
                          bflo(o0[it].z) - lam * bflo(o1.z), bfhi(o0[it].z) - lam * bfhi(o1.z), bflo(o0[it].w) - lam * bflo(o1.w), bfhi(o0[it].w) - lam * bfhi(o1.w)};
      const float rs = oscale / sqrtf((ssv[it] + ss2[(wid ^ 4) * 32 + row]) * (1.f / 256.f) + NORM_EPS);
      u32x4 w; w.x = cvt_pk_bf16(x[0] * rs * g0.x, x[1] * rs * g0.y); w.y = cvt_pk_bf16(x[2] * rs * g0.z, x[3] * rs * g0.w);
      w.z = cvt_pk_bf16(x[4] * rs * g1.x, x[5] * rs * g1.y); w.w = cvt_pk_bf16(x[6] * rs * g1.z, x[7] * rs * g1.w);
      *(u32x4*)(Of + (long)row * DM) = w; }
  }
  __syncthreads();
#undef DF_LDK
#undef DF_LDV
#undef DF_WRK
#undef DF_WRV
}
}

__device__ __forceinline__ float qk_bound(const float* qn, const float* kn) {
    const int lane = threadIdx.x & 63;
    float a = fmaxf(fabsf(qn[lane]), fabsf(qn[lane + 64])), b = fmaxf(fabsf(kn[lane]), fabsf(kn[lane + 64]));
#pragma unroll
    for (int o = 1; o < 64; o <<= 1) { a = fmaxf(a, __shfl_xor(a, o)); b = fmaxf(b, __shfl_xor(b, o)); }
    return 128.f * 1.02f * a * b;
}
__device__ __forceinline__ void gqa_attn_phase(const bf16_t* P, bf16_t* O, const float* qn, const float* kn, const f32x2* rope, char* lds, int G, int bid) {
    constexpr int NBIG = 2048, NSMALL = 256;
    const float mfix = qk_bound(qn, kn);
    const bool sub = __builtin_amdgcn_readfirstlane((int)(mfix * (att::SCALE * 1.4426950408889634f) > 80.f)) != 0;
    for (int L = bid; L < NBIG + NSMALL; L += G) {
        int b, hq, q0, seq;
        if (L < NBIG) { const int xcd = L & 7, j = (L >> 3) & 31, rnd = L >> 8, bk = rnd * 8 + xcd; b = bk >> 2; const int kvh = bk & 3; hq = kvh * 4 + (j >> 3); q0 = CTXL + (j & 7) * 256; seq = TPB; }
        else { const int l2 = L - NBIG; b = l2 >> 4; hq = l2 & 15; q0 = 0; seq = CTXL; }
        const int kvh = hq >> 2;
        const bf16_t* base = P + (size_t)b * TPB * 3072;
        if (sub) att::attn_dense_body<3072, 3072, 2048, true>(base + (size_t)q0 * 3072 + hq * 128, base + 2048 + kvh * 128, base + 2560 + kvh * 128,
                                               O + ((size_t)b * TPB + q0) * DM + hq * 128, seq, mfix, qn, rope, q0 - CTXL, lds);
        else att::attn_dense_body<3072, 3072, 2048, false>(base + (size_t)q0 * 3072 + hq * 128, base + 2048 + kvh * 128, base + 2560 + kvh * 128,
                                               O + ((size_t)b * TPB + q0) * DM + hq * 128, seq, mfix, qn, rope, q0 - CTXL, lds);
    }
}
__device__ __forceinline__ void diff_attn_phase(const bf16_t* P, bf16_t* OD, bf16_t* O, const float* qn, const float* kn, const f32x2* rope,
                                                const float* lq1, const float* lk1, const float* lq2, const float* lk2, const float* gain, char* lds, int G, int bid) {
    const float mfix = qk_bound(qn, kn);
    const bool sub = __builtin_amdgcn_readfirstlane((int)(mfix * (att::SCALE * 1.4426950408889634f) > 80.f)) != 0;
    const int lane = threadIdx.x & 63;
    const float lam_init = 0.8f - 0.6f * 0.54881163609402643f;
    const float d1 = wave_sum(lq1[lane] * lk1[lane] + lq1[lane + 64] * lk1[lane + 64]);
    const float d2 = wave_sum(lq2[lane] * lk2[lane] + lq2[lane + 64] * lk2[lane + 64]);
    const float lam = expf(d1) - expf(d2) + lam_init, oscale = 1.f - lam_init;
    for (int L = bid; L < 2048; L += G) {
        const int xcd = L & 7, j = (L >> 3) & 31, rnd = L >> 8, bh = (rnd * 8 + xcd) * 2 + (j >> 4), b = bh >> 3, h = bh & 7, qb = j & 15;
        const bf16_t* base = P + (size_t)b * TPB * 6144;
        bf16_t* Of = O + ((size_t)b * TPB + CTXL + qb * 128) * DM + h * 256;
#pragma unroll 1
        for (int m = 0; m < 2; ++m) {
            if (sub) att::attn_diff_body<6144, 4096, true>(base + (size_t)(CTXL + qb * 128) * 6144 + (2 * h + m) * 128, base + 2048 + (2 * h + m) * 128, base + 4096 + h * 256,
                                        OD + ((size_t)b * SEQ + qb * 128) * 4096 + (2 * h + m) * 256, TPB, mfix, qn, rope, qb * 128, lds, m == 1, Of, lam, oscale, gain);
            else att::attn_diff_body<6144, 4096, false>(base + (size_t)(CTXL + qb * 128) * 6144 + (2 * h + m) * 128, base + 2048 + (2 * h + m) * 128, base + 4096 + h * 256,
                                        OD + ((size_t)b * SEQ + qb * 128) * 4096 + (2 * h + m) * 256, TPB, mfix, qn, rope, qb * 128, lds, m == 1, Of, lam, oscale, gain);
        }
    }
}
__device__ __forceinline__ void diff_combine_phase(const bf16_t* OD, bf16_t* O, const float* lq1, const float* lk1, const float* lq2, const float* lk2, const float* gain, int G, int bid) {
    const int tid = threadIdx.x, lane = tid & 63, wave = __builtin_amdgcn_readfirstlane(tid >> 6);
    const float lam_init = 0.8f - 0.6f * 0.54881163609402643f;
    const float d1 = wave_sum(lq1[lane] * lk1[lane] + lq1[lane + 64] * lk1[lane + 64]);
    const float d2 = wave_sum(lq2[lane] * lk2[lane] + lq2[lane + 64] * lk2[lane + 64]);
    const float lam = expf(d1) - expf(d2) + lam_init;
    const float oscale = 1.f - lam_init;
    const int sub = lane >> 5, li = lane & 31;
    const f32x4 g0 = *(const f32x4*)(gain + 8 * li), g1 = *(const f32x4*)(gain + 8 * li + 4);
    const long total = (long)NLAT * 4, stride = (long)G * 8;
    constexpr int NI = 4;
    for (long id0 = (long)bid * 8 + wave; id0 < total; id0 += stride * NI) {
        u32x4 a[NI], c[NI]; bf16_t* op[NI]; bool ok[NI];
#pragma unroll
        for (int i = 0; i < NI; ++i) { const long id = id0 + stride * i; ok[i] = id < total; const long idc = ok[i] ? id : id0;
            const int lr = (int)(idc >> 2), h = (int)(idc & 3) * 2 + sub;
            const bf16_t* p = OD + (size_t)lr * 4096 + (2 * h) * 256 + 8 * li; a[i] = *(const u32x4*)p; c[i] = *(const u32x4*)(p + 256);
            const int b = lr / SEQ, t = lr - b * SEQ; op[i] = O + ((size_t)b * TPB + CTXL + t) * DM + h * 256 + 8 * li; }
#pragma unroll
        for (int i = 0; i < NI; ++i) {
            float x[8] = {bflo(a[i].x) - lam * bflo(c[i].x), bfhi(a[i].x) - lam * bfhi(c[i].x), bflo(a[i].y) - lam * bflo(c[i].y), bfhi(a[i].y) - lam * bfhi(c[i].y),
                          bflo(a[i].z) - lam * bflo(c[i].z), bfhi(a[i].z) - lam * bfhi(c[i].z), bflo(a[i].w) - lam * bflo(c[i].w), bfhi(a[i].w) - lam * bfhi(c[i].w)};
            float ss = 0.f;
#pragma unroll
            for (int e = 0; e < 8; ++e) ss += x[e] * x[e];
            ss += __shfl_xor(ss, 1); ss += __shfl_xor(ss, 2); ss += __shfl_xor(ss, 4); ss += __shfl_xor(ss, 8); ss += __shfl_xor(ss, 16);
            const float rs = oscale / sqrtf(ss * (1.f / 256.f) + NORM_EPS);
            u32x4 o; o.x = cvt_pk_bf16(x[0] * rs * g0.x, x[1] * rs * g0.y); o.y = cvt_pk_bf16(x[2] * rs * g0.z, x[3] * rs * g0.w);
            o.z = cvt_pk_bf16(x[4] * rs * g1.x, x[5] * rs * g1.y); o.w = cvt_pk_bf16(x[6] * rs * g1.z, x[7] * rs * g1.w);
            if (ok[i]) *(u32x4*)op[i] = o;
        }
    }
}

__device__ __forceinline__ float logsigmoidf(float x) { return fminf(x, 0.f) - __logf(1.f + __expf(-fabsf(x))); }
constexpr int G1_ZS = 0, G1_HT = 8192, G1_MS = 12288, G1_QS = 21504, G1_KS = 55296, G1_VS = 21504;
template <int DIR>
__device__ __forceinline__ void gla_prep_dir(const bf16_t* P, const float* wg, const float* bg, bf16_t* QT, bf16_t* KTT, float* CM, float* CL, LAS unsigned char* lds,
                                             int b, int h, int c, int R0, const unsigned (&raw)[32], f32x4 (&accOut)[2]) {
    const int tid = opaque_tid(), lane = tid & 63, wave = __builtin_amdgcn_readfirstlane(tid >> 6), d = tid & 255, half = tid >> 8;
    LAS float* ZS = (LAS float*)(lds + G1_ZS); LAS float* HT = (LAS float*)(lds + G1_HT);
    LAS bf16_t* QS = (LAS bf16_t*)(lds + G1_QS); LAS bf16_t* KS = (LAS bf16_t*)(lds + G1_KS);
    float wcol[16];
#pragma unroll
    for (int kk = 0; kk < 16; ++kk) wcol[kk] = wg[kk * 1024 + 256 * h + d];
    const float bias = bg[256 * h + d];
    float cum[32];
#pragma unroll
    for (int ii = 0; ii < 32; ++ii) {
        const LAS float* zr = ZS + (half * 32 + ii) * 32 + DIR * 16;
        const f32x4 z0 = *(const LAS f32x4*)zr, z1 = *(const LAS f32x4*)(zr + 4), z2 = *(const LAS f32x4*)(zr + 8), z3 = *(const LAS f32x4*)(zr + 12);
        float x = bias;
        x += z0.x * wcol[0] + z0.y * wcol[1] + z0.z * wcol[2] + z0.w * wcol[3];
        x += z1.x * wcol[4] + z1.y * wcol[5] + z1.z * wcol[6] + z1.w * wcol[7];
        x += z2.x * wcol[8] + z2.y * wcol[9] + z2.z * wcol[10] + z2.w * wcol[11];
        x += z3.x * wcol[12] + z3.y * wcol[13] + z3.z * wcol[14] + z3.w * wcol[15];
        cum[ii] = logsigmoidf(x) * 0.0625f;
    }
    float total;
    if (DIR == 0) {
#pragma unroll
        for (int ii = 1; ii < 32; ++ii) cum[ii] += cum[ii - 1];
        total = cum[31];
    } else {
#pragma unroll
        for (int ii = 30; ii >= 0; --ii) cum[ii] += cum[ii + 1];
        total = cum[0];
    }
    HT[(DIR * 2 + half) * 256 + d] = total;
    __syncthreads();
    const float t0 = HT[(DIR * 2 + 0) * 256 + d], t1 = HT[(DIR * 2 + 1) * 256 + d];
    const float cmid = DIR == 0 ? t0 : t1, clast = t0 + t1;
    const float add = DIR == 0 ? (half == 1 ? t0 : 0.f) : (half == 0 ? t1 : 0.f);
    unsigned kpack[16];
    const float ecl = __expf(clast - cmid);
#pragma unroll
    for (int i0 = 0; i0 < 32; i0 += 8) {
        float kcv[8];
#pragma unroll
        for (int e = 0; e < 8; ++e) {
            const int ii = i0 + e;
            const float cu = cum[ii] + add;
            const float e1 = __expf(cu - cmid);
            const f32x2 ee = {e1, __builtin_amdgcn_rcpf(e1)};
            const f32x2 qk = (f32x2){__builtin_bit_cast(float, raw[ii] << 16), __builtin_bit_cast(float, raw[ii] & 0xffff0000u)} * ee;
            const unsigned qkb = cvt_pk_bf16(qk.x * 0.0625f, qk.y);
            QS[(half * 32 + ii) * 264 + d] = (bf16_t)(qkb & 0xffffu); KS[(half * 32 + ii) * 264 + d] = (bf16_t)(qkb >> 16);
            kcv[e] = qk.y * ecl;
        }
#pragma unroll
        for (int e = 0; e < 8; e += 2) kpack[(i0 + e) >> 1] = cvt_pk_bf16(kcv[e], kcv[e + 1]);
    }
    const size_t chunk_frag0 = ((((size_t)DIR * NB + b) * 36 + c) * 4 + h) * 32;
    {
        bf16_t* kt = KTT + (chunk_frag0 + (size_t)(d >> 4) * 2 + half) * 512 + (d & 15) * 8;
#pragma unroll
        for (int q = 0; q < 4; ++q) *(u32x4*)(kt + q * 128) = (u32x4){kpack[4 * q], kpack[4 * q + 1], kpack[4 * q + 2], kpack[4 * q + 3]};
    }
    if (half == 0) { const size_t vi = (((size_t)DIR * NB + b) * 36 + c) * 1024 + 256 * h + d; CM[vi] = cmid; CL[vi] = clast; }
    __syncthreads();
    const int ti = wave >> 1, tj0 = (wave & 1) * 2, fr = lane & 15, fq = lane >> 4;
    {
#pragma unroll
        for (int x = 0; x < 4; ++x) { const int f = wave * 4 + x, fti = f >> 3, fks = f & 7;
            *(bf16x8*)(QT + (chunk_frag0 + f) * 512 + lane * 8) = *(const LAS bf16x8*)(QS + (16 * fti + fr) * 264 + 32 * fks + 8 * fq); }
    }
#pragma unroll
    for (int x = 0; x < 2; ++x) {
        f32x4 acc = {0.f, 0.f, 0.f, 0.f};
#pragma unroll
        for (int ks = 0; ks < 8; ++ks) {
            const bf16x8 av = *(const LAS bf16x8*)(QS + (16 * ti + fr) * 264 + 32 * ks + 8 * fq);
            const bf16x8 bv = *(const LAS bf16x8*)(KS + (16 * (tj0 + x) + fr) * 264 + 32 * ks + 8 * fq);
            acc = __builtin_amdgcn_mfma_f32_16x16x32_bf16(av, bv, acc, 0, 0, 0);
        }
        accOut[x] = acc;
    }
    __syncthreads();
}
__device__ __forceinline__ void gla_prep_phase(const bf16_t* P, const float* Z, const float* wgf, const float* bgf, const float* wgb, const float* bgb,
                                               bf16_t* QT, bf16_t* KTT, bf16_t* VT, float* CM, float* CL, _Float16* O32, LAS unsigned char* lds, int G, int bid) {
    const int tid = opaque_tid(), lane = tid & 63, wave = __builtin_amdgcn_readfirstlane(tid >> 6), fr = lane & 15, fq = lane >> 4;
    LAS float* ZS = (LAS float*)(lds + G1_ZS);
    LAS bf16_t* MS = (LAS bf16_t*)(lds + G1_MS);
    LAS bf16_t* VSw = (LAS bf16_t*)(lds + G1_VS) + wave * (64 * 72);
    for (int u = bid; u < NB * 4 * 36; u += G) {
        const int b = u / 144, rem = u - b * 144, h = rem / 36, c = rem - h * 36, R0 = b * TPB + 64 * c;
        { const int row = tid >> 3, c4 = (tid & 7) * 4; *(LAS f32x4*)(ZS + row * 32 + c4) = *(const f32x4*)(Z + (size_t)(R0 + row) * 32 + c4); }
        __syncthreads();
        unsigned raw[32];
        { const bf16_t* qp = P + (size_t)(R0 + (tid >> 8) * 32) * 6144 + 256 * h + (tid & 255);
#pragma unroll
          for (int ii = 0; ii < 32; ++ii) raw[ii] = (unsigned)qp[(size_t)ii * 6144] | ((unsigned)qp[(size_t)ii * 6144 + 1024] << 16); }
        f32x4 accF[2], accB[2];
        gla_prep_dir<0>(P, wgf, bgf, QT, KTT, CM, CL, lds, b, h, c, R0, raw, accF);
        gla_prep_dir<1>(P, wgb, bgb, QT, KTT, CM, CL, lds, b, h, c, R0, raw, accB);
        const int ti = wave >> 1, tj0 = (wave & 1) * 2;
#pragma unroll
        for (int x = 0; x < 2; ++x)
#pragma unroll
            for (int r = 0; r < 4; ++r) { const int i = 16 * ti + 4 * fq + r, j = 16 * (tj0 + x) + fr;
                const float m = (j <= i ? accF[x][r] : 0.f) + (j >= i ? accB[x][r] : 0.f);
                MS[i * 72 + j] = (bf16_t)f2bf(m); }
#pragma unroll
        for (int it = 0; it < 8; ++it) { const int q = it * 64 + lane, j = q >> 3, ec = (q & 7) * 8;
            const u32x4 w = *(const u32x4*)(P + (size_t)(R0 + j) * 6144 + 2048 + 512 * h + 64 * wave + ec);
            const int js = (((j >> 3) ^ (q & 7)) << 3) | (j & 7);
            VSw[(ec + 0) * 72 + js] = (bf16_t)(w.x & 0xffff); VSw[(ec + 1) * 72 + js] = (bf16_t)(w.x >> 16);
            VSw[(ec + 2) * 72 + js] = (bf16_t)(w.y & 0xffff); VSw[(ec + 3) * 72 + js] = (bf16_t)(w.y >> 16);
            VSw[(ec + 4) * 72 + js] = (bf16_t)(w.z & 0xffff); VSw[(ec + 5) * 72 + js] = (bf16_t)(w.z >> 16);
            VSw[(ec + 6) * 72 + js] = (bf16_t)(w.w & 0xffff); VSw[(ec + 7) * 72 + js] = (bf16_t)(w.w >> 16); }
        __syncthreads();
        {
            bf16_t* vt = VT + ((((size_t)b * 36 + c) * 4 + h) * 512 + 64 * wave) * 64;
#pragma unroll
            for (int it = 0; it < 8; ++it) { const int q = it * 64 + lane, e = q >> 3, jc = (q & 7) * 8;
                *(u32x4*)(vt + (size_t)e * 64 + jc) = *(const LAS u32x4*)(VSw + e * 72 + (jc ^ (((e >> 3) & 7) << 3))); }
        }
        f32x4 oacc[4][4];
#pragma unroll
        for (int a = 0; a < 4; ++a)
#pragma unroll
            for (int bb = 0; bb < 4; ++bb) oacc[a][bb] = (f32x4){0.f, 0.f, 0.f, 0.f};
#pragma unroll
        for (int ks = 0; ks < 2; ++ks) {
            bf16x8 av[4], bv[4];
#pragma unroll
            for (int t = 0; t < 4; ++t) { av[t] = *(const LAS bf16x8*)(MS + (16 * t + fr) * 72 + 32 * ks + 8 * fq); bv[t] = *(const LAS bf16x8*)(VSw + (16 * t + fr) * 72 + (((4 * ks + fq) ^ ((2 * t + (fr >> 3)) & 7)) << 3)); }
#pragma unroll
            for (int a = 0; a < 4; ++a)
#pragma unroll
                for (int bb = 0; bb < 4; ++bb) oacc[a][bb] = __builtin_amdgcn_mfma_f32_16x16x32_bf16(bv[bb], av[a], oacc[a][bb], 0, 0, 0);
        }
#pragma unroll
        for (int a = 0; a < 4; ++a) { _Float16* op = O32 + (size_t)(R0 + 16 * a + fr) * 2048 + 512 * h + 64 * wave + 4 * fq;
#pragma unroll
            for (int bb = 0; bb < 4; ++bb) { u32x2 w; w.x = pk_f16(oacc[a][bb].x, oacc[a][bb].y); w.y = pk_f16(oacc[a][bb].z, oacc[a][bb].w); *(u32x2*)(op + 16 * bb) = w; } }
        __syncthreads();
    }
}
constexpr int SC_ST = 0, SC_VT = 67584, SC_VTB = 18432;
__device__ __forceinline__ void gla_scan_phase(const bf16_t* QT, const bf16_t* KTT, const bf16_t* VT, const float* CM, const float* CL, _Float16* O32, LAS unsigned char* lds, int G, int bid, float sgn = 1.f) {
    const int tid = opaque_tid(), lane = tid & 63, wave = __builtin_amdgcn_readfirstlane(tid >> 6), fr = lane & 15, fq = lane >> 4;
    const int ti = wave >> 1, tj0 = (wave & 1) * 4;
    LAS bf16_t* ST = (LAS bf16_t*)(lds + SC_ST);
    const int vte = tid >> 2, vtp = tid & 3;
    for (int u0 = bid; u0 < 256; u0 += G) {
        const int u = (G == 256) ? ((u0 & 7) * 32 + (u0 >> 3)) : u0;
        const int b = u >> 4, h = (u >> 2) & 3, sl = u & 3;
#define SC_CHUNK(q, dir, c) const int dir = (q) >= 36 ? 1 : 0; const int s_##c = (q) - 36 * dir; const int c = dir == 0 ? s_##c : (s_##c < 4 ? 3 - s_##c : 39 - s_##c)
#define SC_LOAD_CMCL(q) do { SC_CHUNK(q, d_, c_); const size_t vb = (((size_t)d_ * NB + b) * 36 + c_) * 1024 + 256 * h + 32 * wave + 4 * fq; \
        _Pragma("unroll") for (int t = 0; t < 2; ++t) { cm[t] = *(const f32x4*)(CM + vb + 16 * t); cl[t] = *(const f32x4*)(CL + vb + 16 * t); } } while (0)
#define SC_LOAD_Q(q) do { SC_CHUNK(q, d_, c_); const bf16_t* qfr = QT + ((((((size_t)d_ * NB + b) * 36 + c_) * 4 + h) * 32) + ti * 8) * 512 + lane * 8; \
        _Pragma("unroll") for (int ks = 0; ks < 8; ++ks) qf[ks] = *(const bf16x8*)(qfr + ks * 512); } while (0)
#define SC_LOAD_K(q) do { SC_CHUNK(q, d_, c_); const bf16_t* kb = KTT + ((((((size_t)d_ * NB + b) * 36 + c_) * 4 + h) * 32) + wave * 4) * 512 + lane * 8; \
        _Pragma("unroll") for (int ks = 0; ks < 2; ++ks) _Pragma("unroll") for (int t = 0; t < 2; ++t) kf[t][ks] = *(const bf16x8*)(kb + (t * 2 + ks) * 512); } while (0)
#define SC_LOAD_V(q) do { SC_CHUNK(q, d_, c_); (void)d_; const bf16_t* vp = VT + ((((size_t)b * 36 + c_) * 4 + h) * 512 + 128 * sl + vte) * 64 + 16 * vtp; \
        vs0 = *(const bf16x8*)vp; vs1 = *(const bf16x8*)(vp + 8); } while (0)
#define SC_WRITE_V(buf) do { LAS bf16_t* vd = (LAS bf16_t*)(lds + SC_VT + (buf) * SC_VTB) + vte * 72 + 16 * vtp; *(LAS bf16x8*)vd = vs0; *(LAS bf16x8*)(vd + 8) = vs1; } while (0)
#define SC_LOAD_O(q) do { SC_CHUNK(q, d_, c_); (void)d_; const _Float16* ob_ = O32 + (size_t)(b * TPB + 64 * c_ + 16 * ti + fr) * 2048 + 512 * h + 128 * sl + 16 * tj0 + 4 * fq; \
        _Pragma("unroll") for (int x = 0; x < 4; ++x) ov[x] = *(const u32x2*)(ob_ + 16 * x); } while (0)
        f32x4 S[2][8];
#pragma unroll
        for (int t = 0; t < 2; ++t)
#pragma unroll
            for (int uu = 0; uu < 8; ++uu) S[t][uu] = (f32x4){0.f, 0.f, 0.f, 0.f};
        f32x4 cm[2], cl[2]; bf16x8 qf[8], kf[2][2], vs0, vs1; u32x2 ov[4];
        SC_LOAD_V(0); SC_WRITE_V(0); SC_LOAD_V(1);
        SC_LOAD_CMCL(0); SC_LOAD_Q(0); SC_LOAD_K(0); SC_LOAD_O(0);
        __syncthreads();
        for (int q = 0; q < 72; ++q) {
            SC_CHUNK(q, dir, c);
            (void)dir;
            const int R0 = b * TPB + 64 * c;
            const int qn = q < 71 ? q + 1 : 71, qnn = q < 70 ? q + 2 : 71;
            if (q == 36) {
#pragma unroll
                for (int t = 0; t < 2; ++t)
#pragma unroll
                    for (int uu = 0; uu < 8; ++uu) S[t][uu] = (f32x4){0.f, 0.f, 0.f, 0.f};
            }
            _Float16* const ob = O32 + (size_t)(R0 + 16 * ti + fr) * 2048 + 512 * h + 128 * sl + 16 * tj0 + 4 * fq;
            f32x4 dec[2];
#pragma unroll
            for (int t = 0; t < 2; ++t) { const f32x4 e = {__expf(cm[t].x), __expf(cm[t].y), __expf(cm[t].z), __expf(cm[t].w)};
                dec[t] = (f32x4){__expf(cl[t].x), __expf(cl[t].y), __expf(cl[t].z), __expf(cl[t].w)};
#pragma unroll
                for (int uu = 0; uu < 8; ++uu) { const f32x4 v = S[t][uu] * e; u32x2 w; w.x = cvt_pk_bf16(v.x, v.y); w.y = cvt_pk_bf16(v.z, v.w);
                    *(LAS u32x2*)(ST + (16 * uu + fr) * 264 + 32 * wave + 16 * t + 4 * fq) = w; } }
            SC_LOAD_CMCL(qn);
            __syncthreads();
            SC_WRITE_V((q + 1) & 1); SC_LOAD_V(qnn);
            f32x4 oa[4];
#pragma unroll
            for (int x = 0; x < 4; ++x) oa[x] = (f32x4){0.f, 0.f, 0.f, 0.f};
#pragma unroll
            for (int ks = 0; ks < 8; ++ks) {
#pragma unroll
                for (int x = 0; x < 4; ++x) { const bf16x8 bv = *(const LAS bf16x8*)(ST + (16 * (tj0 + x) + fr) * 264 + 32 * ks + 8 * fq);
                    oa[x] = __builtin_amdgcn_mfma_f32_16x16x32_bf16(bv, qf[ks], oa[x], 0, 0, 0); } }
            __syncthreads();
            SC_LOAD_Q(qn);
#pragma unroll
            for (int x = 0; x < 4; ++x) { u32x2 w; w.x = pk_f16(f16lo(ov[x].x) + sgn * oa[x].x, f16hi(ov[x].x) + sgn * oa[x].y); w.y = pk_f16(f16lo(ov[x].y) + sgn * oa[x].z, f16hi(ov[x].y) + sgn * oa[x].w);
                *(u32x2*)(ob + 16 * x) = w; }
            SC_LOAD_O(qn);
            const LAS bf16_t* vt = (const LAS bf16_t*)(lds + SC_VT + (q & 1) * SC_VTB);
#pragma unroll
            for (int t = 0; t < 2; ++t)
#pragma unroll
                for (int uu = 0; uu < 8; ++uu) S[t][uu] = S[t][uu] * dec[t];
#pragma unroll
            for (int ks = 0; ks < 2; ++ks)
#pragma unroll
                for (int uu = 0; uu < 8; ++uu) { const bf16x8 bv = *(const LAS bf16x8*)(vt + (16 * uu + fr) * 72 + 32 * ks + 8 * fq);
#pragma unroll
                    for (int t = 0; t < 2; ++t) S[t][uu] = __builtin_amdgcn_mfma_f32_16x16x32_bf16(kf[t][ks], bv, S[t][uu], 0, 0, 0); }
            SC_LOAD_K(qn);
        }
        __syncthreads();
#undef SC_CHUNK
#undef SC_LOAD_CMCL
#undef SC_LOAD_Q
#undef SC_LOAD_K
#undef SC_LOAD_V
#undef SC_WRITE_V
#undef SC_LOAD_O
    }
}
__device__ __forceinline__ void gla_finish_phase(const _Float16* O32, const bf16_t* P, const float* gain, bf16_t* O, int G, int bid) {
    const int tid = threadIdx.x, lane = tid & 63, wave = __builtin_amdgcn_readfirstlane(tid >> 6);
    const f32x4 g0 = *(const f32x4*)(gain + 4 * lane), g1 = *(const f32x4*)(gain + 256 + 4 * lane);
    const long total = (long)NT * 4, stride = (long)G * 8;
    constexpr int NI = 4;
    for (long id0 = (long)bid * 8 + wave; id0 < total; id0 += stride * NI) {
        u32x2 qa[NI], qc[NI]; f32x4 a[NI], c[NI]; u32x2 ra[NI], rc[NI]; bf16_t* op[NI]; bool ok[NI];
#pragma unroll
        for (int i = 0; i < NI; ++i) { const long id = id0 + stride * i; ok[i] = id < total; const long idc = ok[i] ? id : id0;
            const int r = (int)(idc >> 2), h = (int)(idc & 3);
            const _Float16* ip = O32 + (size_t)r * 2048 + 512 * h + 4 * lane; qa[i] = *(const u32x2*)ip; qc[i] = *(const u32x2*)(ip + 256);
            const bf16_t* rp = P + (size_t)r * 6144 + 4096 + 512 * h + 4 * lane; ra[i] = *(const u32x2*)rp; rc[i] = *(const u32x2*)(rp + 256);
            op[i] = O + (size_t)r * DM + 512 * h + 4 * lane; }
#pragma unroll
        for (int i = 0; i < NI; ++i) {
            a[i] = (f32x4){f16lo(qa[i].x), f16hi(qa[i].x), f16lo(qa[i].y), f16hi(qa[i].y)}; c[i] = (f32x4){f16lo(qc[i].x), f16hi(qc[i].x), f16lo(qc[i].y), f16hi(qc[i].y)};
            const float ss = wave_sum((a[i].x * a[i].x + a[i].y * a[i].y) + (a[i].z * a[i].z + a[i].w * a[i].w) + (c[i].x * c[i].x + c[i].y * c[i].y) + (c[i].z * c[i].z + c[i].w * c[i].w));
            const float rs = 1.0f / sqrtf(ss * (1.f / 512.f) + NORM_EPS);
            u32x2 o0, o1;
            o0.x = cvt_pk_bf16(a[i].x * rs * g0.x * siluf(bflo(ra[i].x)), a[i].y * rs * g0.y * siluf(bfhi(ra[i].x)));
            o0.y = cvt_pk_bf16(a[i].z * rs * g0.z * siluf(bflo(ra[i].y)), a[i].w * rs * g0.w * siluf(bfhi(ra[i].y)));
            o1.x = cvt_pk_bf16(c[i].x * rs * g1.x * siluf(bflo(rc[i].x)), c[i].y * rs * g1.y * siluf(bfhi(rc[i].x)));
            o1.y = cvt_pk_bf16(c[i].z * rs * g1.z * siluf(bflo(rc[i].y)), c[i].w * rs * g1.w * siluf(bfhi(rc[i].y)));
            if (ok[i]) { *(u32x2*)op[i] = o0; *(u32x2*)(op[i] + 256) = o1; }
        }
    }
}

__device__ __forceinline__ void fnet_nyquist(const bf16_t* DFT2m, const bf16_t* UVT, bf16_t* O, int G, int bid) {
    const int tid = opaque_tid(), lane = tid & 63, wave = __builtin_amdgcn_readfirstlane(tid >> 6), fr = lane & 15, fq = lane >> 4;
    for (int task = bid * 8 + wave; task < NB * 128; task += G * 8) {
        const int b = task >> 7, l0 = (task & 127) * 16;
        const bf16_t* ap = DFT2m + (size_t)(l0 + fr) * 4096 + 8 * fq;
        const bf16_t* bp = UVT + ((size_t)b * 1024 + (size_t)(fr & 3) * 256) * 4096 + 2048 + 8 * fq;
        f32x4 acc = {0.f, 0.f, 0.f, 0.f};
#pragma unroll 8
        for (int ks = 0; ks < 64; ++ks) acc = __builtin_amdgcn_mfma_f32_16x16x32_bf16(*(const bf16x8*)(ap + 32 * ks), *(const bf16x8*)(bp + 32 * ks), acc, 0, 0, 0);
        if (fr < 4) {
#pragma unroll
            for (int r = 0; r < 4; ++r) O[((size_t)b * TPB + CTXL + l0 + 4 * fq + r) * DM + fr * 512 + 256] = (bf16_t)f2bf(acc[r]);
        }
    }
}

__device__ __forceinline__ void fnet_row1024(const bf16_t* UVT, bf16_t* O, int G, int bid) {
    const int tid = opaque_tid(), lane = tid & 63, wave = __builtin_amdgcn_readfirstlane(tid >> 6);
    const float cw = bf2f((unsigned short)f2bf(0.022097086912079608f));
    for (int task = bid * 8 + wave; task < NB * 1024; task += G * 8) {
        const int b = task >> 10, ch = task & 1023, g = ch >> 8, t = ch & 255;
        const bf16_t* up = UVT + ((size_t)b * 1024 + ch) * 4096 + 8 * lane;
        float sum = 0.f;
#pragma unroll
        for (int j = 0; j < 4; ++j) { const u32x4 w = *(const u32x4*)(up + 512 * j);
            sum += (bflo(w.x) - bfhi(w.x)) + (bflo(w.y) - bfhi(w.y)) + (bflo(w.z) - bfhi(w.z)) + (bflo(w.w) - bfhi(w.w)); }
        sum = wave_sum(sum) * cw;
        if (lane == 0) { bf16_t* orow = O + ((size_t)b * TPB + CTXL + 1024) * DM + g * 512; const bf16_t v = (bf16_t)f2bf(sum); orow[t] = v; if (t != 0) orow[256 + t] = v; }
    }
}

constexpr int NPH = 34;
template <int L> __device__ __forceinline__ int c_in(int which) {
    constexpr int base = L == 0 ? 4 : L == 1 ? 17 : L == 2 ? 27 : 42;
    constexpr int n2 = L == 0 ? 14 : L == 1 ? 24 : L == 2 ? 39 : 46;
    return which < 3 ? base + which : n2 + (which - 3);
}
__global__ void __launch_bounds__(512, 2) fwd_kernel(KArgs a) {
    extern __shared__ __attribute__((aligned(16))) unsigned char lds_raw[];
    LAS unsigned char* lds = (LAS unsigned char*)lds_raw;
    const int tid = threadIdx.x, G = gridDim.x, bid = blockIdx.x;
    if (tid < 16) ((LAS unsigned*)(lds + MISC_OFF))[tid] = 0u;
    __syncthreads();
    unsigned* barw = (unsigned*)(a.ws + WS_CTL) + 4096;
    XcdBarrier bar; bar.bar = barw; bar.x = 0; bar.st = (volatile LAS unsigned*)(lds + MISC_OFF);
    if (N_LAUNCH_MODE == 1) bar = xcd_barrier_post(barw, (volatile LAS unsigned*)(lds + MISC_OFF));
    const int lo = a.ph_lo, hi = a.ph_hi;
#ifndef PHSEL
#define PHSEL -1
#endif
#define IN(k) ((PHSEL < 0 || PHSEL == (k)) && lo <= (k) && (k) < hi)
#ifndef STAMP_A
#define STAMP_A -100
#endif
#ifndef STAMP_B
#define STAMP_B -100
#endif
    unsigned long long tA0 = 0, tA1 = 0, tB0 = 0, tB1 = 0;
#define STAMP_AT(k) do { if ((k) + 1 == STAMP_A) tA0 = wall_clock64(); if ((k) == STAMP_A) tA1 = wall_clock64(); if ((k) + 1 == STAMP_B) tB0 = wall_clock64(); if ((k) == STAMP_B) tB1 = wall_clock64(); } while (0)
#define SEAM(k) do { if (IN(k) && IN((k) + 1)) xcd_barrier(bar); STAMP_AT(k); } while (0)
#ifndef PROBE_REP
#define PROBE_REP -1
#endif
#ifndef PROBE_N
#define PROBE_N 2
#endif
#define REPS(k) (PROBE_REP == (k) ? PROBE_N : 1)

#define p_ws (a.ws)
#define p_modv ((float*)(a.ws + WS_MODV))
#define p_rope ((const f32x2*)(a.ws + WS_ROPE))
#define p_DFT1 ((bf16_t*)(a.ws + WS_DFT1))
#define p_DFT2 ((bf16_t*)(a.ws + WS_DFT2))
#define p_Wf1 ((bf16_t*)(a.ws + W_FFN1))
#define p_Wf2 ((bf16_t*)(a.ws + W_FFN2))
#define p_Win ((bf16_t*)(a.ws + W_IN))
#define p_Wout ((bf16_t*)(a.ws + W_OUT))
#define p_xh ((void*)(a.ws + WS_XH))
#define p_xhc ((void*)(a.ws + WS_XHC))
#define p_HN ((bf16_t*)(a.ws + WS_HN))
#define p_OB ((bf16_t*)(a.ws + WS_O))
#define p_BIG ((bf16_t*)(a.ws + WS_BIG))
#define p_out (a.out)

#define PH_PREP(k, L, FIN, FOUT, WI, NIN, WO, LATONLY, ...) if (IN(k)) { \
        convert_layer(a, lds, bid * 8 + (int)(threadIdx.x >> 6), G * 8, FIN, FOUT, WI, NIN, WO, ##__VA_ARGS__); \
        norm_phase<(L != 0)>(L == 0 ? (const void*)a.in[0] : (const void*)p_xh, L == 0 ? (const void*)a.in[2] : (const void*)p_xhc, a.in[c_in<L>(2)], p_modv + (size_t)L * 17 * 12288, 0, 2048, p_HN, LATONLY, G, bid, L == 0 ? p_xh : nullptr, L == 0 ? p_xhc : nullptr); } SEAM(k)
#ifndef SKEW_TICKS
#define SKEW_TICKS 0
#endif
#define PH_SKEW() do { if (SKEW_TICKS > 0) { const unsigned long long t0_ = __builtin_amdgcn_s_memrealtime(); const unsigned long long w_ = (unsigned long long)(bid & 3) * SKEW_TICKS; \
        while (__builtin_amdgcn_s_memrealtime() - t0_ < w_) __builtin_amdgcn_s_sleep(32); } } while (0)
#define PH_PROJ(k, NN, LDC, ZT, ZP, KLO, KHI, KN, PROJTAIL) if (IN(k)) { PH_SKEW(); \
        ProbStd g{p_HN, p_Win, DM, DM, DM, 0}; pg8::UOrder S; S.init(144, NN, 1, G, bid, 4); EpiProj E{p_BIG, LDC, ZT, ZP, KLO, KHI, KN, p_rope}; \
        pg8::gemm_phase<ProbStd, EpiProj>(lds, g, S, E); PROJTAIL } SEAM(k)
#define PROJTAIL_L(L, FIRST) if (G == 256 && bid >= (FIRST)) convert_layer(a, lds, (bid - (FIRST)) * 8 + (int)(threadIdx.x >> 6), (256 - (FIRST)) * 8, nullptr, a.in[c_in<L>(5)], nullptr, 0, nullptr);
#define PH_DELAY(ticks) do { if ((ticks) > 0 && G == 256 && bid >= 128) { const unsigned long long t0_ = __builtin_amdgcn_s_memrealtime(); \
        while (__builtin_amdgcn_s_memrealtime() - t0_ < (unsigned long long)(ticks)) __builtin_amdgcn_s_sleep(32); } } while (0)
#define PH_OUT(k, L, AMAP, OUTTAIL) if (IN(k)) { PH_DELAY(0); \
        ProbStd g{p_OB, p_Wout, DM, DM, DM, AMAP}; pg8::UOrder S; S.init(AMAP ? 128 : 144, 8, 1, G, bid, 4); \
        EpiResT<true, true> E{p_xh, p_xhc, p_xh, p_xhc, p_modv + (size_t)L * 17 * 12288, 4096, AMAP, lds + 131072}; \
        pg8::gemm_phase<ProbStd, EpiResT<true, true>>(lds, g, S, E); OUTTAIL } SEAM(k)
#define FFNTAIL(FIRST, FIN, FOUT, SH1, SH2) if (G == 256 && bid >= (FIRST)) convert_layer(a, lds, (bid - (FIRST)) * 8 + (int)(threadIdx.x >> 6), (256 - (FIRST)) * 8, FIN, FOUT, nullptr, 0, nullptr, 0, SH1, SH2); \
        else if (G != 256) convert_layer(a, lds, bid * 8 + (int)(threadIdx.x >> 6), G * 8, FIN, FOUT, nullptr, 0, nullptr, 0, SH1, SH2);
#define PH_NORM2(k, L, AMAP) if (IN(k)) { \
        norm_phase<true>(p_xh, p_xhc, a.in[c_in<L>(3)], p_modv + (size_t)L * 17 * 12288, 6144, 8192, p_HN, AMAP, G, bid); } SEAM(k)
#define PH_FFN1(k, L, AMAP) if (IN(k)) { PH_SKEW(); \
        ProbStd g{p_HN, L == 3 ? (bf16_t*)(p_ws + WS_W3F1) : p_Wf1, DM, DM, DM, AMAP}; pg8::UOrder S; S.init(AMAP ? 128 : 144, 44, 1, G, bid, 4); EpiSwiGLU E{p_BIG, AMAP}; \
        pg8::gemm_phase<ProbStd, EpiSwiGLU>(lds, g, S, E); } SEAM(k)
#define PH_FFN2(k, L, AMAP, TAILCONV) if (IN(k)) { \
        ProbStd g{p_BIG, L == 3 ? (bf16_t*)(p_ws + WS_W3F2) : p_Wf2, FF, FF, FF, AMAP}; pg8::UOrder S; S.init(AMAP ? 128 : 144, 8, 1, G, bid, 4, 1); \
        EpiResT<true, (L != 3)> E{p_xh, p_xhc, L == 3 ? (void*)p_out : p_xh, p_xhc, p_modv + (size_t)L * 17 * 12288, 10240, AMAP, lds + 131072}; \
        pg8::gemm_phase<ProbStd, EpiResT<true, (L != 3)>>(lds, g, S, E); TAILCONV } SEAM(k)
#define TAILCONV_L(L1, WI, NIN, WO) if (G == 256 && bid >= 128) convert_layer(a, lds, (bid - 128) * 8 + (int)(threadIdx.x >> 6), 128 * 8, a.in[c_in<L1>(4)], nullptr, WI, NIN, WO); \
        else if (G != 256) { xcd_barrier(bar); convert_layer(a, lds, bid * 8 + (int)(threadIdx.x >> 6), G * 8, a.in[c_in<L1>(4)], nullptr, WI, NIN, WO); }

    if (IN(0)) { ph_prologue(a, lds, G, bid); } SEAM(0);
#if PROBE_REP == 0
    if (IN(0)) { ph_prologue(a, lds, G, bid); } SEAM(0);
#endif
#if PROBE_REP >= 200 && PROBE_REP < 210
    if (IN(0)) { const int tid_ = opaque_tid(), lane_ = tid_ & 63, wv_ = tid_ >> 6;
        char* base_ = (char*)(p_ws + WS_O32) + (size_t)bid * (PROBE_REP == 202 ? (size_t)256 * 11264 : (size_t)131072);
        u32x4 val_ = {(unsigned)tid_, 1u, 2u, 3u}; u32x4 accl_ = {0u, 0u, 0u, 0u};
#pragma unroll 1
        for (int it = 0; it < 1024; it += 8) {
#pragma unroll
            for (int k2 = 0; k2 < 8; ++k2) { const int slot = ((it + k2) & 15) * 8 + wv_;
                char* p_;
                if (PROBE_REP == 200 || PROBE_REP == 203) p_ = base_ + (size_t)slot * 1024 + lane_ * 16;
                else if (PROBE_REP == 201) p_ = base_ + (size_t)((slot >> 3) * 16 + (lane_ & 15)) * 512 + (slot & 7) * 64 + (lane_ >> 4) * 16;
                else if (PROBE_REP == 204) p_ = base_ + (size_t)((slot >> 2) * 8 + (lane_ >> 3)) * 512 + (slot & 3) * 128 + (lane_ & 7) * 16;
                else if (PROBE_REP == 205) p_ = base_ + (size_t)((slot >> 3) * 16 + (lane_ >> 2)) * 512 + (slot & 7) * 64 + (lane_ & 3) * 16;
                else p_ = base_ + (size_t)((slot >> 3) * 16 + (lane_ & 15)) * 11264 + (slot & 7) * 64 + (lane_ >> 4) * 16;
                if (PROBE_REP == 203) { const u32x4 r_ = *(const volatile u32x4*)p_; accl_ += r_; }
                else { val_.y += 1u; *(u32x4*)p_ = val_; } }
        }
        if (PROBE_REP == 203 && accl_.x == 0x12345678u && accl_.y == 77u) *(u32x4*)base_ = accl_;
    } SEAM(0);
#endif

    PH_PREP(1, 0, nullptr, nullptr, a.in[7], 6176, a.in[13], 0);
#if PROBE_REP == 1
    PH_PREP(1, 0, nullptr, nullptr, a.in[7], 6176, a.in[13], 0);
#endif
    PH_PROJ(2, 25, 6144, 24, (float*)(p_ws + WS_Z), 0, 0, nullptr, FFNTAIL(16, a.in[c_in<0>(4)], a.in[c_in<0>(5)], 0, 0));
#if PROBE_REP == 2
    PH_PROJ(2, 25, 6144, 24, (float*)(p_ws + WS_Z), 0, 0, nullptr, FFNTAIL(16, a.in[c_in<0>(4)], a.in[c_in<0>(5)], 0, 0));
#endif
    {
        bf16_t* QT = (bf16_t*)(p_ws + WS_O); bf16_t* KTT = (bf16_t*)(p_ws + WS_KTT); bf16_t* VT = (bf16_t*)(p_ws + WS_HN);
        float* CM = (float*)(p_ws + WS_CMCL); float* CL = CM + (size_t)2 * NB * 36 * 1024; _Float16* O32 = (_Float16*)p_out;
        if (IN(3)) { gla_prep_phase(p_BIG, (const float*)(p_ws + WS_Z), a.in[8], a.in[9], a.in[10], a.in[11], QT, KTT, VT, CM, CL, O32, lds, G, bid); } SEAM(3);
#if PROBE_REP == 3
        if (IN(3)) { gla_prep_phase(p_BIG, (const float*)(p_ws + WS_Z), a.in[8], a.in[9], a.in[10], a.in[11], QT, KTT, VT, CM, CL, O32, lds, G, bid); } SEAM(3);
#endif
#if PROBE_REP == 4
        if (IN(4)) { gla_scan_phase(QT, KTT, VT, CM, CL, O32, lds, G, bid); xcd_barrier(bar); gla_scan_phase(QT, KTT, VT, CM, CL, O32, lds, G, bid, -1.f); xcd_barrier(bar); }
#endif
        if (IN(4)) { gla_scan_phase(QT, KTT, VT, CM, CL, O32, lds, G, bid); } SEAM(4);
        if (IN(5)) { gla_finish_phase(O32, p_BIG, a.in[12], p_OB, G, bid); } SEAM(5);
#if PROBE_REP == 5
        if (IN(5)) { gla_finish_phase(O32, p_BIG, a.in[12], p_OB, G, bid); } SEAM(5);
#endif
    }
    PH_OUT(6, 0, 0, FFNTAIL(128, nullptr, a.in[c_in<3>(5)], 0, WS_W3F2 - W_FFN2));
#if PROBE_REP == 6
    PH_OUT(6, 0, 0, FFNTAIL(128, nullptr, a.in[c_in<3>(5)], 0, WS_W3F2 - W_FFN2));
#endif
    PH_NORM2(7, 0, 0);
#if PROBE_REP == 7
    PH_NORM2(7, 0, 0);
#endif
    PH_FFN1(8, 0, 0);
#if PROBE_REP == 8
    PH_FFN1(8, 0, 0);
#endif
    PH_FFN2(9, 0, 0, TAILCONV_L(1, a.in[20], 3072, a.in[23]));

    PH_PREP(10, 1, nullptr, (G == 256 ? (const float*)nullptr : a.in[c_in<1>(5)]), nullptr, 0, nullptr, 0);
#if PROBE_REP == 10
    PH_PREP(10, 1, nullptr, (G == 256 ? (const float*)nullptr : a.in[c_in<1>(5)]), nullptr, 0, nullptr, 0);
#endif
    PH_PROJ(11, 12, 3072, -1, nullptr, 8, 10, a.in[22], PROJTAIL_L(1, 192));
#if PROBE_REP == 11
    PH_PROJ(11, 12, 3072, -1, nullptr, 8, 10, a.in[22], PROJTAIL_L(1, 192));
#endif
    if (IN(13)) { gqa_attn_phase(p_BIG, p_OB, a.in[21], a.in[22], p_rope, (char*)lds_raw, G, bid); } SEAM(13);
#if PROBE_REP == 13
    if (IN(13)) { gqa_attn_phase(p_BIG, p_OB, a.in[21], a.in[22], p_rope, (char*)lds_raw, G, bid); } SEAM(13);
#endif
    PH_OUT(14, 1, 0, FFNTAIL(128, a.in[c_in<3>(4)], nullptr, WS_W3F1 - W_FFN1, 0));
    PH_NORM2(15, 1, 0);
#if PROBE_REP == 15
    PH_NORM2(15, 1, 0);
#endif
    PH_FFN1(16, 1, 0);
#if PROBE_REP == 16
    PH_FFN1(16, 1, 0);
#endif
    PH_FFN2(17, 1, 0, TAILCONV_L(2, a.in[30], 6144, a.in[38]));

    PH_PREP(18, 2, nullptr, (G == 256 ? (const float*)nullptr : a.in[c_in<2>(5)]), nullptr, 0, nullptr, 0);
#if PROBE_REP == 18
    PH_PREP(18, 2, nullptr, (G == 256 ? (const float*)nullptr : a.in[c_in<2>(5)]), nullptr, 0, nullptr, 0);
#endif
    PH_PROJ(19, 24, 6144, -1, nullptr, 8, 16, a.in[32], PROJTAIL_L(2, 128));
#if PROBE_REP == 19
    PH_PROJ(19, 24, 6144, -1, nullptr, 8, 16, a.in[32], PROJTAIL_L(2, 128));
#endif
    if (IN(21)) { diff_attn_phase(p_BIG, (bf16_t*)(p_ws + WS_GX), p_OB, a.in[31], a.in[32], p_rope, a.in[33], a.in[34], a.in[35], a.in[36], a.in[37], (char*)lds_raw, G, bid); } SEAM(21);
#if PROBE_REP == 21
    if (IN(21)) { diff_attn_phase(p_BIG, (bf16_t*)(p_ws + WS_GX), p_OB, a.in[31], a.in[32], p_rope, a.in[33], a.in[34], a.in[35], a.in[36], a.in[37], (char*)lds_raw, G, bid); } SEAM(21);
#endif
    PH_OUT(23, 2, 1, );
    PH_NORM2(24, 2, 1);
#if PROBE_REP == 24
    PH_NORM2(24, 2, 1);
#endif
    PH_FFN1(25, 2, 1);
#if PROBE_REP == 25
    PH_FFN1(25, 2, 1);
#endif
    PH_FFN2(26, 2, 1, );

    PH_PREP(27, 3, nullptr, nullptr, nullptr, 0, a.in[45], 1, 2);
#if PROBE_REP == 27
    PH_PREP(27, 3, nullptr, nullptr, nullptr, 0, a.in[45], 1, 2);
#endif
    if (IN(28)) { ProbF1 g{p_DFT1, p_HN, 512, DM, 512}; pg8::UOrder S; S.init(2, 8, 64, G, bid); EpiF1 E{p_BIG}; pg8::gemm_phase<ProbF1, EpiF1>(lds, g, S, E); } SEAM(28);
#if PROBE_REP == 28
    if (IN(28)) { ProbF1 g{p_DFT1, p_HN, 512, DM, 512}; pg8::UOrder S; S.init(2, 8, 64, G, bid); EpiF1 E{p_BIG}; pg8::gemm_phase<ProbF1, EpiF1>(lds, g, S, E); } SEAM(28);
#endif
    if (IN(29)) { ProbF2 g{p_DFT2, p_BIG, 4096, 4096, 2048}; pg8::UOrder S; S.init(4, 4, 16, G, bid); EpiF2P E{p_BIG + (size_t)64 * 1024 * 1024};
        pg8::gemm_phase<ProbF2, EpiF2P>(lds, g, S, E); fnet_nyquist(p_DFT2, p_BIG, p_OB, G, bid); fnet_row1024(p_BIG, p_OB, G, bid); } SEAM(29);
    if (IN(29)) { ProbF2 g{p_DFT2 + 2048, p_BIG + 2048, 4096, 4096, 2048}; pg8::UOrder S; S.init(4, 4, 16, G, bid); EpiF2Q E{p_BIG + (size_t)64 * 1024 * 1024, p_OB};
        pg8::gemm_phase<ProbF2, EpiF2Q>(lds, g, S, E); } SEAM(29);
    PH_OUT(30, 3, 1, );
    PH_NORM2(31, 3, 1);
#if PROBE_REP == 31
    PH_NORM2(31, 3, 1);
#endif
    PH_FFN1(32, 3, 1);
#if PROBE_REP == 32
    PH_FFN1(32, 3, 1);
#endif
    PH_FFN2(33, 3, 1, );
#if STAMP_A >= 0
    xcd_barrier(bar); STAMP_AT(33);
    if (bid == 0 && tid == 0) p_out[0] = (float)(tA1 - tA0) * 0.01f;
    if (bid == 1) { const float bv = STAMP_B >= 0 ? (float)(tB1 - tB0) * 0.001f : 50.f; for (int i = 1 + tid; i <= 1000000; i += 512) p_out[i] = bv; }
#endif
#undef IN
#undef SEAM
#undef p_ws
#undef p_modv
#undef p_rope
#undef p_DFT1
#undef p_DFT2
#undef p_Wf1
#undef p_Wf2
#undef p_Win
#undef p_Wout
#undef p_xh
#undef p_xhc
#undef p_HN
#undef p_OB
#undef p_BIG
#undef p_out
}

extern "C" void kernel_launch(void* const* d_in, const int* in_sizes, int n_in, void* d_out, int out_size, void* d_ws, size_t ws_size, hipStream_t stream) {
    static int grid = 0;
    if (grid == 0) {
        if (n_in != 49 || out_size != NLAT * DM || ws_size < WS_END) { fprintf(stderr, "kernel_launch: unexpected shapes: n_in %d out %d ws %zu (need >= %zu)\n", n_in, out_size, ws_size, (size_t)WS_END); grid = -1; return; }
        int dev = 0, cus = 0, per_cu = 0;
        if (hipGetDevice(&dev) != hipSuccess || hipDeviceGetAttribute(&cus, hipDeviceAttributeMultiprocessorCount, dev) != hipSuccess) { grid = -1; return; }
        if (hipFuncSetAttribute((const void*)fwd_kernel, hipFuncAttributeMaxDynamicSharedMemorySize, LDS_BYTES) != hipSuccess) { fprintf(stderr, "kernel_launch: hipFuncSetAttribute failed\n"); grid = -1; return; }
        if (hipOccupancyMaxActiveBlocksPerMultiprocessor(&per_cu, (const void*)fwd_kernel, 512, LDS_BYTES) != hipSuccess || per_cu < 1) { fprintf(stderr, "kernel_launch: occupancy query says %d\n", per_cu); }
        (void)hipGetLastError();
        grid = cus;
    }
    if (grid < 0) return;
    (void)hipMemsetAsync((char*)d_ws + WS_CTL, 0, CTL_ZERO_BYTES, stream);
    KArgs a{};
    for (int i = 0; i < 49; ++i) a.in[i] = (const float*)d_in[i];
    a.out = (float*)d_out; a.ws = (unsigned char*)d_ws;
#if N_LAUNCH_MODE == 1
    a.ph_lo = 0; a.ph_hi = NPH;
    hipLaunchKernelGGL(fwd_kernel, dim3(grid), dim3(512), LDS_BYTES, stream, a);
#else
    for (int k = 0; k < NPH; ++k) { a.ph_lo = k; a.ph_hi = k + 1; hipLaunchKernelGGL(fwd_kernel, dim3(grid), dim3(512), LDS_BYTES, stream, a); }
#endif
    const hipError_t le = hipPeekAtLastError();
    if (le != hipSuccess) fprintf(stderr, "kernel_launch: launch failed: %s\n", hipGetErrorName(le));
}
```
